# Optimizing an MI355X kernel written in HIP

```python
import jax, jax.numpy as jnp
from jax import lax
import numpy as np

D_MODEL = 1024
BATCH = 4
SEQ = 4096
DEPTH = 1

CTX_LEN = 256
GRID_W = 64
ATT_HEADS = 8
ATT_KV_HEADS = 2
ATT_GROUP = ATT_HEADS // ATT_KV_HEADS
ATT_HEAD_DIM = 64
ATT_WIDTH = ATT_HEADS * ATT_HEAD_DIM
ATT_KV_WIDTH = ATT_KV_HEADS * ATT_HEAD_DIM
AXIS_DIM = ATT_HEAD_DIM // 2
ROPE_THETA = 10000.0
Q_BLOCK = 128
HG_HEADS = 4
HG_HEAD_DIM = 128
HG_WIDTH = HG_HEADS * HG_HEAD_DIM
MIX_WIDTH = ATT_WIDTH + HG_WIDTH
CHUNK = 64
D_FF = ((8 * D_MODEL // 3 + 255) // 256) * 256
EPS = 1e-6
IN_SIZES = (ATT_WIDTH, ATT_KV_WIDTH, ATT_KV_WIDTH, HG_WIDTH, HG_WIDTH, HG_WIDTH, HG_WIDTH, HG_WIDTH)
IN_COLS = sum(IN_SIZES)
IN_SPLIT_IDX = tuple(int(v) for v in np.cumsum(IN_SIZES)[:-1])

kernel_name = "hymba_gqa_hgrn2_prefix_dit_block"


def rmsnorm(x, g):
    xf = x.astype(jnp.float32)
    y = xf * lax.rsqrt(jnp.mean(xf * xf, axis=-1, keepdims=True) + EPS)
    return (y * g.astype(jnp.float32)).astype(x.dtype)


def modulate(h, shift, scale):
    return h * (1 + scale) + shift


def axial_rope_tables(n_tokens):
    n_rows = n_tokens // GRID_W
    row = jnp.repeat(jnp.arange(n_rows, dtype=jnp.float32), GRID_W)
    col = jnp.tile(jnp.arange(GRID_W, dtype=jnp.float32), n_rows)
    inv = ROPE_THETA ** (-jnp.arange(0, AXIS_DIM, 2, dtype=jnp.float32) / AXIS_DIM)
    ar = row[:, None] * inv
    ac = col[:, None] * inv
    ang = jnp.concatenate([ar, ar, ac, ac], axis=-1)
    return jnp.cos(ang), jnp.sin(ang)


def apply_rope(x, cos, sin):
    x4 = x.reshape(*x.shape[:-1], 2, 2, ATT_HEAD_DIM // 4)
    rot = jnp.stack([-x4[..., 1, :], x4[..., 0, :]], axis=-2).reshape(x.shape)
    return (x * cos[:, None, :] + rot * sin[:, None, :]).astype(x.dtype)


def latent_attention(qx, kx, vx, kc, vc):
    B, T = qx.shape[:2]
    nblk = T // Q_BLOCK
    keys = jnp.concatenate([kc, kx], axis=1)
    vals = jnp.concatenate([vc, vx], axis=1)
    qb = qx.reshape(B, nblk, Q_BLOCK, ATT_KV_HEADS, ATT_GROUP, ATT_HEAD_DIM).transpose(1, 0, 2, 3, 4, 5)
    scale = ATT_HEAD_DIM ** -0.5

    def block(q):
        s = jnp.einsum('bqkgd,bnkd->bkgqn', q, keys).astype(jnp.float32) * scale
        p = jax.nn.softmax(s, axis=-1)
        return jnp.einsum('bkgqn,bnkd->bqkgd', p.astype(vals.dtype), vals)

    o = lax.map(block, qb)
    return o.transpose(1, 0, 2, 3, 4, 5).reshape(B, T, ATT_WIDTH)


def context_attention(qc, kc, vc):
    B, L = qc.shape[:2]
    q = qc.reshape(B, L, ATT_KV_HEADS, ATT_GROUP, ATT_HEAD_DIM)
    s = jnp.einsum('bqkgd,bnkd->bkgqn', q, kc).astype(jnp.float32) * (ATT_HEAD_DIM ** -0.5)
    p = jax.nn.softmax(s, axis=-1)
    o = jnp.einsum('bkgqn,bnkd->bqkgd', p.astype(vc.dtype), vc)
    return o.reshape(B, L, ATT_WIDTH)


def gla_chunked(q, k, v, logf, s0):
    B, T, H, DK = q.shape
    n = T // CHUNK

    def to_chunks(a):
        return a.reshape(B, n, CHUNK, H, a.shape[-1]).transpose(1, 0, 3, 2, 4)

    mask = jnp.tril(jnp.ones((CHUNK, CHUNK), dtype=bool))[:, :, None]

    def step(S, inp):
        qc, kc, vc, lf = inp
        b = jnp.cumsum(lf, axis=-2)
        diff = b[:, :, :, None, :] - b[:, :, None, :, :]
        decay = jnp.where(mask, jnp.exp(jnp.minimum(diff, 0.0)), 0.0)
        A = jnp.einsum('bhtk,bhsk,bhtsk->bhts', qc, kc, decay)
        o = jnp.einsum('bhts,bhsv->bhtv', A, vc) + jnp.einsum('bhtk,bhkv->bhtv', qc * jnp.exp(b), S)
        b_last = b[:, :, -1, :]
        S_new = jnp.exp(b_last)[..., None] * S + jnp.einsum(
            'bhsk,bhsv->bhkv', kc * jnp.exp(b_last[:, :, None, :] - b), vc)
        return S_new, o

    S, o = lax.scan(step, s0, (to_chunks(q), to_chunks(k), to_chunks(v), to_chunks(logf)))
    return o.transpose(1, 0, 3, 2, 4).reshape(B, T, H, v.shape[-1]), S


def hgrn2_prep(q, i, f, lb_d):
    B, T = q.shape[:2]
    fg = lb_d + (1.0 - lb_d) * jax.nn.sigmoid(f.astype(jnp.float32))
    sh = lambda a: a.reshape(B, T, HG_HEADS, HG_HEAD_DIM)
    qh = sh(jax.nn.silu(q.astype(jnp.float32)) * (HG_HEAD_DIM ** -0.5))
    return qh, sh(1.0 - fg), sh(i.astype(jnp.float32)), sh(jnp.log(fg))


def hgrn2_bidirectional(px, pc, lb_l, gain):
    qx, ix, ffx, fbx, gx = px
    qc, ic, ffc, fbc, gc = pc
    B = qx.shape[0]
    s0 = jnp.zeros((B, HG_HEADS, HG_HEAD_DIM, HG_HEAD_DIM), jnp.float32)
    flip = lambda a: a[:, ::-1]
    oc_f, sc_f = gla_chunked(*hgrn2_prep(qc, ic, ffc, lb_l[0]), s0)
    ox_f, _ = gla_chunked(*hgrn2_prep(qx, ix, ffx, lb_l[0]), sc_f)
    oc_b, sc_b = gla_chunked(*map(flip, hgrn2_prep(qc, ic, fbc, lb_l[1])), s0)
    ox_b, _ = gla_chunked(*map(flip, hgrn2_prep(qx, ix, fbx, lb_l[1])), sc_b)

    def readout(o_f, o_b, g):
        Bn, T = g.shape[:2]
        o = rmsnorm(o_f + flip(o_b), gain).reshape(Bn, T, HG_WIDTH)
        return (o * jax.nn.silu(g.astype(jnp.float32))).astype(g.dtype)

    return readout(ox_f, ox_b, gx), readout(oc_f, oc_b, gc)


def swiglu(h, w_gu, w_down):
    a, b = jnp.split(h @ w_gu, 2, axis=-1)
    return (jax.nn.silu(a) * b) @ w_down


def setup_inputs(seed: int = 0) -> dict:
    key = jax.random.key(seed)
    ks = jax.random.split(key, 17)
    nrm = lambda k, shape, s: jax.random.normal(k, shape, jnp.float32) * s
    return {
        "x": nrm(ks[0], (BATCH, SEQ, D_MODEL), 1.0),
        "c": nrm(ks[1], (BATCH, D_MODEL), 1.0),
        "ctx": nrm(ks[2], (BATCH, CTX_LEN, D_MODEL), 1.0),
        "c_ctx": nrm(ks[3], (D_MODEL,), 1.0),
        "w_mod": nrm(ks[4], (DEPTH, D_MODEL, 6 * D_MODEL), 0.5 * D_MODEL ** -0.5),
        "b_mod": nrm(ks[5], (DEPTH, 6 * D_MODEL), 0.02),
        "g_norm1": 1.0 + nrm(ks[6], (DEPTH, D_MODEL), 0.02),
        "w_in": nrm(ks[7], (DEPTH, D_MODEL, IN_COLS), D_MODEL ** -0.5),
        "g_q": 1.0 + nrm(ks[8], (DEPTH, ATT_HEAD_DIM), 0.02),
        "g_k": 1.0 + nrm(ks[9], (DEPTH, ATT_HEAD_DIM), 0.02),
        "lb_raw": nrm(ks[10], (DEPTH + 1, 2, HG_WIDTH), 0.5),
        "g_hg": 1.0 + nrm(ks[11], (DEPTH, HG_HEAD_DIM), 0.02),
        "w_out": nrm(ks[12], (DEPTH, MIX_WIDTH, D_MODEL), MIX_WIDTH ** -0.5),
        "g_norm2": 1.0 + nrm(ks[13], (DEPTH, D_MODEL), 0.02),
        "w_gu": nrm(ks[14], (DEPTH, D_MODEL, 2 * D_FF), D_MODEL ** -0.5),
        "w_down": nrm(ks[15], (DEPTH, D_FF, D_MODEL), D_FF ** -0.5),
        "g_final": 1.0 + nrm(ks[16], (D_MODEL,), 0.02),
    }


def reference(x, c, ctx, c_ctx, w_mod, b_mod, g_norm1, w_in, g_q, g_k, lb_raw, g_hg, w_out,
              g_norm2, w_gu, w_down, g_final):
    B, T = x.shape[:2]
    cos, sin = axial_rope_tables(T)
    lb_all = jnp.cumsum(jax.nn.softmax(lb_raw.astype(jnp.float32), axis=0), axis=0)
    heads = lambda a, h, d: a.reshape(a.shape[0], a.shape[1], h, d)
    for l in range(DEPTH):
        last = l == DEPTH - 1
        mx = [m[:, None, :] for m in jnp.split(jax.nn.silu(c) @ w_mod[l] + b_mod[l], 6, axis=-1)]
        mc = jnp.split(jax.nn.silu(c_ctx) @ w_mod[l] + b_mod[l], 6, axis=-1)
        hx = modulate(rmsnorm(x, g_norm1[l]), mx[0], mx[1])
        hc = modulate(rmsnorm(ctx, g_norm1[l]), mc[0], mc[1])
        px = jnp.split(hx @ w_in[l], IN_SPLIT_IDX, axis=-1)
        pc = jnp.split(hc @ w_in[l], IN_SPLIT_IDX, axis=-1)
        qx = apply_rope(rmsnorm(heads(px[0], ATT_HEADS, ATT_HEAD_DIM), g_q[l]), cos, sin)
        kx = apply_rope(rmsnorm(heads(px[1], ATT_KV_HEADS, ATT_HEAD_DIM), g_k[l]), cos, sin)
        vx = heads(px[2], ATT_KV_HEADS, ATT_HEAD_DIM)
        kc = rmsnorm(heads(pc[1], ATT_KV_HEADS, ATT_HEAD_DIM), g_k[l])
        vc = heads(pc[2], ATT_KV_HEADS, ATT_HEAD_DIM)
        att_x = latent_attention(qx, kx, vx, kc, vc)
        hg_x, hg_c = hgrn2_bidirectional(px[3:], pc[3:], lb_all[l], g_hg[l])
        x = x + mx[2] * (jnp.concatenate([att_x, hg_x], axis=-1) @ w_out[l])
        x = x + mx[5] * swiglu(modulate(rmsnorm(x, g_norm2[l]), mx[3], mx[4]), w_gu[l], w_down[l])
        if not last:
            qc = rmsnorm(heads(pc[0], ATT_HEADS, ATT_HEAD_DIM), g_q[l])
            att_c = context_attention(qc, kc, vc)
            ctx = ctx + mc[2] * (jnp.concatenate([att_c, hg_c], axis=-1) @ w_out[l])
            ctx = ctx + mc[5] * swiglu(modulate(rmsnorm(ctx, g_norm2[l]), mc[3], mc[4]), w_gu[l], w_down[l])
    return rmsnorm(x, g_final)
```

```cpp
#include <hip/hip_runtime.h>
#include <hip/hip_cooperative_groups.h>
#include <cstdio>
#include <cstdint>
namespace cg = cooperative_groups;

#define DEVI __device__ __forceinline__
typedef unsigned short bf16_t;
typedef short bf16x8 __attribute__((ext_vector_type(8)));
typedef float f32x4 __attribute__((ext_vector_type(4)));
typedef unsigned u32x4 __attribute__((ext_vector_type(4)));
typedef unsigned u32x2 __attribute__((ext_vector_type(2)));

constexpr int DM = 1024, NB = 4, SEQ = 4096, CTX = 256, NLAT = NB * SEQ, NCTX = NB * CTX, MROWS = NLAT + NCTX;
constexpr int NKEY = CTX + SEQ;
constexpr int INC = 3328, DFF = 2816, NCH = NKEY / 64;
constexpr int NTASK = NB * 4 * 2 * NCH;
constexpr float EPS = 1e-6f;

constexpr size_t OFF_CNT = 16384;
constexpr size_t OFF_MOD = 32768;
constexpr size_t OFF_LB = OFF_MOD + 122880;
constexpr size_t OFF_WIN = OFF_LB + 4096;
constexpr size_t OFF_WOUT = OFF_WIN + 6815744;
constexpr size_t OFF_WGU = OFF_WOUT + 2097152;
constexpr size_t OFF_WDN = OFF_WGU + 11534336;
constexpr size_t OFF_A = OFF_WDN + 5767168;
constexpr size_t OFF_QATT = OFF_A + 35651584;
constexpr size_t OFF_KATT = OFF_QATT + 16777216;
constexpr size_t OFF_VATT = OFF_KATT + 4456448;
constexpr size_t OFF_QHG = OFF_VATT + 4456448;
constexpr size_t OFF_VHG = OFF_QHG + 17825792;
constexpr size_t OFF_LFC = OFF_VHG + 17825792;
constexpr size_t OFF_GHG = OFF_LFC + 4194304;
constexpr size_t OFF_KT = OFF_GHG + 16777216;
constexpr size_t OFF_AM = OFF_KT + 35651584;
constexpr size_t OFF_DV = OFF_AM + 17825792;
constexpr size_t OFF_MIX = OFF_DV + 3342336;
constexpr size_t OFF_END1 = OFF_MIX + 33554432;
constexpr size_t OFF_LF = OFF_MIX;
constexpr size_t OFF_OB = OFF_END1;
constexpr size_t OFF_END3 = OFF_OB + 33554432;
constexpr size_t OFF_RSS = OFF_END3;
constexpr size_t OFF_CGU = OFF_RSS + 65536;
static_assert(OFF_CGU + 90112 <= 268435456, "workspace over 256 MiB");
static_assert(OFF_LF + 67108864 <= 268435456 && OFF_END3 <= 268435456, "workspace over 256 MiB");
constexpr size_t OFF_X1 = OFF_QATT;
constexpr size_t OFF_ACT = OFF_X1 + 67108864;
constexpr size_t OFF_END2 = OFF_ACT + 92274688;
constexpr size_t WS_NEED = 268435456;
static_assert(WS_NEED <= 268435456, "workspace over 256 MiB");

struct Params {
    const float *x, *c, *ctx, *c_ctx, *w_mod, *b_mod, *g_norm1, *w_in, *g_q, *g_k, *lb_raw, *g_hg, *w_out, *g_norm2, *w_gu, *w_down, *g_final;
    float* out; unsigned char* ws;
};

DEVI unsigned pk_bf16(float lo, float hi) { unsigned r; asm("v_cvt_pk_bf16_f32 %0, %1, %2" : "=v"(r) : "v"(lo), "v"(hi)); return r; }
DEVI unsigned pk_bf16_t(float lo, float hi) { unsigned r; asm("s_nop 1\n\tv_cvt_pk_bf16_f32 %0, %1, %2" : "=v"(r) : "v"(lo), "v"(hi)); return r; }
DEVI unsigned pk_bf16_m(float lo, float hi) { unsigned r; asm("v_cvt_pk_bf16_f32 %0, %1, %2\n\ts_nop 1" : "=v"(r) : "v"(lo), "v"(hi)); return r; }
DEVI void mfma_settle() { asm volatile("s_nop 7\n\ts_nop 7" ::: "memory"); }
DEVI float bf2f(bf16_t h) { return __uint_as_float(((unsigned)h) << 16); }
DEVI float bflo(unsigned u) { return __uint_as_float(u << 16); }
DEVI float bfhi(unsigned u) { return __uint_as_float(u & 0xffff0000u); }
DEVI float siluf(float v) { return v * __builtin_amdgcn_rcpf(1.f + __expf(-v)); }
DEVI f32x4 mfma16(u32x4 a, u32x4 b, f32x4 c) {
    return __builtin_amdgcn_mfma_f32_16x16x32_bf16(__builtin_bit_cast(bf16x8, a), __builtin_bit_cast(bf16x8, b), c, 0, 0, 0);
}
DEVI int tidl() { int t = (int)threadIdx.x; asm volatile("" : "+v"(t)); return t; }
DEVI float wave_sum(float v) {
#pragma unroll
    for (int o = 1; o < 64; o <<= 1) v += __shfl_xor(v, o);
    return v;
}

DEVI void p0_transpose(const float* __restrict__ W, int ldw, bf16_t* __restrict__ Wt, int ldt, int k0, int n0, int gu, unsigned char* smem) {
    float* tile = (float*)smem;
    const int tid = tidl();
#pragma unroll
    for (int i = 0; i < 4; ++i) {
        const int kr = (tid >> 4) + 16 * i, nc = (tid & 15) * 4;
        const f32x4 v = *(const f32x4*)(W + (size_t)(k0 + kr) * ldw + n0 + nc);
        tile[kr * 65 + nc + 0] = v[0]; tile[kr * 65 + nc + 1] = v[1]; tile[kr * 65 + nc + 2] = v[2]; tile[kr * 65 + nc + 3] = v[3];
    }
    __syncthreads();
    const int nl = tid >> 2, kc = (tid & 3) * 16;
    unsigned w[8];
#pragma unroll
    for (int i = 0; i < 8; ++i) w[i] = pk_bf16(tile[(kc + 2 * i) * 65 + nl], tile[(kc + 2 * i + 1) * 65 + nl]);
    const int n = n0 + nl; int nrow = n;
    if (gu) { const int isB = n >= DFF; const int jj = isB ? n - DFF : n; nrow = (jj >> 4) * 32 + (jj & 15) + (isB ? 16 : 0); }
    u32x4* dst = (u32x4*)(Wt + (size_t)nrow * ldt + k0 + kc);
    dst[0] = (u32x4){w[0], w[1], w[2], w[3]}; dst[1] = (u32x4){w[4], w[5], w[6], w[7]};
    __syncthreads();
}

DEVI void p0_mod(const Params& p, int tsk, unsigned char* smem) {
    float* sc = (float*)smem;
    float* red = sc + 5 * 1024;
    float* mod = (float*)(p.ws + OFF_MOD);
    const int tid = tidl();
    for (int idx = tid; idx < 5120; idx += 256) { const int r = idx >> 10, k = idx & 1023; const float v = r < 4 ? p.c[r * 1024 + k] : p.c_ctx[k]; sc[idx] = siluf(v); }
    __syncthreads();
    const int cl = tid & 31, kp = tid >> 5, col = tsk * 32 + cl;
    float a0 = 0.f, a1 = 0.f, a2 = 0.f, a3 = 0.f, a4 = 0.f;
#pragma unroll 16
    for (int k = kp * 128; k < kp * 128 + 128; ++k) {
        const float w = p.w_mod[(size_t)k * 6144 + col];
        a0 += sc[k] * w; a1 += sc[1024 + k] * w; a2 += sc[2048 + k] * w; a3 += sc[3072 + k] * w; a4 += sc[4096 + k] * w;
    }
    red[(kp * 5 + 0) * 32 + cl] = a0; red[(kp * 5 + 1) * 32 + cl] = a1; red[(kp * 5 + 2) * 32 + cl] = a2; red[(kp * 5 + 3) * 32 + cl] = a3; red[(kp * 5 + 4) * 32 + cl] = a4;
    __syncthreads();
    if (tid < 160) { const int r = tid >> 5, c2 = tid & 31; float s = 0.f;
#pragma unroll
        for (int q = 0; q < 8; ++q) s += red[(q * 5 + r) * 32 + c2];
        mod[r * 6144 + tsk * 32 + c2] = s + p.b_mod[tsk * 32 + c2]; }
    __syncthreads();
}

DEVI void phase0(const Params& p, unsigned char* smem) {
    constexpr int T_MOD = 192, T_IN = 16 * 52, T_OUT = 16 * 16, T_GU = 16 * 88, T_DN = 44 * 16;
    constexpr int E0 = T_MOD + 1, E1 = E0 + T_IN, E2 = E1 + T_OUT, E3 = E2 + T_GU, E4 = E3 + T_DN;
    for (int t = blockIdx.x; t < E4; t += gridDim.x) {
        if (t < T_MOD) { p0_mod(p, t, smem); }
        else if (t == T_MOD) {
            float* lb = (float*)(p.ws + OFF_LB);
            for (int i = tidl(); i < 1024; i += 256) lb[i] = 1.f / (1.f + __expf(p.lb_raw[1024 + i] - p.lb_raw[i]));
            float* rss = (float*)(p.ws + OFF_RSS);
            for (int i = tidl(); i < NLAT; i += 256) rss[i] = 0.f;
        }
        else if (t < E1) { const int u = t - E0, kt = u / 52, nt = u % 52; p0_transpose(p.w_in, INC, (bf16_t*)(p.ws + OFF_WIN), 1024, kt * 64, nt * 64, 0, smem); }
        else if (t < E2) { const int u = t - E1, kt = u / 16, nt = u % 16; p0_transpose(p.w_out, 1024, (bf16_t*)(p.ws + OFF_WOUT), 1024, kt * 64, nt * 64, 0, smem); }
        else if (t < E3) { const int u = t - E2, kt = u / 88, nt = u % 88; p0_transpose(p.w_gu, 2 * DFF, (bf16_t*)(p.ws + OFF_WGU), 1024, kt * 64, nt * 64, 1, smem); }
        else { const int u = t - E3, kt = u / 16, nt = u % 16; p0_transpose(p.w_down, 1024, (bf16_t*)(p.ws + OFF_WDN), DFF, kt * 64, nt * 64, 0, smem); }
    }
}

DEVI void norm_mod_phase(const float* __restrict__ src_lat, const float* __restrict__ src_ctx, bf16_t* __restrict__ dst, const float* __restrict__ g,
                         const float* __restrict__ mod, int shift_idx, int scale_idx, int nrows) {
    const int lane = tidl() & 63, wid = tidl() >> 6;
    for (int t = blockIdx.x; t * 4 < nrows; t += gridDim.x) {
        const int row = t * 4 + wid;
        const float* src = row < NLAT ? src_lat + (size_t)row * DM : src_ctx + (size_t)(row - NLAT) * DM;
        const int mrow = row < NLAT ? (row >> 12) : 4;
        f32x4 v[4]; float ss = 0.f;
#pragma unroll
        for (int i = 0; i < 4; ++i) { v[i] = *(const f32x4*)(src + lane * 4 + 256 * i); ss += v[i][0] * v[i][0] + v[i][1] * v[i][1] + v[i][2] * v[i][2] + v[i][3] * v[i][3]; }
        ss = wave_sum(ss);
        const float rstd = rsqrtf(ss * (1.f / DM) + EPS);
#pragma unroll
        for (int i = 0; i < 4; ++i) {
            const int col = lane * 4 + 256 * i;
            const f32x4 gg = *(const f32x4*)(g + col), sh = *(const f32x4*)(mod + mrow * 6144 + shift_idx * 1024 + col), sc = *(const f32x4*)(mod + mrow * 6144 + scale_idx * 1024 + col);
            f32x4 h;
#pragma unroll
            for (int j = 0; j < 4; ++j) h[j] = v[i][j] * rstd * gg[j] * (1.f + sc[j]) + sh[j];
            *(u32x2*)(dst + (size_t)row * DM + col) = (u32x2){pk_bf16(h[0], h[1]), pk_bf16(h[2], h[3])};
        }
    }
}


DEVI void cgu_phase(const Params& p) {
    const int lane = tidl() & 63, wid = tidl() >> 6;
    const float* mod = (const float*)(p.ws + OFF_MOD);
    const bf16_t* W = (const bf16_t*)(p.ws + OFF_WGU);
    float* cgu = (float*)(p.ws + OFF_CGU);
    for (int t = blockIdx.x; t * 4 < 2 * DFF; t += gridDim.x) {
        const int n = t * 4 + wid;
        const u32x4 w0 = *(const u32x4*)(W + (size_t)n * DM + lane * 16), w1 = *(const u32x4*)(W + (size_t)n * DM + lane * 16 + 8);
        float wv[16] = {bflo(w0.x), bfhi(w0.x), bflo(w0.y), bfhi(w0.y), bflo(w0.z), bfhi(w0.z), bflo(w0.w), bfhi(w0.w),
                        bflo(w1.x), bfhi(w1.x), bflo(w1.y), bfhi(w1.y), bflo(w1.z), bfhi(w1.z), bflo(w1.w), bfhi(w1.w)};
#pragma unroll
        for (int b = 0; b < 4; ++b) {
            const float* sh = mod + b * 6144 + 3 * 1024 + lane * 16;
            float s = 0.f;
#pragma unroll
            for (int q = 0; q < 4; ++q) { const f32x4 sv = *(const f32x4*)(sh + 4 * q); s += sv[0] * wv[4 * q] + sv[1] * wv[4 * q + 1] + sv[2] * wv[4 * q + 2] + sv[3] * wv[4 * q + 3]; }
            s = wave_sum(s);
            if (lane == 0) cgu[b * 2 * DFF + n] = s;
        }
    }
}

#define LDSP __attribute__((address_space(3)))
#define GLBP __attribute__((address_space(1)))
DEVI void glds16(const void* g, unsigned char* l) {
    __builtin_amdgcn_global_load_lds((const GLBP void*)g, (LDSP void*)l, 16, 0, 0);
}
struct GTile2 { const bf16_t* ga; const bf16_t* gb; };
DEVI GTile2 gemm2_src(const bf16_t* A, int lda, const bf16_t* Bt, int ldb, int row0, int col0) {
    const int tid = tidl(), sr = tid >> 2, scn = (tid & 3) ^ ((tid >> 4) & 3);
    GTile2 t; t.ga = A + (size_t)(row0 + sr) * lda + scn * 8; t.gb = Bt + (size_t)(col0 + sr) * ldb + scn * 8; return t;
}
#define G2_ISSUE_T(T, kt_, slot_) { unsigned char* sb_ = smem + (slot_) * 24576 + st_off; const int ko_ = (kt_) * 32; \
        glds16(T.ga + ko_, sb_); glds16(T.ga + a64 + ko_, sb_ + 4096); glds16(T.ga + 2 * a64 + ko_, sb_ + 8192); glds16(T.ga + 3 * a64 + ko_, sb_ + 12288); \
        glds16(T.gb + ko_, sb_ + 16384); glds16(T.gb + b64 + ko_, sb_ + 20480); }
DEVI int mod3(int v) { return v >= 6 ? v - 6 : (v >= 3 ? v - 3 : v); }
DEVI void gemm2_tile(const GTile2 cur, const GTile2 nxt, const bool has_next, const bool first, int& g0, int lda, int ldb, int K, unsigned char* smem,
                     f32x4 (&accL)[4][4], f32x4 (&accH)[4][4]) {
    const int tid = tidl(), lane = tid & 63, wid = tid >> 6, wr = wid >> 1, wc = wid & 1, fr = lane & 15, fq = lane >> 4;
    const size_t a64 = (size_t)64 * lda, b64 = (size_t)64 * ldb;
    const int st_off = tid * 16;
    const int sw = (fr >> 2) & 3;
    const unsigned lds0 = (unsigned)(size_t)((LDSP unsigned char*)smem);
    const unsigned a_rd = lds0 + (wr * 128 + fr) * 64 + ((fq ^ sw) << 4);
    const unsigned b_rd = lds0 + 16384 + (wc * 64 + fr) * 64 + ((fq ^ sw) << 4);
#pragma unroll
    for (int m = 0; m < 4; ++m)
#pragma unroll
        for (int n = 0; n < 4; ++n) { accL[m][n] = (f32x4){0.f, 0.f, 0.f, 0.f}; accH[m][n] = (f32x4){0.f, 0.f, 0.f, 0.f}; }
    const int nk = K >> 5;
    if (first) {
        asm volatile("s_waitcnt vmcnt(0)" ::: "memory");
        __builtin_amdgcn_s_barrier();
        G2_ISSUE_T(cur, 0, mod3(g0)) G2_ISSUE_T(cur, 1, mod3(g0 + 1))
    }
    int slot = mod3(g0);
    for (int s = 0; s < nk; ++s) {
        if (has_next || s + 1 < nk) asm volatile("s_waitcnt vmcnt(6)" ::: "memory");
        else asm volatile("s_waitcnt vmcnt(0)" ::: "memory");
        __builtin_amdgcn_s_barrier();
        { const int s2 = s + 2; const int sl2 = mod3(slot + 2);
          if (s2 < nk) G2_ISSUE_T(cur, s2, sl2) else if (has_next) G2_ISSUE_T(nxt, s2 - nk, sl2) }
        const unsigned sa = a_rd + slot * 24576, sb = b_rd + slot * 24576;
        u32x4 a0, a1, a2, a3, a4, a5, a6, a7, b0, b1, b2, b3;
        asm volatile("ds_read_b128 %0, %1" : "=v"(a0) : "v"(sa)); asm volatile("ds_read_b128 %0, %1 offset:1024" : "=v"(a1) : "v"(sa));
        asm volatile("ds_read_b128 %0, %1 offset:2048" : "=v"(a2) : "v"(sa)); asm volatile("ds_read_b128 %0, %1 offset:3072" : "=v"(a3) : "v"(sa));
        asm volatile("ds_read_b128 %0, %1" : "=v"(b0) : "v"(sb)); asm volatile("ds_read_b128 %0, %1 offset:1024" : "=v"(b1) : "v"(sb));
        asm volatile("ds_read_b128 %0, %1 offset:2048" : "=v"(b2) : "v"(sb)); asm volatile("ds_read_b128 %0, %1 offset:3072" : "=v"(b3) : "v"(sb));
        asm volatile("ds_read_b128 %0, %1 offset:4096" : "=v"(a4) : "v"(sa)); asm volatile("ds_read_b128 %0, %1 offset:5120" : "=v"(a5) : "v"(sa));
        asm volatile("ds_read_b128 %0, %1 offset:6144" : "=v"(a6) : "v"(sa)); asm volatile("ds_read_b128 %0, %1 offset:7168" : "=v"(a7) : "v"(sa));
        asm volatile("s_waitcnt lgkmcnt(4)" : "+v"(a0), "+v"(a1), "+v"(a2), "+v"(a3), "+v"(b0), "+v"(b1), "+v"(b2), "+v"(b3));
        __builtin_amdgcn_s_setprio(1);
        accL[0][0] = mfma16(b0, a0, accL[0][0]); accL[0][1] = mfma16(b1, a0, accL[0][1]); accL[0][2] = mfma16(b2, a0, accL[0][2]); accL[0][3] = mfma16(b3, a0, accL[0][3]);
        accL[1][0] = mfma16(b0, a1, accL[1][0]); accL[1][1] = mfma16(b1, a1, accL[1][1]); accL[1][2] = mfma16(b2, a1, accL[1][2]); accL[1][3] = mfma16(b3, a1, accL[1][3]);
        accL[2][0] = mfma16(b0, a2, accL[2][0]); accL[2][1] = mfma16(b1, a2, accL[2][1]); accL[2][2] = mfma16(b2, a2, accL[2][2]); accL[2][3] = mfma16(b3, a2, accL[2][3]);
        accL[3][0] = mfma16(b0, a3, accL[3][0]); accL[3][1] = mfma16(b1, a3, accL[3][1]); accL[3][2] = mfma16(b2, a3, accL[3][2]); accL[3][3] = mfma16(b3, a3, accL[3][3]);
        asm volatile("s_waitcnt lgkmcnt(0)" : "+v"(a4), "+v"(a5), "+v"(a6), "+v"(a7), "+v"(b0), "+v"(b1), "+v"(b2), "+v"(b3));
        accH[0][0] = mfma16(b0, a4, accH[0][0]); accH[0][1] = mfma16(b1, a4, accH[0][1]); accH[0][2] = mfma16(b2, a4, accH[0][2]); accH[0][3] = mfma16(b3, a4, accH[0][3]);
        accH[1][0] = mfma16(b0, a5, accH[1][0]); accH[1][1] = mfma16(b1, a5, accH[1][1]); accH[1][2] = mfma16(b2, a5, accH[1][2]); accH[1][3] = mfma16(b3, a5, accH[1][3]);
        accH[2][0] = mfma16(b0, a6, accH[2][0]); accH[2][1] = mfma16(b1, a6, accH[2][1]); accH[2][2] = mfma16(b2, a6, accH[2][2]); accH[2][3] = mfma16(b3, a6, accH[2][3]);
        accH[3][0] = mfma16(b0, a7, accH[3][0]); accH[3][1] = mfma16(b1, a7, accH[3][1]); accH[3][2] = mfma16(b2, a7, accH[3][2]); accH[3][3] = mfma16(b3, a7, accH[3][3]);
        __builtin_amdgcn_s_setprio(0);
        slot = mod3(slot + 1);
    }
    g0 = slot;
}
DEVI bool xcd_tile2(int j, int NT, bool ctx, int& mt, int& nt) {
    const int x = blockIdx.x & 7, band = 8 * NT;
    if (j < band) { nt = j >> 3; mt = 8 * x + (j & 7); return true; }
    const int u = j - band;
    if (ctx && u < 9) { const int w = x * 9 + u; mt = 64 + w / 18; nt = 4 + w % 18; return true; }
    mt = 0; nt = 0; return false;
}

DEVI void epi_in(const Params& p, int mt, int nt, int wr, const f32x4 (&acc)[4][4]) {
    const int lane = tidl() & 63, wid = tidl() >> 6, wc = wid & 1, fr = lane & 15, fq = lane >> 4;
    const int row0 = mt * 128 + wr * 64 + fr;
    const bool lat = mt < 128;
    const int b = lat ? (mt >> 5) : ((mt - 128) >> 1);
    const int ntok0 = lat ? (CTX + ((mt & 31) * 128 + wr * 64 + fr)) : (((mt - 128) & 1) * 128 + wr * 64 + fr);
    unsigned char* ws = p.ws;
    if (nt < 5) {
        const bool isq = nt < 4;
        const float* gg = isq ? p.g_q : p.g_k;
        f32x4 gv[4];
#pragma unroll
        for (int n = 0; n < 4; ++n) gv[n] = *(const f32x4*)(gg + 16 * n + 4 * fq);
        float inv[4];
#pragma unroll
        for (int j = 0; j < 4; ++j) inv[j] = exp2f(-(float)(4 * fq + j) * (13.287712379549449f / 16.f));
        const float osc = isq ? 0.125f * 1.4426950408889634f : 1.f;
#pragma unroll
        for (int m = 0; m < 4; ++m) {
            float ss = 0.f;
#pragma unroll
            for (int n = 0; n < 4; ++n) ss += acc[m][n][0] * acc[m][n][0] + acc[m][n][1] * acc[m][n][1] + acc[m][n][2] * acc[m][n][2] + acc[m][n][3] * acc[m][n][3];
            ss += __shfl_xor(ss, 16); ss += __shfl_xor(ss, 32);
            const float rstd = rsqrtf(ss * (1.f / 64.f) + EPS);
            f32x4 v[4];
#pragma unroll
            for (int n = 0; n < 4; ++n) v[n] = acc[m][n] * rstd * gv[n];
            if (lat) {
                const int t = (mt & 31) * 128 + wr * 64 + fr + 16 * m;
                const float pr = (float)(t >> 6), pc = (float)(t & 63);
#pragma unroll
                for (int a = 0; a < 2; ++a) {
                    const float pos = a == 0 ? pr : pc;
#pragma unroll
                    for (int j = 0; j < 4; ++j) {
                        const float ang = pos * inv[j]; const float cs = __cosf(ang), sn = __sinf(ang);
                        const float x0 = v[2 * a][j], x1 = v[2 * a + 1][j];
                        v[2 * a][j] = x0 * cs - x1 * sn; v[2 * a + 1][j] = x1 * cs + x0 * sn;
                    }
                }
            }
            bf16_t* dst;
            if (isq) dst = (bf16_t*)(ws + OFF_QATT) + (size_t)(row0 + 16 * m) * 512 + (nt * 2 + wc) * 64 + 4 * fq;
            else dst = (bf16_t*)(ws + OFF_KATT) + ((size_t)(b * 2 + wc) * NKEY + ntok0 + 16 * m) * 64 + 4 * fq;
#pragma unroll
            for (int n = 0; n < 4; ++n) *(u32x2*)(dst + 16 * n) = (u32x2){pk_bf16(v[n][0] * osc, v[n][1] * osc), pk_bf16(v[n][2] * osc, v[n][3] * osc)};
        }
    } else if (nt == 5) {
        mfma_settle();
        bf16_t* base = (bf16_t*)(ws + OFF_VATT) + (size_t)(b * 2 + wc) * 64 * NKEY;
#pragma unroll
        for (int m = 0; m < 4; ++m)
#pragma unroll
            for (int n = 0; n < 4; ++n)
#pragma unroll
                for (int j = 0; j < 4; ++j) base[(size_t)(16 * n + 4 * fq + j) * NKEY + ntok0 + 16 * m] = (bf16_t)(pk_bf16(acc[m][n][j], 0.f) & 0xffffu);
    } else if (nt < 10) {
        const int cl = (nt - 6) * 128 + wc * 64 + 4 * fq;
#pragma unroll
        for (int m = 0; m < 4; ++m) {
            bf16_t* dst = (bf16_t*)(ws + OFF_QHG) + (size_t)(row0 + 16 * m) * 512 + cl;
#pragma unroll
            for (int n = 0; n < 4; ++n) {
                const float s = 0.08838834764831845f;
                *(u32x2*)(dst + 16 * n) = (u32x2){pk_bf16(siluf(acc[m][n][0]) * s, siluf(acc[m][n][1]) * s), pk_bf16(siluf(acc[m][n][2]) * s, siluf(acc[m][n][3]) * s)};
            }
        }
    } else if (nt < 14) {
        mfma_settle();
        const int h = nt - 10;
        bf16_t* base = (bf16_t*)(ws + OFF_VHG) + (size_t)((b * 4 + h) * 128 + wc * 64) * NKEY;
#pragma unroll
        for (int m = 0; m < 4; ++m)
#pragma unroll
            for (int n = 0; n < 4; ++n)
#pragma unroll
                for (int j = 0; j < 4; ++j) base[(size_t)(16 * n + 4 * fq + j) * NKEY + ntok0 + 16 * m] = (bf16_t)(pk_bf16(acc[m][n][j], 0.f) & 0xffffu);
    } else if (nt < 22) {
        const int cl = (nt - 14) * 128 + wc * 64 + 4 * fq;
        const float* lb = (const float*)(ws + OFF_LB);
        f32x4 lbv[4];
#pragma unroll
        for (int n = 0; n < 4; ++n) lbv[n] = *(const f32x4*)(lb + cl + 16 * n);
#pragma unroll
        for (int m = 0; m < 4; ++m) {
            float* dst = lat ? (float*)(ws + OFF_LF) + (size_t)(row0 + 16 * m) * 1024 + cl : (float*)(ws + OFF_LFC) + (size_t)(row0 + 16 * m - NLAT) * 1024 + cl;
#pragma unroll
            for (int n = 0; n < 4; ++n) {
                f32x4 o;
#pragma unroll
                for (int j = 0; j < 4; ++j) { const float sg = __builtin_amdgcn_rcpf(1.f + __expf(-acc[m][n][j])); o[j] = __logf(lbv[n][j] + (1.f - lbv[n][j]) * sg); }
                *(f32x4*)(dst + 16 * n) = o;
            }
        }
    } else {
        const int cl = (nt - 22) * 128 + wc * 64 + 4 * fq;
#pragma unroll
        for (int m = 0; m < 4; ++m) {
            bf16_t* dst = (bf16_t*)(ws + OFF_GHG) + (size_t)(row0 + 16 * m) * 512 + cl;
#pragma unroll
            for (int n = 0; n < 4; ++n)
                *(u32x2*)(dst + 16 * n) = (u32x2){pk_bf16(siluf(acc[m][n][0]), siluf(acc[m][n][1])), pk_bf16(siluf(acc[m][n][2]), siluf(acc[m][n][3]))};
        }
    }
}

DEVI void phase_gemm_in(const Params& p, unsigned char* smem) {
    const bf16_t* A = (const bf16_t*)(p.ws + OFF_A);
    const bf16_t* Bt = (const bf16_t*)(p.ws + OFF_WIN);
    bool first = true; int g0 = 0;
    const int nbx = gridDim.x >> 3, wr = tidl() >> 7;
    for (int j = blockIdx.x >> 3; ; j += nbx) {
        int mt, nt, mtn, ntn;
        if (!xcd_tile2(j, 26, true, mt, nt)) break;
        const bool has_next = xcd_tile2(j + nbx, 26, true, mtn, ntn);
        f32x4 accL[4][4], accH[4][4];
        gemm2_tile(gemm2_src(A, DM, Bt, DM, mt * 256, nt * 128), gemm2_src(A, DM, Bt, DM, mtn * 256, ntn * 128), has_next, first, g0, DM, DM, DM, smem, accL, accH);
        first = false;
        epi_in(p, 2 * mt + wr, nt, 0, accL);
        epi_in(p, 2 * mt + wr, nt, 1, accH);
    }
}

DEVI void hg_prep_task(const Params& p, int tk, unsigned char* smem) {
    const int c = tk % NCH, dir = (tk / NCH) & 1, bh = tk / (2 * NCH), h = bh & 3, b = bh >> 2;
    const int tid = tidl(), k = tid & 127, hf = tid >> 7;
    unsigned char* ws = p.ws;
    bf16_t* sQ = (bf16_t*)smem;
    bf16_t* sK = (bf16_t*)(smem + 17408);
    float* tot = (float*)(smem + 34816);
    const bool lat = c >= 4;
    const int rowbase = lat ? (b * SEQ + (c - 4) * 64) : (NLAT + b * CTX + c * 64);
    const float* lfp = lat ? (const float*)(ws + OFF_LF) + (size_t)rowbase * 1024 + dir * 512 + h * 128 + k
                           : (const float*)(ws + OFF_LFC) + (size_t)(rowbase - NLAT) * 1024 + dir * 512 + h * 128 + k;
    const bf16_t* qp = (const bf16_t*)(ws + OFF_QHG) + (size_t)rowbase * 512 + h * 128 + k;
    float tsum = 0.f;
#pragma unroll
    for (int i = 0; i < 32; ++i) tsum += lfp[(size_t)(hf * 32 + i) * 1024];
    tot[hf * 128 + k] = tsum;
    __syncthreads();
    const float t0 = tot[k], t1 = tot[128 + k];
    const float r = dir == 0 ? t0 : t1, blast = t0 + t1;
    const float addv = (dir == 0) ? (hf == 1 ? t0 : 0.f) : (hf == 0 ? t1 : 0.f);
    bf16_t* Qg = (bf16_t*)(ws + OFF_A) + (size_t)tk * 8192;
    float run = addv - r;
    u32x4* kd = (u32x4*)((bf16_t*)(ws + OFF_KT) + (size_t)tk * 8192 + k * 64 + hf * 32);
#pragma unroll 1
    for (int gg = 0; gg < 4; ++gg) {
        const int g = dir == 0 ? gg : 3 - gg;
        unsigned kw4[4];
#pragma unroll
        for (int jj = 0; jj < 4; ++jj) {
            const int ii = dir == 0 ? jj : 3 - jj;
            const int i = g * 8 + 2 * ii;
            const float l0 = lfp[(size_t)(hf * 32 + i) * 1024], l1 = lfp[(size_t)(hf * 32 + i + 1) * 1024];
            float b0, b1;
            if (dir == 0) { b0 = run + l0; b1 = b0 + l1; run = b1; } else { b1 = run + l1; b0 = b1 + l0; run = b0; }
            const float q0 = bf2f(qp[(size_t)(hf * 32 + i) * 512]), q1 = bf2f(qp[(size_t)(hf * 32 + i + 1) * 512]);
            const unsigned qq = pk_bf16(q0 * __expf(b0), q1 * __expf(b1));
            const unsigned kq = pk_bf16((1.f - __expf(l0)) * __expf(-b0), (1.f - __expf(l1)) * __expf(-b1));
            if (dir == 0) kw4[jj] = kq; else kw4[3 - jj] = kq;
            const int tok = hf * 32 + i;
            sQ[tok * 136 + k] = (bf16_t)(qq & 0xffffu); sQ[(tok + 1) * 136 + k] = (bf16_t)(qq >> 16);
            sK[tok * 136 + k] = (bf16_t)(kq & 0xffffu); sK[(tok + 1) * 136 + k] = (bf16_t)(kq >> 16);
        }
        kd[g] = (u32x4){kw4[0], kw4[1], kw4[2], kw4[3]};
    }
    if (hf == 0) {
        float* dv = (float*)(ws + OFF_DV) + (size_t)tk * 384;
        dv[k] = __expf(r); dv[128 + k] = __expf(blast - r); dv[256 + k] = __expf(blast);
    }
    __syncthreads();
#pragma unroll
    for (int j = 0; j < 4; ++j) { const int idx = tid + 256 * j, rq = idx >> 4, cq = idx & 15; *(u32x4*)(Qg + rq * 128 + cq * 8) = *(const u32x4*)(smem + rq * 272 + cq * 16); }
    const int lane = tid & 63, w = tid >> 6, fr = lane & 15, fq = lane >> 4;
    f32x4 a[4];
#pragma unroll
    for (int sn = 0; sn < 4; ++sn) a[sn] = (f32x4){0.f, 0.f, 0.f, 0.f};
#pragma unroll
    for (int kk = 0; kk < 4; ++kk) {
        const u32x4 qf = *(const u32x4*)(smem + (16 * w + fr) * 272 + (32 * kk + 8 * fq) * 2);
#pragma unroll
        for (int sn = 0; sn < 4; ++sn) {
            const u32x4 kf = *(const u32x4*)(smem + 17408 + (16 * sn + fr) * 272 + (32 * kk + 8 * fq) * 2);
            a[sn] = mfma16(kf, qf, a[sn]);
        }
    }
    bf16_t* Ag = (bf16_t*)(ws + OFF_AM) + (size_t)tk * 4096;
    const int t = 16 * w + fr;
#pragma unroll
    for (int sn = 0; sn < 4; ++sn) {
        float o[4];
#pragma unroll
        for (int j = 0; j < 4; ++j) { const int s = 16 * sn + 4 * fq + j; const bool keep = dir == 0 ? (s <= t) : (s >= t); o[j] = keep ? a[sn][j] : 0.f; }
        *(u32x2*)(Ag + t * 64 + 16 * sn + 4 * fq) = (u32x2){pk_bf16(o[0], o[1]), pk_bf16(o[2], o[3])};
    }
    __syncthreads();
}

constexpr int SC_KT = 0, SC_QT = 16384, SC_DV = 16384 + 17408, SC_BUF = 16384 + 17408 + 1536;
DEVI int scan_chunk(int dir, int i) { return dir == 0 ? i : (i < 4 ? 3 - i : 71 - i); }
DEVI void scan_block(const Params& p, int blk, unsigned char* smem) {
    const int tid = tidl(), lane = tid & 63, wid = tid >> 6, fr = lane & 15, fq = lane >> 4;
    const int vs = (blk & 1) * 4 + wid, dir = (blk >> 1) & 1, h = (blk >> 2) & 3, b = blk >> 4;
    unsigned char* ws = p.ws;
    const unsigned char* Qt = ws + OFF_A;
    const unsigned char* KtT = ws + OFF_KT;
    const bf16_t* Am = (const bf16_t*)(ws + OFF_AM);
    const unsigned char* dvb = ws + OFF_DV;
    bf16_t* obuf = (bf16_t*)(ws + OFF_OB) + (dir ? (size_t)NLAT * 512 : 0);
    const bf16_t* vrow = (const bf16_t*)(ws + OFF_VHG) + (size_t)((b * 4 + h) * 128 + vs * 16 + fr) * NKEY;
    const int tk0 = ((b * 4 + h) * 2 + dir) * NCH;
    int kt_dst[4], qt_dst[4];
#pragma unroll
    for (int j = 0; j < 4; ++j) {
        const int idx = tid + 256 * j;
        const int rk = idx >> 3, ck = idx & 7; kt_dst[j] = SC_KT + rk * 128 + ((ck ^ ((rk >> 1) & 7)) << 4);
        const int rq = idx >> 4, cq = idx & 15; qt_dst[j] = SC_QT + rq * 272 + cq * 16;
    }
    const int sw = (fr >> 1) & 7;
    const int kt_rd = SC_KT + fr * 128 + ((fq ^ sw) << 4);
    const int qt_rd = SC_QT + fr * 272 + 8 * fq;
    f32x4 S[8];
#pragma unroll
    for (int m = 0; m < 8; ++m) S[m] = (f32x4){0.f, 0.f, 0.f, 0.f};
    u32x4 stK[4], stQ[4], stD, vN[2], aC[8], vC[2];
    unsigned dummy = 0u;
    {
        const int c = scan_chunk(dir, 0); const size_t tk = tk0 + c;
#pragma unroll
        for (int j = 0; j < 4; ++j) { stK[j] = *(const u32x4*)(KtT + tk * 16384 + (tid + 256 * j) * 16); stQ[j] = *(const u32x4*)(Qt + tk * 16384 + (tid + 256 * j) * 16); }
        stD = (tid < 96) ? *(const u32x4*)(dvb + tk * 1536 + tid * 16) : (u32x4){0u, 0u, 0u, 0u};
        vC[0] = *(const u32x4*)(vrow + 64 * c + 8 * fq); vC[1] = *(const u32x4*)(vrow + 64 * c + 32 + 8 * fq);
#pragma unroll
        for (int q = 0; q < 8; ++q) aC[q] = *(const u32x4*)(Am + tk * 4096 + (16 * (q >> 1) + fr) * 64 + 32 * (q & 1) + 8 * fq);
#pragma unroll
        for (int j = 0; j < 4; ++j) { *(u32x4*)(smem + kt_dst[j]) = stK[j]; *(u32x4*)(smem + qt_dst[j]) = stQ[j]; }
        if (tid < 96) *(u32x4*)(smem + SC_DV + tid * 16) = stD;
        __syncthreads();
    }
#pragma unroll 1
    for (int i = 0; i < NCH; ++i) {
        const int c = scan_chunk(dir, i);
        const unsigned char* buf = smem + (i & 1) * SC_BUF;
        const int cn = scan_chunk(dir, i + 1 < NCH ? i + 1 : NCH - 1);
        const int c3 = scan_chunk(dir, i + 3 < NCH ? i + 3 : NCH - 1);
        const size_t tkn = tk0 + cn, tk3 = tk0 + c3;
#pragma unroll
        for (int j = 0; j < 4; ++j) { stK[j] = *(const u32x4*)(KtT + tkn * 16384 + (tid + 256 * j) * 16); stQ[j] = *(const u32x4*)(Qt + tkn * 16384 + (tid + 256 * j) * 16); }
        stD = *(const u32x4*)(dvb + tkn * 1536 + (tid < 96 ? tid : 0) * 16);
        vN[0] = *(const u32x4*)(vrow + 64 * cn + 8 * fq); vN[1] = *(const u32x4*)(vrow + 64 * cn + 32 + 8 * fq);
        const unsigned t0 = *(const unsigned*)((tid < 128 ? Qt : KtT) + tk3 * 16384 + (tid & 127) * 128);
        const unsigned t1 = *(const unsigned*)((const unsigned char*)Am + tk3 * 8192 + (tid & 63) * 128);
        const unsigned t2 = *(const unsigned*)(vrow + 64 * c3);
        f32x4 o[4];
#pragma unroll
        for (int nt = 0; nt < 4; ++nt) o[nt] = (f32x4){0.f, 0.f, 0.f, 0.f};
#pragma unroll
        for (int nt = 0; nt < 4; ++nt) { o[nt] = mfma16(vC[0], aC[2 * nt], o[nt]); o[nt] = mfma16(vC[1], aC[2 * nt + 1], o[nt]); }
        __builtin_amdgcn_sched_barrier(0);
#pragma unroll
        for (int q = 0; q < 8; ++q) aC[q] = *(const u32x4*)(Am + tkn * 4096 + (16 * (q >> 1) + fr) * 64 + 32 * (q & 1) + 8 * fq);
#pragma unroll
        for (int kk = 0; kk < 4; ++kk) {
            const f32x4 da = *(const f32x4*)(buf + SC_DV + (32 * kk + 4 * fq) * 4), db = *(const f32x4*)(buf + SC_DV + (32 * kk + 16 + 4 * fq) * 4);
            const u32x4 sf = (u32x4){pk_bf16_m(S[2 * kk][0] * da[0], S[2 * kk][1] * da[1]), pk_bf16_m(S[2 * kk][2] * da[2], S[2 * kk][3] * da[3]),
                                     pk_bf16_m(S[2 * kk + 1][0] * db[0], S[2 * kk + 1][1] * db[1]), pk_bf16_m(S[2 * kk + 1][2] * db[2], S[2 * kk + 1][3] * db[3])};
#pragma unroll
            for (int nt = 0; nt < 4; ++nt) {
                const u32x2 qa = *(const u32x2*)(buf + qt_rd + nt * 4352 + 64 * kk), qb = *(const u32x2*)(buf + qt_rd + nt * 4352 + 64 * kk + 32);
                o[nt] = mfma16(sf, (u32x4){qa.x, qa.y, qb.x, qb.y}, o[nt]);
            }
        }
        if (c >= 4) {
            mfma_settle();
            bf16_t* od = obuf + (size_t)(b * SEQ + (c - 4) * 64 + fr) * 512 + h * 128 + vs * 16 + 4 * fq;
#pragma unroll
            for (int nt = 0; nt < 4; ++nt) *(u32x2*)(od + (size_t)(16 * nt) * 512) = (u32x2){pk_bf16(o[nt][0], o[nt][1]), pk_bf16(o[nt][2], o[nt][3])};
        }
        __builtin_amdgcn_sched_barrier(0);
#pragma unroll
        for (int mt = 0; mt < 8; ++mt) {
            f32x4 u = (f32x4){0.f, 0.f, 0.f, 0.f};
#pragma unroll
            for (int kk = 0; kk < 2; ++kk) { const u32x4 kf = *(const u32x4*)(buf + ((kt_rd + mt * 2048) ^ (kk << 6))); u = mfma16(kf, vC[kk], u); }
            const f32x4 d2 = *(const f32x4*)(buf + SC_DV + (128 + 16 * mt + 4 * fq) * 4), d3 = *(const f32x4*)(buf + SC_DV + (256 + 16 * mt + 4 * fq) * 4);
            S[mt] = d3 * S[mt] + d2 * u;
        }
        dummy |= t0 | t1 | t2;
        {
            unsigned char* nb = smem + ((i + 1) & 1) * SC_BUF;
#pragma unroll
            for (int j = 0; j < 4; ++j) { *(u32x4*)(nb + kt_dst[j]) = stK[j]; *(u32x4*)(nb + qt_dst[j]) = stQ[j]; }
            if (tid < 96) *(u32x4*)(nb + SC_DV + tid * 16) = stD;
            vC[0] = vN[0]; vC[1] = vN[1];
        }
        __syncthreads();
    }
    if (dummy == 0x9e3779b9u) p.out[0] = 0.f;
}

DEVI void attn_item(const Params& p, int item, unsigned char* smem) {
    const int g = item & 3, qb = (item >> 2) & 31, bk = item >> 7, b = bk >> 1, kvh = bk & 1, head = kvh * 4 + g;
    const int tid = tidl(), lane = tid & 63, wid = tid >> 6, fr = lane & 15, fq = lane >> 4;
    unsigned char* ws = p.ws;
    const int r0 = tid >> 3, cl = (tid & 7) ^ ((tid >> 4) & 7);
    const unsigned char* kg0 = ws + OFF_KATT + (size_t)bk * NKEY * 64 * 2 + r0 * 128 + cl * 16;
    const unsigned char* vg0 = ws + OFF_VATT + (size_t)bk * 64 * NKEY * 2 + (size_t)r0 * NKEY * 2 + cl * 16;
    const int st_off = tid * 16;
#define ATT_ISSUE(kt_) { unsigned char* sb_ = smem + ((kt_) & 3) * 16384 + st_off; \
        glds16(kg0 + (size_t)(kt_) * 8192, sb_); glds16(kg0 + (size_t)(kt_) * 8192 + 4096, sb_ + 4096); \
        glds16(vg0 + (kt_) * 128, sb_ + 8192); glds16(vg0 + (size_t)32 * NKEY * 2 + (kt_) * 128, sb_ + 12288); }
    const int q0 = b * SEQ + qb * 128 + wid * 32;
    u32x4 qf[2][2];
#pragma unroll
    for (int qt = 0; qt < 2; ++qt)
#pragma unroll
        for (int kk = 0; kk < 2; ++kk) qf[qt][kk] = *(const u32x4*)((const bf16_t*)(ws + OFF_QATT) + (size_t)(q0 + 16 * qt + fr) * 512 + head * 64 + 32 * kk + 8 * fq);
    f32x4 o[4][2];
#pragma unroll
    for (int dt = 0; dt < 4; ++dt) { o[dt][0] = (f32x4){0.f, 0.f, 0.f, 0.f}; o[dt][1] = (f32x4){0.f, 0.f, 0.f, 0.f}; }
    float gqm = fabsf(p.g_q[lane]), gkm = fabsf(p.g_k[lane]);
#pragma unroll
    for (int of2 = 1; of2 < 64; of2 <<= 1) { gqm = fmaxf(gqm, __shfl_xor(gqm, of2)); gkm = fmaxf(gkm, __shfl_xor(gkm, of2)); }
    const float Mst = 64.f * gqm * gkm * (0.125f * 1.4426950408889634f) * 1.01f;
    f32x4 lacc[2] = {(f32x4){0.f, 0.f, 0.f, 0.f}, (f32x4){0.f, 0.f, 0.f, 0.f}};
    const unsigned one2 = fr == 0 ? 0x3f803f80u : 0u;
    const u32x4 ones = (u32x4){one2, one2, one2, one2};
    const int sw = (fr >> 1) & 7;
    const unsigned lds0 = (unsigned)(size_t)((LDSP unsigned char*)smem);
    const unsigned k_rd = lds0 + fr * 128 + ((fq ^ sw) << 4);
    const unsigned v_rd = lds0 + 8192 + fr * 128 + (((fq >> 1) ^ sw) << 4) + (fq & 1) * 8;
    asm volatile("s_waitcnt vmcnt(0)" ::: "memory");
    __builtin_amdgcn_s_barrier();
    ATT_ISSUE(0) ATT_ISSUE(1) ATT_ISSUE(2)
    for (int kt = 0; kt < NCH; ++kt) {
        if (kt + 2 < NCH) asm volatile("s_waitcnt vmcnt(8)" ::: "memory");
        else if (kt + 1 < NCH) asm volatile("s_waitcnt vmcnt(4)" ::: "memory");
        else asm volatile("s_waitcnt vmcnt(0)" ::: "memory");
        __builtin_amdgcn_s_barrier();
        if (kt + 3 < NCH) ATT_ISSUE(kt + 3)
        const unsigned kb = k_rd + (kt & 3) * 16384, vb = v_rd + (kt & 3) * 16384;
        u32x4 k0, k1, k2, k3, k4, k5, k6, k7;
        asm volatile("ds_read_b128 %0, %1" : "=v"(k0) : "v"(kb));
        asm volatile("ds_read_b128 %0, %1 offset:2048" : "=v"(k1) : "v"(kb));
        asm volatile("ds_read_b128 %0, %1 offset:4096" : "=v"(k2) : "v"(kb));
        asm volatile("ds_read_b128 %0, %1 offset:6144" : "=v"(k3) : "v"(kb));
        asm volatile("ds_read_b128 %0, %1" : "=v"(k4) : "v"(kb ^ 64u));
        asm volatile("ds_read_b128 %0, %1 offset:2048" : "=v"(k5) : "v"(kb ^ 64u));
        asm volatile("ds_read_b128 %0, %1 offset:4096" : "=v"(k6) : "v"(kb ^ 64u));
        asm volatile("ds_read_b128 %0, %1 offset:6144" : "=v"(k7) : "v"(kb ^ 64u));
        asm volatile("s_waitcnt lgkmcnt(0)" : "+v"(k0), "+v"(k1), "+v"(k2), "+v"(k3), "+v"(k4), "+v"(k5), "+v"(k6), "+v"(k7));
        f32x4 s[4][2];
        const f32x4 z4 = (f32x4){-Mst, -Mst, -Mst, -Mst};
        s[0][0] = mfma16(k0, qf[0][0], z4); s[0][1] = mfma16(k0, qf[1][0], z4);
        s[1][0] = mfma16(k1, qf[0][0], z4); s[1][1] = mfma16(k1, qf[1][0], z4);
        s[2][0] = mfma16(k2, qf[0][0], z4); s[2][1] = mfma16(k2, qf[1][0], z4);
        s[3][0] = mfma16(k3, qf[0][0], z4); s[3][1] = mfma16(k3, qf[1][0], z4);
        s[0][0] = mfma16(k4, qf[0][1], s[0][0]); s[0][1] = mfma16(k4, qf[1][1], s[0][1]);
        s[1][0] = mfma16(k5, qf[0][1], s[1][0]); s[1][1] = mfma16(k5, qf[1][1], s[1][1]);
        s[2][0] = mfma16(k6, qf[0][1], s[2][0]); s[2][1] = mfma16(k6, qf[1][1], s[2][1]);
        s[3][0] = mfma16(k7, qf[0][1], s[3][0]); s[3][1] = mfma16(k7, qf[1][1], s[3][1]);
        u32x2 va[8], vbq[8];
#pragma unroll
        for (int kk = 0; kk < 2; ++kk)
#pragma unroll
            for (int dt = 0; dt < 4; ++dt) {
                const unsigned ad = (vb + dt * 2048) ^ (kk << 6);
                asm volatile("ds_read_b64 %0, %1" : "=v"(va[kk * 4 + dt]) : "v"(ad));
                asm volatile("ds_read_b64 %0, %1" : "=v"(vbq[kk * 4 + dt]) : "v"(ad ^ 32u));
            }
        u32x4 pf[2][2];
#pragma unroll
        for (int qt = 0; qt < 2; ++qt) {
#pragma unroll
            for (int ks = 0; ks < 4; ++ks)
#pragma unroll
                for (int j = 0; j < 4; ++j) s[ks][qt][j] = __builtin_amdgcn_exp2f(s[ks][qt][j]);
#pragma unroll
            for (int kk = 0; kk < 2; ++kk)
                pf[qt][kk] = (u32x4){pk_bf16_t(s[2 * kk][qt][0], s[2 * kk][qt][1]), pk_bf16_t(s[2 * kk][qt][2], s[2 * kk][qt][3]),
                                     pk_bf16_t(s[2 * kk + 1][qt][0], s[2 * kk + 1][qt][1]), pk_bf16_t(s[2 * kk + 1][qt][2], s[2 * kk + 1][qt][3])};
        }
        asm volatile("s_nop 1" ::: "memory");
        asm volatile("s_waitcnt lgkmcnt(0)" : "+v"(va[0]), "+v"(va[1]), "+v"(va[2]), "+v"(va[3]), "+v"(va[4]), "+v"(va[5]), "+v"(va[6]), "+v"(va[7]),
                     "+v"(vbq[0]), "+v"(vbq[1]), "+v"(vbq[2]), "+v"(vbq[3]), "+v"(vbq[4]), "+v"(vbq[5]), "+v"(vbq[6]), "+v"(vbq[7]));
#pragma unroll
        for (int kk = 0; kk < 2; ++kk)
#pragma unroll
            for (int dt = 0; dt < 4; ++dt) {
                const u32x4 vfr = (u32x4){va[kk * 4 + dt].x, va[kk * 4 + dt].y, vbq[kk * 4 + dt].x, vbq[kk * 4 + dt].y};
                o[dt][0] = mfma16(vfr, pf[0][kk], o[dt][0]); o[dt][1] = mfma16(vfr, pf[1][kk], o[dt][1]);
            }
        lacc[0] = mfma16(ones, pf[0][0], lacc[0]); lacc[0] = mfma16(ones, pf[0][1], lacc[0]);
        lacc[1] = mfma16(ones, pf[1][0], lacc[1]); lacc[1] = mfma16(ones, pf[1][1], lacc[1]);
    }
#undef ATT_ISSUE
#pragma unroll
    for (int qt = 0; qt < 2; ++qt) {
        const float l = __shfl(lacc[qt][0], fr);
        const float il = 1.f / l;
        bf16_t* dst = (bf16_t*)(ws + OFF_MIX) + (size_t)(q0 + 16 * qt + fr) * 1024 + head * 64 + 4 * fq;
#pragma unroll
        for (int dt = 0; dt < 4; ++dt) *(u32x2*)(dst + 16 * dt) = (u32x2){pk_bf16(o[dt][qt][0] * il, o[dt][qt][1] * il), pk_bf16(o[dt][qt][2] * il, o[dt][qt][3] * il)};
    }
}

DEVI void readout_phase(const Params& p) {
    const int lane = tidl() & 63, wid = tidl() >> 6;
    const bf16_t* of = (const bf16_t*)(p.ws + OFF_OB); const bf16_t* ob = of + (size_t)NLAT * 512;
    const bf16_t* gh = (const bf16_t*)(p.ws + OFF_GHG);
    bf16_t* mix = (bf16_t*)(p.ws + OFF_MIX);
    const f32x4 g0 = *(const f32x4*)(p.g_hg + (lane & 15) * 8), g1 = *(const f32x4*)(p.g_hg + (lane & 15) * 8 + 4);
    for (int t = blockIdx.x; t * 4 < NLAT; t += gridDim.x) {
        const size_t row = (size_t)t * 4 + wid;
        const u32x4 ua = *(const u32x4*)(of + row * 512 + lane * 8), ub = *(const u32x4*)(ob + row * 512 + lane * 8);
        const u32x4 gg = *(const u32x4*)(gh + row * 512 + lane * 8);
        f32x4 v0 = (f32x4){bflo(ua.x) + bflo(ub.x), bfhi(ua.x) + bfhi(ub.x), bflo(ua.y) + bflo(ub.y), bfhi(ua.y) + bfhi(ub.y)};
        f32x4 v1 = (f32x4){bflo(ua.z) + bflo(ub.z), bfhi(ua.z) + bfhi(ub.z), bflo(ua.w) + bflo(ub.w), bfhi(ua.w) + bfhi(ub.w)};
        float ss = v0[0] * v0[0] + v0[1] * v0[1] + v0[2] * v0[2] + v0[3] * v0[3] + v1[0] * v1[0] + v1[1] * v1[1] + v1[2] * v1[2] + v1[3] * v1[3];
        ss += __shfl_xor(ss, 1); ss += __shfl_xor(ss, 2); ss += __shfl_xor(ss, 4); ss += __shfl_xor(ss, 8);
        const float rstd = rsqrtf(ss * (1.f / 128.f) + EPS);
        v0 = v0 * rstd * g0; v1 = v1 * rstd * g1;
        *(u32x4*)(mix + row * 1024 + 512 + lane * 8) = (u32x4){pk_bf16(v0[0] * bflo(gg.x), v0[1] * bfhi(gg.x)), pk_bf16(v0[2] * bflo(gg.y), v0[3] * bfhi(gg.y)),
                                                              pk_bf16(v1[0] * bflo(gg.z), v1[1] * bfhi(gg.z)), pk_bf16(v1[2] * bflo(gg.w), v1[3] * bfhi(gg.w))};
    }
}

template <bool FUSE_NORM>
DEVI void epi_res(const Params& p, int mt, int nt, int wr, const f32x4 (&acc)[4][4], const float* res, float* dst, int gate_idx) {
    const float* mod = (const float*)(p.ws + OFF_MOD);
    const int lane = tidl() & 63, wid = tidl() >> 6, wc = wid & 1, fr = lane & 15, fq = lane >> 4;
    const int b = mt >> 5, col = nt * 128 + wc * 64 + 4 * fq;
    f32x4 gt[4], gs[4];
#pragma unroll
    for (int n = 0; n < 4; ++n) {
        gt[n] = *(const f32x4*)(mod + b * 6144 + gate_idx * 1024 + col + 16 * n);
        if (FUSE_NORM) gs[n] = *(const f32x4*)(p.g_norm2 + col + 16 * n) * (*(const f32x4*)(mod + b * 6144 + 4 * 1024 + col + 16 * n) + 1.f);
    }
#pragma unroll
    for (int m = 0; m < 4; ++m) {
        const int row = mt * 128 + wr * 64 + 16 * m + fr;
        float ss = 0.f;
#pragma unroll
        for (int n = 0; n < 4; ++n) {
            const size_t off = (size_t)row * DM + col + 16 * n;
            const f32x4 v = *(const f32x4*)(res + off) + gt[n] * acc[m][n];
            *(f32x4*)(dst + off) = v;
            if (FUSE_NORM) {
                ss += v[0] * v[0] + v[1] * v[1] + v[2] * v[2] + v[3] * v[3];
                const f32x4 hh = v * gs[n];
                *(u32x2*)((bf16_t*)(p.ws + OFF_A) + off) = (u32x2){pk_bf16(hh[0], hh[1]), pk_bf16(hh[2], hh[3])};
            }
        }
        if (FUSE_NORM) {
            ss += __shfl_xor(ss, 16); ss += __shfl_xor(ss, 32);
            if (fq == 0) atomicAdd((float*)(p.ws + OFF_RSS) + row, ss);
        }
    }
}
template <bool FUSE_NORM>
DEVI void phase_gemm_res(const Params& p, const bf16_t* A, int lda, const bf16_t* Bt, int K, const float* res, float* dst, int gate_idx, unsigned char* smem) {
    bool first = true; int g0 = 0;
    const int nbx = gridDim.x >> 3, wr = tidl() >> 7;
    for (int j = blockIdx.x >> 3; ; j += nbx) {
        int mt, nt, mtn, ntn;
        if (!xcd_tile2(j, 8, false, mt, nt)) break;
        const bool has_next = xcd_tile2(j + nbx, 8, false, mtn, ntn);
        f32x4 accL[4][4], accH[4][4];
        gemm2_tile(gemm2_src(A, lda, Bt, K, mt * 256, nt * 128), gemm2_src(A, lda, Bt, K, mtn * 256, ntn * 128), has_next, first, g0, lda, K, K, smem, accL, accH);
        first = false;
        epi_res<FUSE_NORM>(p, 2 * mt + wr, nt, 0, accL, res, dst, gate_idx);
        epi_res<FUSE_NORM>(p, 2 * mt + wr, nt, 1, accH, res, dst, gate_idx);
    }
}

DEVI void epi_gu(const Params& p, int mt, int nt, int wr, const f32x4 (&acc)[4][4]) {
    bf16_t* act = (bf16_t*)(p.ws + OFF_ACT);
    const int lane = tidl() & 63, wid = tidl() >> 6, wc = wid & 1, fr = lane & 15, fq = lane >> 4;
    const float* cg = (const float*)(p.ws + OFF_CGU) + (mt >> 5) * 2 * DFF + nt * 128 + wc * 64 + 4 * fq;
    f32x4 cb[4];
#pragma unroll
    for (int n = 0; n < 4; ++n) cb[n] = *(const f32x4*)(cg + 16 * n);
#pragma unroll
    for (int m = 0; m < 4; ++m) {
        const int row = mt * 128 + wr * 64 + 16 * m + fr;
        const float rstd = rsqrtf(((const float*)(p.ws + OFF_RSS))[row] * (1.f / DM) + EPS);
        bf16_t* dst = act + (size_t)row * DFF + nt * 64 + wc * 32 + 4 * fq;
#pragma unroll
        for (int n2 = 0; n2 < 2; ++n2) {
            const f32x4 a = acc[m][2 * n2] * rstd + cb[2 * n2], bq = acc[m][2 * n2 + 1] * rstd + cb[2 * n2 + 1];
            *(u32x2*)(dst + 16 * n2) = (u32x2){pk_bf16(siluf(a[0]) * bq[0], siluf(a[1]) * bq[1]), pk_bf16(siluf(a[2]) * bq[2], siluf(a[3]) * bq[3])};
        }
    }
}
DEVI void phase_gemm_gu(const Params& p, unsigned char* smem) {
    const bf16_t* A = (const bf16_t*)(p.ws + OFF_A);
    const bf16_t* Bt = (const bf16_t*)(p.ws + OFF_WGU);
    bool first = true; int g0 = 0;
    const int nbx = gridDim.x >> 3, wr = tidl() >> 7;
    for (int j = blockIdx.x >> 3; ; j += nbx) {
        int mt, nt, mtn, ntn;
        if (!xcd_tile2(j, 44, false, mt, nt)) break;
        const bool has_next = xcd_tile2(j + nbx, 44, false, mtn, ntn);
        f32x4 accL[4][4], accH[4][4];
        gemm2_tile(gemm2_src(A, DM, Bt, DM, mt * 256, nt * 128), gemm2_src(A, DM, Bt, DM, mtn * 256, ntn * 128), has_next, first, g0, DM, DM, DM, smem, accL, accH);
        first = false;
        epi_gu(p, 2 * mt + wr, nt, 0, accL);
        epi_gu(p, 2 * mt + wr, nt, 1, accH);
    }
}

DEVI void final_norm_phase(const Params& p) {
    const int lane = tidl() & 63, wid = tidl() >> 6;
    for (int t = blockIdx.x; t * 4 < NLAT; t += gridDim.x) {
        const float* srow = (const float*)(p.ws + OFF_X1) + ((size_t)t * 4 + wid) * DM;
        float* row = p.out + ((size_t)t * 4 + wid) * DM;
        f32x4 v[4]; float ss = 0.f;
#pragma unroll
        for (int i = 0; i < 4; ++i) { v[i] = *(const f32x4*)(srow + lane * 4 + 256 * i); ss += v[i][0] * v[i][0] + v[i][1] * v[i][1] + v[i][2] * v[i][2] + v[i][3] * v[i][3]; }
        ss = wave_sum(ss);
        const float rstd = rsqrtf(ss * (1.f / DM) + EPS);
#pragma unroll
        for (int i = 0; i < 4; ++i) { const f32x4 gg = *(const f32x4*)(p.g_final + lane * 4 + 256 * i); *(f32x4*)(row + lane * 4 + 256 * i) = v[i] * rstd * gg; }
    }
}


#define XB_TMO      128
#define XB_XCNT(j)  (256  + 64 * (j))
#define XB_XSUB(j)  (1280 + 64 * (j))
#define XB_XGEN(j)  (2304 + 64 * (j))
#define XB_TOP      3328
#define XB_TOPGEN   3392
#define XB_SPIN_CAP (1u << 22)
#define LAS __attribute__((address_space(3)))
DEVI unsigned xb_ld(unsigned* p)              { return __hip_atomic_load(p, __ATOMIC_RELAXED, __HIP_MEMORY_SCOPE_AGENT); }
DEVI unsigned xb_add(unsigned* p, unsigned v) { return __hip_atomic_fetch_add(p, v, __ATOMIC_RELAXED, __HIP_MEMORY_SCOPE_AGENT); }
DEVI unsigned xb_xcc_id() { return (unsigned)__builtin_amdgcn_s_getreg((3 << 11) | 20) & 0xFu; }
#define XB_SPIN(cond, bar) do { unsigned _sp = 0; while (cond) { __builtin_amdgcn_s_sleep(1); \
    if ((++_sp & 255u) == 0u) { if (xb_ld(&(bar)[XB_TMO])) break; if (_sp > XB_SPIN_CAP) { atomicAdd(&(bar)[XB_TMO], 1u); break; } } } } while (0)
struct XcdBarrier { unsigned* bar; unsigned x; volatile unsigned* st; };
DEVI XcdBarrier xcd_barrier_post(unsigned* bar, volatile unsigned* st) {
    XcdBarrier b; b.bar = bar; b.x = xb_xcc_id(); b.st = st;
    if (threadIdx.x == 0) (void)xb_add(&bar[XB_XCNT(b.x)], 1u);
    return b;
}
DEVI void xcd_barrier_complete(unsigned* bar, unsigned x, unsigned& nloc, unsigned& nx) {
    const unsigned G = gridDim.x * gridDim.y * gridDim.z;
    unsigned sum, cnt, mine, sp = 0u;
    for (;;) {
        sum = 0u; cnt = 0u; mine = 0u;
#pragma unroll
        for (unsigned j = 0; j < 16; ++j) { const unsigned c = xb_ld(&bar[XB_XCNT(j)]); sum += c; cnt += (c > 0u) ? 1u : 0u; mine = (j == x) ? c : mine; }
        if (sum == G) break;
        __builtin_amdgcn_s_sleep(1);
        if ((++sp & 255u) == 0u) { if (xb_ld(&bar[XB_TMO])) break; if (sp > XB_SPIN_CAP) { atomicAdd(&bar[XB_TMO], 1u); break; } }
    }
    nloc = mine > 0u ? mine : 1u; nx = cnt > 0u ? cnt : 1u;
}
DEVI void xcd_barrier(const XcdBarrier& b) {
    asm volatile("s_waitcnt vmcnt(0)" ::: "memory");
    __syncthreads();
    if (threadIdx.x == 0) {
        unsigned* bar = b.bar;
        __builtin_amdgcn_s_waitcnt(0);
        unsigned nloc = b.st[0], nx = b.st[1];
        if (nloc == 0u) { xcd_barrier_complete(bar, b.x, nloc, nx); b.st[0] = nloc; b.st[1] = nx; }
        const unsigned old = xb_add(&bar[XB_XSUB(b.x)], 1u);
        const unsigned gen = old / nloc;
        if (old + 1u == (gen + 1u) * nloc) {
            __builtin_amdgcn_fence(__ATOMIC_RELEASE, "agent");
            asm volatile("s_waitcnt vmcnt(0)" ::: "memory");
            const unsigned og = xb_add(&bar[XB_TOP], 1u);
            const unsigned tg = og / nx;
            if (og + 1u == (tg + 1u) * nx) xb_add(&bar[XB_TOPGEN], 1u);
            else XB_SPIN(xb_ld(&bar[XB_TOPGEN]) == tg, bar);
            __builtin_amdgcn_fence(__ATOMIC_ACQUIRE, "agent");
            xb_add(&bar[XB_XGEN(b.x)], 1u);
            asm volatile("s_waitcnt vmcnt(0)" ::: "memory");
        } else {
            XB_SPIN(xb_ld(&bar[XB_XGEN(b.x)]) == gen, bar);
            __builtin_amdgcn_fence(__ATOMIC_ACQUIRE, "agent");
            asm volatile("s_waitcnt vmcnt(0)" ::: "memory");
        }
    }
    __syncthreads();
}

#define GRID_SYNC() xcd_barrier(xb)

__global__ void __launch_bounds__(256, 2) hymba_fwd(Params p) {
    __shared__ __attribute__((aligned(16))) unsigned char smem[73728];
    __shared__ int s_item;
    __shared__ unsigned xb_st[4];
    if (threadIdx.x < 4) xb_st[threadIdx.x] = 0u;
    __syncthreads();
    const XcdBarrier xb = xcd_barrier_post((unsigned*)p.ws, xb_st);
    unsigned char* ws = p.ws;
    const float* mod = (const float*)(ws + OFF_MOD);

    phase0(p, smem);
    GRID_SYNC();
    norm_mod_phase(p.x, p.ctx, (bf16_t*)(ws + OFF_A), p.g_norm1, mod, 0, 1, MROWS);
    cgu_phase(p);
    GRID_SYNC();
    phase_gemm_in(p, smem);
    GRID_SYNC();
    for (int t = blockIdx.x; t < NTASK; t += gridDim.x) hg_prep_task(p, t, smem);
    GRID_SYNC();
    if (blockIdx.x < 64) scan_block(p, blockIdx.x, smem);
    for (;;) {
        __syncthreads();
        if (threadIdx.x == 0) s_item = (int)atomicAdd((unsigned*)(ws + OFF_CNT), 1u);
        __syncthreads();
        const int item = s_item;
        if (item >= 1024) break;
        attn_item(p, item, smem);
    }
    GRID_SYNC();
    readout_phase(p);
    GRID_SYNC();
    phase_gemm_res<true>(p, (const bf16_t*)(ws + OFF_MIX), DM, (const bf16_t*)(ws + OFF_WOUT), DM, p.x, (float*)(ws + OFF_X1), 2, smem);
    GRID_SYNC();
    phase_gemm_gu(p, smem);
    GRID_SYNC();
    phase_gemm_res<false>(p, (const bf16_t*)(ws + OFF_ACT), DFF, (const bf16_t*)(ws + OFF_WDN), DFF, (const float*)(ws + OFF_X1), (float*)(ws + OFF_X1), 5, smem);
    GRID_SYNC();
    final_norm_phase(p);
}

extern "C" void kernel_launch(void* const* d_in, const int* in_sizes, int n_in, void* d_out, int out_size, void* d_ws, size_t ws_size, hipStream_t stream) {
    static int grid_blocks = 0;
    if (!grid_blocks) {
        int dev = 0, cus = 0, per_cu = 0;
        hipGetDevice(&dev);
        hipDeviceGetAttribute(&cus, hipDeviceAttributeMultiprocessorCount, dev);
        hipOccupancyMaxActiveBlocksPerMultiprocessor(&per_cu, hymba_fwd, 256, 0);
        if (per_cu > 2) per_cu = 2;
        if (per_cu < 1) per_cu = 1;
        grid_blocks = cus * per_cu;
    }
    if (ws_size < WS_NEED) { fprintf(stderr, "workspace too small: %zu < %zu\n", ws_size, (size_t)WS_NEED); return; }
    Params p{};
    p.x = (const float*)d_in[0]; p.c = (const float*)d_in[1]; p.ctx = (const float*)d_in[2]; p.c_ctx = (const float*)d_in[3];
    p.w_mod = (const float*)d_in[4]; p.b_mod = (const float*)d_in[5]; p.g_norm1 = (const float*)d_in[6]; p.w_in = (const float*)d_in[7];
    p.g_q = (const float*)d_in[8]; p.g_k = (const float*)d_in[9]; p.lb_raw = (const float*)d_in[10]; p.g_hg = (const float*)d_in[11];
    p.w_out = (const float*)d_in[12]; p.g_norm2 = (const float*)d_in[13]; p.w_gu = (const float*)d_in[14]; p.w_down = (const float*)d_in[15];
    p.g_final = (const float*)d_in[16];
    p.out = (float*)d_out; p.ws = (unsigned char*)d_ws;
    hipMemsetAsync(d_ws, 0, 32768, stream);
    void* args[] = {&p};
    hipError_t e = hipLaunchCooperativeKernel((void*)hymba_fwd, dim3(grid_blocks), dim3(256), args, 0, stream);
    if (e != hipSuccess) fprintf(stderr, "cooperative launch failed: %s (grid %d)\n", hipGetErrorString(e), grid_blocks);
}
```

```cpp
#include <hip/hip_runtime.h>
#include <hip/hip_cooperative_groups.h>
#include <cstdio>
#include <cstdint>
namespace cg = cooperative_groups;

#define DEVI __device__ __forceinline__
typedef unsigned short bf16_t;
typedef short bf16x8 __attribute__((ext_vector_type(8)));
typedef float f32x4 __attribute__((ext_vector_type(4)));
typedef unsigned u32x4 __attribute__((ext_vector_type(4)));
typedef unsigned u32x2 __attribute__((ext_vector_type(2)));

constexpr int DM = 1024, NB = 4, SEQ = 4096, CTX = 256, NLAT = NB * SEQ, NCTX = NB * CTX, MROWS = NLAT + NCTX;
constexpr int NKEY = CTX + SEQ;
constexpr int INC = 3328, DFF = 2816, NCH = NKEY / 64;
constexpr int NTASK = NB * 4 * 2 * NCH;
constexpr float EPS = 1e-6f;

constexpr size_t OFF_CNT = 16384;
constexpr size_t OFF_MOD = 32768;
constexpr size_t OFF_LB = OFF_MOD + 122880;
constexpr size_t OFF_WIN = OFF_LB + 4096;
constexpr size_t OFF_WOUT = OFF_WIN + 6815744;
constexpr size_t OFF_WGU = OFF_WOUT + 2097152;
constexpr size_t OFF_WDN = OFF_WGU + 11534336;
constexpr size_t OFF_A = OFF_WDN + 5767168;
constexpr size_t OFF_QATT = OFF_A + 35651584;
constexpr size_t OFF_KATT = OFF_QATT + 16777216;
constexpr size_t OFF_VATT = OFF_KATT + 4456448;
constexpr size_t OFF_QHG = OFF_VATT + 4456448;
constexpr size_t OFF_VHG = OFF_QHG + 17825792;
constexpr size_t OFF_LFC = OFF_VHG + 17825792;
constexpr size_t OFF_GHG = OFF_LFC + 4194304;
constexpr size_t OFF_KT = OFF_GHG + 16777216;
constexpr size_t OFF_AM = OFF_KT + 35651584;
constexpr size_t OFF_DV = OFF_AM + 17825792;
constexpr size_t OFF_MIX = OFF_DV + 3342336;
constexpr size_t OFF_END1 = OFF_MIX + 33554432;
constexpr size_t OFF_LF = OFF_MIX;
constexpr size_t OFF_OB = OFF_END1;
constexpr size_t OFF_END3 = OFF_OB + 33554432;
constexpr size_t OFF_RSS = OFF_END3;
constexpr size_t OFF_CGU = OFF_RSS + 65536;
static_assert(OFF_CGU + 90112 <= 268435456, "workspace over 256 MiB");
static_assert(OFF_LF + 67108864 <= 268435456 && OFF_END3 <= 268435456, "workspace over 256 MiB");
constexpr size_t OFF_X1 = OFF_QATT;
constexpr size_t OFF_ACT = OFF_X1 + 67108864;
constexpr size_t OFF_END2 = OFF_ACT + 92274688;
constexpr size_t WS_NEED = 268435456;
static_assert(WS_NEED <= 268435456, "workspace over 256 MiB");

struct Params {
    const float *x, *c, *ctx, *c_ctx, *w_mod, *b_mod, *g_norm1, *w_in, *g_q, *g_k, *lb_raw, *g_hg, *w_out, *g_norm2, *w_gu, *w_down, *g_final;
    float* out; unsigned char* ws;
};

DEVI unsigned pk_bf16(float lo, float hi) { unsigned r; asm("v_cvt_pk_bf16_f32 %0, %1, %2" : "=v"(r) : "v"(lo), "v"(hi)); return r; }
DEVI unsigned pk_bf16_t(float lo, float hi) { unsigned r; asm("s_nop 1\n\tv_cvt_pk_bf16_f32 %0, %1, %2" : "=v"(r) : "v"(lo), "v"(hi)); return r; }
DEVI unsigned pk_bf16_m(float lo, float hi) { unsigned r; asm("v_cvt_pk_bf16_f32 %0, %1, %2\n\ts_nop 1" : "=v"(r) : "v"(lo), "v"(hi)); return r; }
DEVI void mfma_settle() { asm volatile("s_nop 7\n\ts_nop 7" ::: "memory"); }
DEVI float bf2f(bf16_t h) { return __uint_as_float(((unsigned)h) << 16); }
DEVI float bflo(unsigned u) { return __uint_as_float(u << 16); }
DEVI float bfhi(unsigned u) { return __uint_as_float(u & 0xffff0000u); }
DEVI float siluf(float v) { return v * __builtin_amdgcn_rcpf(1.f + __expf(-v)); }
DEVI f32x4 mfma16(u32x4 a, u32x4 b, f32x4 c) {
    return __builtin_amdgcn_mfma_f32_16x16x32_bf16(__builtin_bit_cast(bf16x8, a), __builtin_bit_cast(bf16x8, b), c, 0, 0, 0);
}
DEVI int tidl() { int t = (int)threadIdx.x; asm volatile("" : "+v"(t)); return t; }
DEVI float wave_sum(float v) {
#pragma unroll
    for (int o = 1; o < 64; o <<= 1) v += __shfl_xor(v, o);
    return v;
}

DEVI void p0_transpose(const float* __restrict__ W, int ldw, bf16_t* __restrict__ Wt, int ldt, int k0, int n0, int gu, unsigned char* smem) {
    float* tile = (float*)smem;
    const int tid = tidl();
#pragma unroll
    for (int i = 0; i < 4; ++i) {
        const int kr = (tid >> 4) + 16 * i, nc = (tid & 15) * 4;
        const f32x4 v = *(const f32x4*)(W + (size_t)(k0 + kr) * ldw + n0 + nc);
        tile[kr * 65 + nc + 0] = v[0]; tile[kr * 65 + nc + 1] = v[1]; tile[kr * 65 + nc + 2] = v[2]; tile[kr * 65 + nc + 3] = v[3];
    }
    __syncthreads();
    const int nl = tid >> 2, kc = (tid & 3) * 16;
    unsigned w[8];
#pragma unroll
    for (int i = 0; i < 8; ++i) w[i] = pk_bf16(tile[(kc + 2 * i) * 65 + nl], tile[(kc + 2 * i + 1) * 65 + nl]);
    const int n = n0 + nl; int nrow = n;
    if (gu) { const int isB = n >= DFF; const int jj = isB ? n - DFF : n; nrow = (jj >> 4) * 32 + (jj & 15) + (isB ? 16 : 0); }
    u32x4* dst = (u32x4*)(Wt + (size_t)nrow * ldt + k0 + kc);
    dst[0] = (u32x4){w[0], w[1], w[2], w[3]}; dst[1] = (u32x4){w[4], w[5], w[6], w[7]};
    __syncthreads();
}

DEVI void p0_mod(const Params& p, int tsk, unsigned char* smem) {
    float* sc = (float*)smem;
    float* red = sc + 5 * 1024;
    float* mod = (float*)(p.ws + OFF_MOD);
    const int tid = tidl();
    for (int idx = tid; idx < 5120; idx += 256) { const int r = idx >> 10, k = idx & 1023; const float v = r < 4 ? p.c[r * 1024 + k] : p.c_ctx[k]; sc[idx] = siluf(v); }
    __syncthreads();
    const int cl = tid & 31, kp = tid >> 5, col = tsk * 32 + cl;
    float a0 = 0.f, a1 = 0.f, a2 = 0.f, a3 = 0.f, a4 = 0.f;
#pragma unroll 16
    for (int k = kp * 128; k < kp * 128 + 128; ++k) {
        const float w = p.w_mod[(size_t)k * 6144 + col];
        a0 += sc[k] * w; a1 += sc[1024 + k] * w; a2 += sc[2048 + k] * w; a3 += sc[3072 + k] * w; a4 += sc[4096 + k] * w;
    }
    red[(kp * 5 + 0) * 32 + cl] = a0; red[(kp * 5 + 1) * 32 + cl] = a1; red[(kp * 5 + 2) * 32 + cl] = a2; red[(kp * 5 + 3) * 32 + cl] = a3; red[(kp * 5 + 4) * 32 + cl] = a4;
    __syncthreads();
    if (tid < 160) { const int r = tid >> 5, c2 = tid & 31; float s = 0.f;
#pragma unroll
        for (int q = 0; q < 8; ++q) s += red[(q * 5 + r) * 32 + c2];
        mod[r * 6144 + tsk * 32 + c2] = s + p.b_mod[tsk * 32 + c2]; }
    __syncthreads();
}

DEVI void phase0(const Params& p, unsigned char* smem) {
    constexpr int T_MOD = 192, T_IN = 16 * 52, T_OUT = 16 * 16, T_GU = 16 * 88, T_DN = 44 * 16;
    constexpr int E0 = T_MOD + 1, E1 = E0 + T_IN, E2 = E1 + T_OUT, E3 = E2 + T_GU, E4 = E3 + T_DN;
    for (int t = blockIdx.x; t < E4; t += gridDim.x) {
        if (t < T_MOD) { p0_mod(p, t, smem); }
        else if (t == T_MOD) {
            float* lb = (float*)(p.ws + OFF_LB);
            for (int i = tidl(); i < 1024; i += 256) lb[i] = 1.f / (1.f + __expf(p.lb_raw[1024 + i] - p.lb_raw[i]));
            float* rss = (float*)(p.ws + OFF_RSS);
            for (int i = tidl(); i < NLAT; i += 256) rss[i] = 0.f;
        }
        else if (t < E1) { const int u = t - E0, kt = u / 52, nt = u % 52; p0_transpose(p.w_in, INC, (bf16_t*)(p.ws + OFF_WIN), 1024, kt * 64, nt * 64, 0, smem); }
        else if (t < E2) { const int u = t - E1, kt = u / 16, nt = u % 16; p0_transpose(p.w_out, 1024, (bf16_t*)(p.ws + OFF_WOUT), 1024, kt * 64, nt * 64, 0, smem); }
        else if (t < E3) { const int u = t - E2, kt = u / 88, nt = u % 88; p0_transpose(p.w_gu, 2 * DFF, (bf16_t*)(p.ws + OFF_WGU), 1024, kt * 64, nt * 64, 1, smem); }
        else { const int u = t - E3, kt = u / 16, nt = u % 16; p0_transpose(p.w_down, 1024, (bf16_t*)(p.ws + OFF_WDN), DFF, kt * 64, nt * 64, 0, smem); }
    }
}

DEVI void norm_mod_phase(const float* __restrict__ src_lat, const float* __restrict__ src_ctx, bf16_t* __restrict__ dst, const float* __restrict__ g,
                         const float* __restrict__ mod, int shift_idx, int scale_idx, int nrows) {
    const int lane = tidl() & 63, wid = tidl() >> 6;
    for (int t = blockIdx.x; t * 4 < nrows; t += gridDim.x) {
        const int row = t * 4 + wid;
        const float* src = row < NLAT ? src_lat + (size_t)row * DM : src_ctx + (size_t)(row - NLAT) * DM;
        const int mrow = row < NLAT ? (row >> 12) : 4;
        f32x4 v[4]; float ss = 0.f;
#pragma unroll
        for (int i = 0; i < 4; ++i) { v[i] = *(const f32x4*)(src + lane * 4 + 256 * i); ss += v[i][0] * v[i][0] + v[i][1] * v[i][1] + v[i][2] * v[i][2] + v[i][3] * v[i][3]; }
        ss = wave_sum(ss);
        const float rstd = rsqrtf(ss * (1.f / DM) + EPS);
#pragma unroll
        for (int i = 0; i < 4; ++i) {
            const int col = lane * 4 + 256 * i;
            const f32x4 gg = *(const f32x4*)(g + col), sh = *(const f32x4*)(mod + mrow * 6144 + shift_idx * 1024 + col), sc = *(const f32x4*)(mod + mrow * 6144 + scale_idx * 1024 + col);
            f32x4 h;
#pragma unroll
            for (int j = 0; j < 4; ++j) h[j] = v[i][j] * rstd * gg[j] * (1.f + sc[j]) + sh[j];
            *(u32x2*)(dst + (size_t)row * DM + col) = (u32x2){pk_bf16(h[0], h[1]), pk_bf16(h[2], h[3])};
        }
    }
}


DEVI void cgu_phase(const Params& p) {
    const int lane = tidl() & 63, wid = tidl() >> 6;
    const float* mod = (const float*)(p.ws + OFF_MOD);
    const bf16_t* W = (const bf16_t*)(p.ws + OFF_WGU);
    float* cgu = (float*)(p.ws + OFF_CGU);
    for (int t = blockIdx.x; t * 4 < 2 * DFF; t += gridDim.x) {
        const int n = t * 4 + wid;
        const u32x4 w0 = *(const u32x4*)(W + (size_t)n * DM + lane * 16), w1 = *(const u32x4*)(W + (size_t)n * DM + lane * 16 + 8);
        float wv[16] = {bflo(w0.x), bfhi(w0.x), bflo(w0.y), bfhi(w0.y), bflo(w0.z), bfhi(w0.z), bflo(w0.w), bfhi(w0.w),
                        bflo(w1.x), bfhi(w1.x), bflo(w1.y), bfhi(w1.y), bflo(w1.z), bfhi(w1.z), bflo(w1.w), bfhi(w1.w)};
#pragma unroll
        for (int b = 0; b < 4; ++b) {
            const float* sh = mod + b * 6144 + 3 * 1024 + lane * 16;
            float s = 0.f;
#pragma unroll
            for (int q = 0; q < 4; ++q) { const f32x4 sv = *(const f32x4*)(sh + 4 * q); s += sv[0] * wv[4 * q] + sv[1] * wv[4 * q + 1] + sv[2] * wv[4 * q + 2] + sv[3] * wv[4 * q + 3]; }
            s = wave_sum(s);
            if (lane == 0) cgu[b * 2 * DFF + n] = s;
        }
    }
}

#define LDSP __attribute__((address_space(3)))
#define GLBP __attribute__((address_space(1)))
DEVI void glds16(const void* g, unsigned char* l) {
    __builtin_amdgcn_global_load_lds((const GLBP void*)g, (LDSP void*)l, 16, 0, 0);
}
struct GTile2 { const bf16_t* ga; const bf16_t* gb; };
DEVI GTile2 gemm2_src(const bf16_t* A, int lda, const bf16_t* Bt, int ldb, int row0, int col0) {
    const int tid = tidl(), sr = tid >> 2, scn = (tid & 3) ^ ((tid >> 4) & 3);
    GTile2 t; t.ga = A + (size_t)(row0 + sr) * lda + scn * 8; t.gb = Bt + (size_t)(col0 + sr) * ldb + scn * 8; return t;
}
#define G2_ISSUE_T(T, kt_, slot_) { unsigned char* sb_ = smem + (slot_) * 24576 + st_off; const int ko_ = (kt_) * 32; \
        glds16(T.ga + ko_, sb_); glds16(T.ga + a64 + ko_, sb_ + 4096); glds16(T.ga + 2 * a64 + ko_, sb_ + 8192); glds16(T.ga + 3 * a64 + ko_, sb_ + 12288); \
        glds16(T.gb + ko_, sb_ + 16384); glds16(T.gb + b64 + ko_, sb_ + 20480); }
DEVI int mod3(int v) { return v >= 6 ? v - 6 : (v >= 3 ? v - 3 : v); }
DEVI void gemm2_tile(const GTile2 cur, const GTile2 nxt, const bool has_next, const bool first, int& g0, int lda, int ldb, int K, unsigned char* smem,
                     f32x4 (&accL)[4][4], f32x4 (&accH)[4][4]) {
    const int tid = tidl(), lane = tid & 63, wid = tid >> 6, wr = wid >> 1, wc = wid & 1, fr = lane & 15, fq = lane >> 4;
    const size_t a64 = (size_t)64 * lda, b64 = (size_t)64 * ldb;
    const int st_off = tid * 16;
    const int sw = (fr >> 2) & 3;
    const unsigned lds0 = (unsigned)(size_t)((LDSP unsigned char*)smem);
    const unsigned a_rd = lds0 + (wr * 128 + fr) * 64 + ((fq ^ sw) << 4);
    const unsigned b_rd = lds0 + 16384 + (wc * 64 + fr) * 64 + ((fq ^ sw) << 4);
#pragma unroll
    for (int m = 0; m < 4; ++m)
#pragma unroll
        for (int n = 0; n < 4; ++n) { accL[m][n] = (f32x4){0.f, 0.f, 0.f, 0.f}; accH[m][n] = (f32x4){0.f, 0.f, 0.f, 0.f}; }
    const int nk = K >> 5;
    if (first) {
        asm volatile("s_waitcnt vmcnt(0)" ::: "memory");
        __builtin_amdgcn_s_barrier();
        G2_ISSUE_T(cur, 0, mod3(g0)) G2_ISSUE_T(cur, 1, mod3(g0 + 1))
    }
    int slot = mod3(g0);
    for (int s = 0; s < nk; ++s) {
        if (has_next || s + 1 < nk) asm volatile("s_waitcnt vmcnt(6)" ::: "memory");
        else asm volatile("s_waitcnt vmcnt(0)" ::: "memory");
        __builtin_amdgcn_s_barrier();
        { const int s2 = s + 2; const int sl2 = mod3(slot + 2);
          if (s2 < nk) G2_ISSUE_T(cur, s2, sl2) else if (has_next) G2_ISSUE_T(nxt, s2 - nk, sl2) }
        const unsigned sa = a_rd + slot * 24576, sb = b_rd + slot * 24576;
        u32x4 a0, a1, a2, a3, a4, a5, a6, a7, b0, b1, b2, b3;
        asm volatile("ds_read_b128 %0, %1" : "=v"(a0) : "v"(sa)); asm volatile("ds_read_b128 %0, %1 offset:1024" : "=v"(a1) : "v"(sa));
        asm volatile("ds_read_b128 %0, %1 offset:2048" : "=v"(a2) : "v"(sa)); asm volatile("ds_read_b128 %0, %1 offset:3072" : "=v"(a3) : "v"(sa));
        asm volatile("ds_read_b128 %0, %1" : "=v"(b0) : "v"(sb)); asm volatile("ds_read_b128 %0, %1 offset:1024" : "=v"(b1) : "v"(sb));
        asm volatile("ds_read_b128 %0, %1 offset:2048" : "=v"(b2) : "v"(sb)); asm volatile("ds_read_b128 %0, %1 offset:3072" : "=v"(b3) : "v"(sb));
        asm volatile("ds_read_b128 %0, %1 offset:4096" : "=v"(a4) : "v"(sa)); asm volatile("ds_read_b128 %0, %1 offset:5120" : "=v"(a5) : "v"(sa));
        asm volatile("ds_read_b128 %0, %1 offset:6144" : "=v"(a6) : "v"(sa)); asm volatile("ds_read_b128 %0, %1 offset:7168" : "=v"(a7) : "v"(sa));
        asm volatile("s_waitcnt lgkmcnt(4)" : "+v"(a0), "+v"(a1), "+v"(a2), "+v"(a3), "+v"(b0), "+v"(b1), "+v"(b2), "+v"(b3));
        accL[0][0] = mfma16(b0, a0, accL[0][0]); accL[0][1] = mfma16(b1, a0, accL[0][1]); accL[0][2] = mfma16(b2, a0, accL[0][2]); accL[0][3] = mfma16(b3, a0, accL[0][3]);
        accL[1][0] = mfma16(b0, a1, accL[1][0]); accL[1][1] = mfma16(b1, a1, accL[1][1]); accL[1][2] = mfma16(b2, a1, accL[1][2]); accL[1][3] = mfma16(b3, a1, accL[1][3]);
        accL[2][0] = mfma16(b0, a2, accL[2][0]); accL[2][1] = mfma16(b1, a2, accL[2][1]); accL[2][2] = mfma16(b2, a2, accL[2][2]); accL[2][3] = mfma16(b3, a2, accL[2][3]);
        accL[3][0] = mfma16(b0, a3, accL[3][0]); accL[3][1] = mfma16(b1, a3, accL[3][1]); accL[3][2] = mfma16(b2, a3, accL[3][2]); accL[3][3] = mfma16(b3, a3, accL[3][3]);
        asm volatile("s_waitcnt lgkmcnt(0)" : "+v"(a4), "+v"(a5), "+v"(a6), "+v"(a7), "+v"(b0), "+v"(b1), "+v"(b2), "+v"(b3));
        accH[0][0] = mfma16(b0, a4, accH[0][0]); accH[0][1] = mfma16(b1, a4, accH[0][1]); accH[0][2] = mfma16(b2, a4, accH[0][2]); accH[0][3] = mfma16(b3, a4, accH[0][3]);
        accH[1][0] = mfma16(b0, a5, accH[1][0]); accH[1][1] = mfma16(b1, a5, accH[1][1]); accH[1][2] = mfma16(b2, a5, accH[1][2]); accH[1][3] = mfma16(b3, a5, accH[1][3]);
        accH[2][0] = mfma16(b0, a6, accH[2][0]); accH[2][1] = mfma16(b1, a6, accH[2][1]); accH[2][2] = mfma16(b2, a6, accH[2][2]); accH[2][3] = mfma16(b3, a6, accH[2][3]);
        accH[3][0] = mfma16(b0, a7, accH[3][0]); accH[3][1] = mfma16(b1, a7, accH[3][1]); accH[3][2] = mfma16(b2, a7, accH[3][2]); accH[3][3] = mfma16(b3, a7, accH[3][3]);
        slot = mod3(slot + 1);
    }
    g0 = slot;
}
DEVI bool xcd_tile2(int j, int NT, bool ctx, int& mt, int& nt) {
    const int x = blockIdx.x & 7, band = 8 * NT;
    if (j < band) { nt = j >> 3; mt = 8 * x + (j & 7); return true; }
    const int u = j - band;
    if (ctx && u < 9) { const int w = x * 9 + u; mt = 64 + w / 18; nt = 4 + w % 18; return true; }
    mt = 0; nt = 0; return false;
}

DEVI void epi_in(const Params& p, int mt, int nt, int wr, const f32x4 (&acc)[4][4]) {
    const int lane = tidl() & 63, wid = tidl() >> 6, wc = wid & 1, fr = lane & 15, fq = lane >> 4;
    const int row0 = mt * 128 + wr * 64 + fr;
    const bool lat = mt < 128;
    const int b = lat ? (mt >> 5) : ((mt - 128) >> 1);
    const int ntok0 = lat ? (CTX + ((mt & 31) * 128 + wr * 64 + fr)) : (((mt - 128) & 1) * 128 + wr * 64 + fr);
    unsigned char* ws = p.ws;
    if (nt < 5) {
        const bool isq = nt < 4;
        const float* gg = isq ? p.g_q : p.g_k;
        f32x4 gv[4];
#pragma unroll
        for (int n = 0; n < 4; ++n) gv[n] = *(const f32x4*)(gg + 16 * n + 4 * fq);
        float inv[4];
#pragma unroll
        for (int j = 0; j < 4; ++j) inv[j] = exp2f(-(float)(4 * fq + j) * (13.287712379549449f / 16.f));
        const float osc = isq ? 0.125f * 1.4426950408889634f : 1.f;
#pragma unroll
        for (int m = 0; m < 4; ++m) {
            float ss = 0.f;
#pragma unroll
            for (int n = 0; n < 4; ++n) ss += acc[m][n][0] * acc[m][n][0] + acc[m][n][1] * acc[m][n][1] + acc[m][n][2] * acc[m][n][2] + acc[m][n][3] * acc[m][n][3];
            ss += __shfl_xor(ss, 16); ss += __shfl_xor(ss, 32);
            const float rstd = rsqrtf(ss * (1.f / 64.f) + EPS);
            f32x4 v[4];
#pragma unroll
            for (int n = 0; n < 4; ++n) v[n] = acc[m][n] * rstd * gv[n];
            if (lat) {
                const int t = (mt & 31) * 128 + wr * 64 + fr + 16 * m;
                const float pr = (float)(t >> 6), pc = (float)(t & 63);
#pragma unroll
                for (int a = 0; a < 2; ++a) {
                    const float pos = a == 0 ? pr : pc;
#pragma unroll
                    for (int j = 0; j < 4; ++j) {
                        const float ang = pos * inv[j]; const float cs = __cosf(ang), sn = __sinf(ang);
                        const float x0 = v[2 * a][j], x1 = v[2 * a + 1][j];
                        v[2 * a][j] = x0 * cs - x1 * sn; v[2 * a + 1][j] = x1 * cs + x0 * sn;
                    }
                }
            }
            bf16_t* dst;
            if (isq) dst = (bf16_t*)(ws + OFF_QATT) + (size_t)(row0 + 16 * m) * 512 + (nt * 2 + wc) * 64 + 4 * fq;
            else dst = (bf16_t*)(ws + OFF_KATT) + ((size_t)(b * 2 + wc) * NKEY + ntok0 + 16 * m) * 64 + 4 * fq;
#pragma unroll
            for (int n = 0; n < 4; ++n) *(u32x2*)(dst + 16 * n) = (u32x2){pk_bf16(v[n][0] * osc, v[n][1] * osc), pk_bf16(v[n][2] * osc, v[n][3] * osc)};
        }
    } else if (nt == 5) {
        mfma_settle();
        bf16_t* base = (bf16_t*)(ws + OFF_VATT) + (size_t)(b * 2 + wc) * 64 * NKEY;
#pragma unroll
        for (int m = 0; m < 4; ++m)
#pragma unroll
            for (int n = 0; n < 4; ++n)
#pragma unroll
                for (int j = 0; j < 4; ++j) base[(size_t)(16 * n + 4 * fq + j) * NKEY + ntok0 + 16 * m] = (bf16_t)(pk_bf16(acc[m][n][j], 0.f) & 0xffffu);
    } else if (nt < 10) {
        const int cl = (nt - 6) * 128 + wc * 64 + 4 * fq;
#pragma unroll
        for (int m = 0; m < 4; ++m) {
            bf16_t* dst = (bf16_t*)(ws + OFF_QHG) + (size_t)(row0 + 16 * m) * 512 + cl;
#pragma unroll
            for (int n = 0; n < 4; ++n) {
                const float s = 0.08838834764831845f;
                *(u32x2*)(dst + 16 * n) = (u32x2){pk_bf16(siluf(acc[m][n][0]) * s, siluf(acc[m][n][1]) * s), pk_bf16(siluf(acc[m][n][2]) * s, siluf(acc[m][n][3]) * s)};
            }
        }
    } else if (nt < 14) {
        mfma_settle();
        const int h = nt - 10;
        bf16_t* base = (bf16_t*)(ws + OFF_VHG) + (size_t)((b * 4 + h) * 128 + wc * 64) * NKEY;
#pragma unroll
        for (int m = 0; m < 4; ++m)
#pragma unroll
            for (int n = 0; n < 4; ++n)
#pragma unroll
                for (int j = 0; j < 4; ++j) base[(size_t)(16 * n + 4 * fq + j) * NKEY + ntok0 + 16 * m] = (bf16_t)(pk_bf16(acc[m][n][j], 0.f) & 0xffffu);
    } else if (nt < 22) {
        const int cl = (nt - 14) * 128 + wc * 64 + 4 * fq;
        const float* lb = (const float*)(ws + OFF_LB);
        f32x4 lbv[4], qs[4];
#pragma unroll
        for (int n = 0; n < 4; ++n) {
            lbv[n] = *(const f32x4*)(lb + cl + 16 * n);
#pragma unroll
            for (int j = 0; j < 4; ++j) qs[n][j] = 65535.f * __builtin_amdgcn_rcpf(__logf(lbv[n][j]));
        }
#pragma unroll
        for (int m = 0; m < 4; ++m) {
            bf16_t* dst = lat ? (bf16_t*)(ws + OFF_LF) + (size_t)(row0 + 16 * m) * 1024 + cl : (bf16_t*)(ws + OFF_LFC) + (size_t)(row0 + 16 * m - NLAT) * 1024 + cl;
#pragma unroll
            for (int n = 0; n < 4; ++n) {
                unsigned q[4];
#pragma unroll
                for (int j = 0; j < 4; ++j) {
                    const float sg = __builtin_amdgcn_rcpf(1.f + __expf(-acc[m][n][j]));
                    const float lf = __logf(lbv[n][j] + (1.f - lbv[n][j]) * sg);
                    q[j] = (unsigned)fminf(fmaxf(lf * qs[n][j] + 0.5f, 0.f), 65535.f);
                }
                *(u32x2*)(dst + 16 * n) = (u32x2){q[0] | (q[1] << 16), q[2] | (q[3] << 16)};
            }
        }
    } else {
        const int cl = (nt - 22) * 128 + wc * 64 + 4 * fq;
#pragma unroll
        for (int m = 0; m < 4; ++m) {
            bf16_t* dst = (bf16_t*)(ws + OFF_GHG) + (size_t)(row0 + 16 * m) * 512 + cl;
#pragma unroll
            for (int n = 0; n < 4; ++n)
                *(u32x2*)(dst + 16 * n) = (u32x2){pk_bf16(siluf(acc[m][n][0]), siluf(acc[m][n][1])), pk_bf16(siluf(acc[m][n][2]), siluf(acc[m][n][3]))};
        }
    }
}

DEVI void phase_gemm_in(const Params& p, unsigned char* smem) {
    const bf16_t* A = (const bf16_t*)(p.ws + OFF_A);
    const bf16_t* Bt = (const bf16_t*)(p.ws + OFF_WIN);
    bool first = true; int g0 = 0;
    const int nbx = gridDim.x >> 3, wr = tidl() >> 7;
    for (int j = blockIdx.x >> 3; ; j += nbx) {
        int mt, nt, mtn, ntn;
        if (!xcd_tile2(j, 26, true, mt, nt)) break;
        const bool has_next = xcd_tile2(j + nbx, 26, true, mtn, ntn);
        f32x4 accL[4][4], accH[4][4];
        gemm2_tile(gemm2_src(A, DM, Bt, DM, mt * 256, nt * 128), gemm2_src(A, DM, Bt, DM, mtn * 256, ntn * 128), has_next, first, g0, DM, DM, DM, smem, accL, accH);
        first = false;
        epi_in(p, 2 * mt + wr, nt, 0, accL);
        epi_in(p, 2 * mt + wr, nt, 1, accH);
    }
}

DEVI void hg_prep_task(const Params& p, int tk, unsigned char* smem) {
    const int c = tk % NCH, dir = (tk / NCH) & 1, bh = tk / (2 * NCH), h = bh & 3, b = bh >> 2;
    const int tid = tidl(), k = tid & 127, hf = tid >> 7;
    unsigned char* ws = p.ws;
    bf16_t* sQ = (bf16_t*)smem;
    bf16_t* sK = (bf16_t*)(smem + 17408);
    float* tot = (float*)(smem + 34816);
    const bool lat = c >= 4;
    const int rowbase = lat ? (b * SEQ + (c - 4) * 64) : (NLAT + b * CTX + c * 64);
    const bf16_t* lfp = lat ? (const bf16_t*)(ws + OFF_LF) + (size_t)rowbase * 1024 + dir * 512 + h * 128 + k
                            : (const bf16_t*)(ws + OFF_LFC) + (size_t)(rowbase - NLAT) * 1024 + dir * 512 + h * 128 + k;
    const float lfs = __logf(((const float*)(ws + OFF_LB))[dir * 512 + h * 128 + k]) * (1.f / 65535.f);
    const bf16_t* qp = (const bf16_t*)(ws + OFF_QHG) + (size_t)rowbase * 512 + h * 128 + k;
    float tsum = 0.f;
#pragma unroll
    for (int i = 0; i < 32; ++i) tsum += (float)lfp[(size_t)(hf * 32 + i) * 1024] * lfs;
    tot[hf * 128 + k] = tsum;
    __syncthreads();
    const float t0 = tot[k], t1 = tot[128 + k];
    const float r = dir == 0 ? t0 : t1, blast = t0 + t1;
    const float addv = (dir == 0) ? (hf == 1 ? t0 : 0.f) : (hf == 0 ? t1 : 0.f);
    bf16_t* Qg = (bf16_t*)(ws + OFF_A) + (size_t)tk * 8192;
    float run = addv - r;
    u32x4* kd = (u32x4*)((bf16_t*)(ws + OFF_KT) + (size_t)tk * 8192 + k * 64 + hf * 32);
#pragma unroll 1
    for (int gg = 0; gg < 4; ++gg) {
        const int g = dir == 0 ? gg : 3 - gg;
        unsigned kw4[4];
#pragma unroll
        for (int jj = 0; jj < 4; ++jj) {
            const int ii = dir == 0 ? jj : 3 - jj;
            const int i = g * 8 + 2 * ii;
            const float l0 = (float)lfp[(size_t)(hf * 32 + i) * 1024] * lfs, l1 = (float)lfp[(size_t)(hf * 32 + i + 1) * 1024] * lfs;
            float b0, b1;
            if (dir == 0) { b0 = run + l0; b1 = b0 + l1; run = b1; } else { b1 = run + l1; b0 = b1 + l0; run = b0; }
            const float q0 = bf2f(qp[(size_t)(hf * 32 + i) * 512]), q1 = bf2f(qp[(size_t)(hf * 32 + i + 1) * 512]);
            const unsigned qq = pk_bf16(q0 * __expf(b0), q1 * __expf(b1));
            const unsigned kq = pk_bf16((1.f - __expf(l0)) * __expf(-b0), (1.f - __expf(l1)) * __expf(-b1));
            if (dir == 0) kw4[jj] = kq; else kw4[3 - jj] = kq;
            const int tok = hf * 32 + i;
            sQ[tok * 136 + k] = (bf16_t)(qq & 0xffffu); sQ[(tok + 1) * 136 + k] = (bf16_t)(qq >> 16);
            sK[tok * 136 + k] = (bf16_t)(kq & 0xffffu); sK[(tok + 1) * 136 + k] = (bf16_t)(kq >> 16);
        }
        kd[g] = (u32x4){kw4[0], kw4[1], kw4[2], kw4[3]};
    }
    if (hf == 0) {
        float* dv = (float*)(ws + OFF_DV) + (size_t)tk * 384;
        dv[k] = __expf(r); dv[128 + k] = __expf(blast - r); dv[256 + k] = __expf(blast);
    }
    __syncthreads();
#pragma unroll
    for (int j = 0; j < 4; ++j) { const int idx = tid + 256 * j, rq = idx >> 4, cq = idx & 15; *(u32x4*)(Qg + rq * 128 + cq * 8) = *(const u32x4*)(smem + rq * 272 + cq * 16); }
    const int lane = tid & 63, w = tid >> 6, fr = lane & 15, fq = lane >> 4;
    f32x4 a[4];
#pragma unroll
    for (int sn = 0; sn < 4; ++sn) a[sn] = (f32x4){0.f, 0.f, 0.f, 0.f};
#pragma unroll
    for (int kk = 0; kk < 4; ++kk) {
        const u32x4 qf = *(const u32x4*)(smem + (16 * w + fr) * 272 + (32 * kk + 8 * fq) * 2);
#pragma unroll
        for (int sn = 0; sn < 4; ++sn) {
            const u32x4 kf = *(const u32x4*)(smem + 17408 + (16 * sn + fr) * 272 + (32 * kk + 8 * fq) * 2);
            a[sn] = mfma16(kf, qf, a[sn]);
        }
    }
    bf16_t* Ag = (bf16_t*)(ws + OFF_AM) + (size_t)tk * 4096;
    const int t = 16 * w + fr;
#pragma unroll
    for (int sn = 0; sn < 4; ++sn) {
        float o[4];
#pragma unroll
        for (int j = 0; j < 4; ++j) { const int s = 16 * sn + 4 * fq + j; const bool keep = dir == 0 ? (s <= t) : (s >= t); o[j] = keep ? a[sn][j] : 0.f; }
        *(u32x2*)(Ag + t * 64 + 16 * sn + 4 * fq) = (u32x2){pk_bf16(o[0], o[1]), pk_bf16(o[2], o[3])};
    }
    __syncthreads();
}

constexpr int SC_KT = 0, SC_QT = 16384, SC_DV = 16384 + 17408, SC_BUF = 16384 + 17408 + 1536;
DEVI int scan_chunk(int dir, int i) { return dir == 0 ? i : (i < 4 ? 3 - i : 71 - i); }
DEVI void scan_block(const Params& p, int blk, unsigned char* smem) {
    const int tid = tidl(), lane = tid & 63, wid = tid >> 6, fr = lane & 15, fq = lane >> 4;
    const int vs = (blk & 1) * 4 + wid, dir = (blk >> 1) & 1, h = (blk >> 2) & 3, b = blk >> 4;
    unsigned char* ws = p.ws;
    const unsigned char* Qt = ws + OFF_A;
    const unsigned char* KtT = ws + OFF_KT;
    const bf16_t* Am = (const bf16_t*)(ws + OFF_AM);
    const unsigned char* dvb = ws + OFF_DV;
    bf16_t* obuf = (bf16_t*)(ws + OFF_OB) + (dir ? (size_t)NLAT * 512 : 0);
    const bf16_t* vrow = (const bf16_t*)(ws + OFF_VHG) + (size_t)((b * 4 + h) * 128 + vs * 16 + fr) * NKEY;
    const int tk0 = ((b * 4 + h) * 2 + dir) * NCH;
    int kt_dst[4], qt_dst[4];
#pragma unroll
    for (int j = 0; j < 4; ++j) {
        const int idx = tid + 256 * j;
        const int rk = idx >> 3, ck = idx & 7; kt_dst[j] = SC_KT + rk * 128 + ((ck ^ ((rk >> 1) & 7)) << 4);
        const int rq = idx >> 4, cq = idx & 15; qt_dst[j] = SC_QT + rq * 272 + cq * 16;
    }
    const int sw = (fr >> 1) & 7;
    const int kt_rd = SC_KT + fr * 128 + ((fq ^ sw) << 4);
    const int qt_rd = SC_QT + fr * 272 + 8 * fq;
    f32x4 S[8];
#pragma unroll
    for (int m = 0; m < 8; ++m) S[m] = (f32x4){0.f, 0.f, 0.f, 0.f};
    u32x4 stK[4], stQ[4], stD, vN[2], aC[8], vC[2];
    unsigned dummy = 0u;
    {
        const int c = scan_chunk(dir, 0); const size_t tk = tk0 + c;
#pragma unroll
        for (int j = 0; j < 4; ++j) { stK[j] = *(const u32x4*)(KtT + tk * 16384 + (tid + 256 * j) * 16); stQ[j] = *(const u32x4*)(Qt + tk * 16384 + (tid + 256 * j) * 16); }
        stD = (tid < 96) ? *(const u32x4*)(dvb + tk * 1536 + tid * 16) : (u32x4){0u, 0u, 0u, 0u};
        vC[0] = *(const u32x4*)(vrow + 64 * c + 8 * fq); vC[1] = *(const u32x4*)(vrow + 64 * c + 32 + 8 * fq);
#pragma unroll
        for (int q = 0; q < 8; ++q) aC[q] = *(const u32x4*)(Am + tk * 4096 + (16 * (q >> 1) + fr) * 64 + 32 * (q & 1) + 8 * fq);
#pragma unroll
        for (int j = 0; j < 4; ++j) { *(u32x4*)(smem + kt_dst[j]) = stK[j]; *(u32x4*)(smem + qt_dst[j]) = stQ[j]; }
        if (tid < 96) *(u32x4*)(smem + SC_DV + tid * 16) = stD;
        __syncthreads();
    }
#pragma unroll 1
    for (int i = 0; i < NCH; ++i) {
        const int c = scan_chunk(dir, i);
        const unsigned char* buf = smem + (i & 1) * SC_BUF;
        const int cn = scan_chunk(dir, i + 1 < NCH ? i + 1 : NCH - 1);
        const int c3 = scan_chunk(dir, i + 3 < NCH ? i + 3 : NCH - 1);
        const size_t tkn = tk0 + cn, tk3 = tk0 + c3;
#pragma unroll
        for (int j = 0; j < 4; ++j) { stK[j] = *(const u32x4*)(KtT + tkn * 16384 + (tid + 256 * j) * 16); stQ[j] = *(const u32x4*)(Qt + tkn * 16384 + (tid + 256 * j) * 16); }
        stD = *(const u32x4*)(dvb + tkn * 1536 + (tid < 96 ? tid : 0) * 16);
        vN[0] = *(const u32x4*)(vrow + 64 * cn + 8 * fq); vN[1] = *(const u32x4*)(vrow + 64 * cn + 32 + 8 * fq);
        const unsigned t0 = *(const unsigned*)((tid < 128 ? Qt : KtT) + tk3 * 16384 + (tid & 127) * 128);
        const unsigned t1 = *(const unsigned*)((const unsigned char*)Am + tk3 * 8192 + (tid & 63) * 128);
        const unsigned t2 = *(const unsigned*)(vrow + 64 * c3);
        f32x4 o[4];
#pragma unroll
        for (int nt = 0; nt < 4; ++nt) o[nt] = (f32x4){0.f, 0.f, 0.f, 0.f};
#pragma unroll
        for (int nt = 0; nt < 4; ++nt) { o[nt] = mfma16(vC[0], aC[2 * nt], o[nt]); o[nt] = mfma16(vC[1], aC[2 * nt + 1], o[nt]); }
        __builtin_amdgcn_sched_barrier(0);
#pragma unroll
        for (int q = 0; q < 8; ++q) aC[q] = *(const u32x4*)(Am + tkn * 4096 + (16 * (q >> 1) + fr) * 64 + 32 * (q & 1) + 8 * fq);
#pragma unroll
        for (int kk = 0; kk < 4; ++kk) {
            const f32x4 da = *(const f32x4*)(buf + SC_DV + (32 * kk + 4 * fq) * 4), db = *(const f32x4*)(buf + SC_DV + (32 * kk + 16 + 4 * fq) * 4);
            const u32x4 sf = (u32x4){pk_bf16_m(S[2 * kk][0] * da[0], S[2 * kk][1] * da[1]), pk_bf16_m(S[2 * kk][2] * da[2], S[2 * kk][3] * da[3]),
                                     pk_bf16_m(S[2 * kk + 1][0] * db[0], S[2 * kk + 1][1] * db[1]), pk_bf16_m(S[2 * kk + 1][2] * db[2], S[2 * kk + 1][3] * db[3])};
#pragma unroll
            for (int nt = 0; nt < 4; ++nt) {
                const u32x2 qa = *(const u32x2*)(buf + qt_rd + nt * 4352 + 64 * kk), qb = *(const u32x2*)(buf + qt_rd + nt * 4352 + 64 * kk + 32);
                o[nt] = mfma16(sf, (u32x4){qa.x, qa.y, qb.x, qb.y}, o[nt]);
            }
        }
        if (c >= 4) {
            mfma_settle();
            bf16_t* od = obuf + (size_t)(b * SEQ + (c - 4) * 64 + fr) * 512 + h * 128 + vs * 16 + 4 * fq;
#pragma unroll
            for (int nt = 0; nt < 4; ++nt) *(u32x2*)(od + (size_t)(16 * nt) * 512) = (u32x2){pk_bf16(o[nt][0], o[nt][1]), pk_bf16(o[nt][2], o[nt][3])};
        }
        __builtin_amdgcn_sched_barrier(0);
#pragma unroll
        for (int mt = 0; mt < 8; ++mt) {
            f32x4 u = (f32x4){0.f, 0.f, 0.f, 0.f};
#pragma unroll
            for (int kk = 0; kk < 2; ++kk) { const u32x4 kf = *(const u32x4*)(buf + ((kt_rd + mt * 2048) ^ (kk << 6))); u = mfma16(kf, vC[kk], u); }
            const f32x4 d2 = *(const f32x4*)(buf + SC_DV + (128 + 16 * mt + 4 * fq) * 4), d3 = *(const f32x4*)(buf + SC_DV + (256 + 16 * mt + 4 * fq) * 4);
            S[mt] = d3 * S[mt] + d2 * u;
        }
        dummy |= t0 | t1 | t2;
        {
            unsigned char* nb = smem + ((i + 1) & 1) * SC_BUF;
#pragma unroll
            for (int j = 0; j < 4; ++j) { *(u32x4*)(nb + kt_dst[j]) = stK[j]; *(u32x4*)(nb + qt_dst[j]) = stQ[j]; }
            if (tid < 96) *(u32x4*)(nb + SC_DV + tid * 16) = stD;
            vC[0] = vN[0]; vC[1] = vN[1];
        }
        __syncthreads();
    }
    if (dummy == 0x9e3779b9u) p.out[0] = 0.f;
}

DEVI void attn_item(const Params& p, int item, unsigned char* smem) {
    const int g = item & 3, qb = (item >> 2) & 31, bk = item >> 7, b = bk >> 1, kvh = bk & 1, head = kvh * 4 + g;
    const int tid = tidl(), lane = tid & 63, wid = tid >> 6, fr = lane & 15, fq = lane >> 4;
    unsigned char* ws = p.ws;
    const int r0 = tid >> 3, cl = (tid & 7) ^ ((tid >> 4) & 7);
    const unsigned char* kg0 = ws + OFF_KATT + (size_t)bk * NKEY * 64 * 2 + r0 * 128 + cl * 16;
    const unsigned char* vg0 = ws + OFF_VATT + (size_t)bk * 64 * NKEY * 2 + (size_t)r0 * NKEY * 2 + cl * 16;
    const int st_off = tid * 16;
#define ATT_ISSUE(kt_) { unsigned char* sb_ = smem + ((kt_) & 3) * 16384 + st_off; \
        glds16(kg0 + (size_t)(kt_) * 8192, sb_); glds16(kg0 + (size_t)(kt_) * 8192 + 4096, sb_ + 4096); \
        glds16(vg0 + (kt_) * 128, sb_ + 8192); glds16(vg0 + (size_t)32 * NKEY * 2 + (kt_) * 128, sb_ + 12288); }
    const int q0 = b * SEQ + qb * 128 + wid * 32;
    u32x4 qf[2][2];
#pragma unroll
    for (int qt = 0; qt < 2; ++qt)
#pragma unroll
        for (int kk = 0; kk < 2; ++kk) qf[qt][kk] = *(const u32x4*)((const bf16_t*)(ws + OFF_QATT) + (size_t)(q0 + 16 * qt + fr) * 512 + head * 64 + 32 * kk + 8 * fq);
    f32x4 o[4][2];
#pragma unroll
    for (int dt = 0; dt < 4; ++dt) { o[dt][0] = (f32x4){0.f, 0.f, 0.f, 0.f}; o[dt][1] = (f32x4){0.f, 0.f, 0.f, 0.f}; }
    float gqm = fabsf(p.g_q[lane]), gkm = fabsf(p.g_k[lane]);
#pragma unroll
    for (int of2 = 1; of2 < 64; of2 <<= 1) { gqm = fmaxf(gqm, __shfl_xor(gqm, of2)); gkm = fmaxf(gkm, __shfl_xor(gkm, of2)); }
    const float Mst = 64.f * gqm * gkm * (0.125f * 1.4426950408889634f) * 1.01f;
    f32x4 lacc[2] = {(f32x4){0.f, 0.f, 0.f, 0.f}, (f32x4){0.f, 0.f, 0.f, 0.f}};
    const unsigned one2 = fr == 0 ? 0x3f803f80u : 0u;
    const u32x4 ones = (u32x4){one2, one2, one2, one2};
    const int sw = (fr >> 1) & 7;
    const unsigned lds0 = (unsigned)(size_t)((LDSP unsigned char*)smem);
    const unsigned k_rd = lds0 + fr * 128 + ((fq ^ sw) << 4);
    const unsigned v_rd = lds0 + 8192 + fr * 128 + (((fq >> 1) ^ sw) << 4) + (fq & 1) * 8;
    asm volatile("s_waitcnt vmcnt(0)" ::: "memory");
    __builtin_amdgcn_s_barrier();
    ATT_ISSUE(0) ATT_ISSUE(1) ATT_ISSUE(2)
    for (int kt = 0; kt < NCH; ++kt) {
        if (kt + 2 < NCH) asm volatile("s_waitcnt vmcnt(8)" ::: "memory");
        else if (kt + 1 < NCH) asm volatile("s_waitcnt vmcnt(4)" ::: "memory");
        else asm volatile("s_waitcnt vmcnt(0)" ::: "memory");
        __builtin_amdgcn_s_barrier();
        if (kt + 3 < NCH) ATT_ISSUE(kt + 3)
        const unsigned kb = k_rd + (kt & 3) * 16384, vb = v_rd + (kt & 3) * 16384;
        u32x4 k0, k1, k2, k3, k4, k5, k6, k7;
        asm volatile("ds_read_b128 %0, %1" : "=v"(k0) : "v"(kb));
        asm volatile("ds_read_b128 %0, %1 offset:2048" : "=v"(k1) : "v"(kb));
        asm volatile("ds_read_b128 %0, %1 offset:4096" : "=v"(k2) : "v"(kb));
        asm volatile("ds_read_b128 %0, %1 offset:6144" : "=v"(k3) : "v"(kb));
        asm volatile("ds_read_b128 %0, %1" : "=v"(k4) : "v"(kb ^ 64u));
        asm volatile("ds_read_b128 %0, %1 offset:2048" : "=v"(k5) : "v"(kb ^ 64u));
        asm volatile("ds_read_b128 %0, %1 offset:4096" : "=v"(k6) : "v"(kb ^ 64u));
        asm volatile("ds_read_b128 %0, %1 offset:6144" : "=v"(k7) : "v"(kb ^ 64u));
        asm volatile("s_waitcnt lgkmcnt(0)" : "+v"(k0), "+v"(k1), "+v"(k2), "+v"(k3), "+v"(k4), "+v"(k5), "+v"(k6), "+v"(k7));
        f32x4 s[4][2];
        const f32x4 z4 = (f32x4){-Mst, -Mst, -Mst, -Mst};
        s[0][0] = mfma16(k0, qf[0][0], z4); s[0][1] = mfma16(k0, qf[1][0], z4);
        s[1][0] = mfma16(k1, qf[0][0], z4); s[1][1] = mfma16(k1, qf[1][0], z4);
        s[2][0] = mfma16(k2, qf[0][0], z4); s[2][1] = mfma16(k2, qf[1][0], z4);
        s[3][0] = mfma16(k3, qf[0][0], z4); s[3][1] = mfma16(k3, qf[1][0], z4);
        s[0][0] = mfma16(k4, qf[0][1], s[0][0]); s[0][1] = mfma16(k4, qf[1][1], s[0][1]);
        s[1][0] = mfma16(k5, qf[0][1], s[1][0]); s[1][1] = mfma16(k5, qf[1][1], s[1][1]);
        s[2][0] = mfma16(k6, qf[0][1], s[2][0]); s[2][1] = mfma16(k6, qf[1][1], s[2][1]);
        s[3][0] = mfma16(k7, qf[0][1], s[3][0]); s[3][1] = mfma16(k7, qf[1][1], s[3][1]);
        u32x2 va[8], vbq[8];
#pragma unroll
        for (int kk = 0; kk < 2; ++kk)
#pragma unroll
            for (int dt = 0; dt < 4; ++dt) {
                const unsigned ad = (vb + dt * 2048) ^ (kk << 6);
                asm volatile("ds_read_b64 %0, %1" : "=v"(va[kk * 4 + dt]) : "v"(ad));
                asm volatile("ds_read_b64 %0, %1" : "=v"(vbq[kk * 4 + dt]) : "v"(ad ^ 32u));
            }
        u32x4 pf[2][2];
#pragma unroll
        for (int qt = 0; qt < 2; ++qt) {
#pragma unroll
            for (int ks = 0; ks < 4; ++ks)
#pragma unroll
                for (int j = 0; j < 4; ++j) s[ks][qt][j] = __builtin_amdgcn_exp2f(s[ks][qt][j]);
#pragma unroll
            for (int kk = 0; kk < 2; ++kk)
                pf[qt][kk] = (u32x4){pk_bf16_t(s[2 * kk][qt][0], s[2 * kk][qt][1]), pk_bf16_t(s[2 * kk][qt][2], s[2 * kk][qt][3]),
                                     pk_bf16_t(s[2 * kk + 1][qt][0], s[2 * kk + 1][qt][1]), pk_bf16_t(s[2 * kk + 1][qt][2], s[2 * kk + 1][qt][3])};
        }
        asm volatile("s_nop 1" ::: "memory");
        asm volatile("s_waitcnt lgkmcnt(0)" : "+v"(va[0]), "+v"(va[1]), "+v"(va[2]), "+v"(va[3]), "+v"(va[4]), "+v"(va[5]), "+v"(va[6]), "+v"(va[7]),
                     "+v"(vbq[0]), "+v"(vbq[1]), "+v"(vbq[2]), "+v"(vbq[3]), "+v"(vbq[4]), "+v"(vbq[5]), "+v"(vbq[6]), "+v"(vbq[7]));
#pragma unroll
        for (int kk = 0; kk < 2; ++kk)
#pragma unroll
            for (int dt = 0; dt < 4; ++dt) {
                const u32x4 vfr = (u32x4){va[kk * 4 + dt].x, va[kk * 4 + dt].y, vbq[kk * 4 + dt].x, vbq[kk * 4 + dt].y};
                o[dt][0] = mfma16(vfr, pf[0][kk], o[dt][0]); o[dt][1] = mfma16(vfr, pf[1][kk], o[dt][1]);
            }
        lacc[0] = mfma16(ones, pf[0][0], lacc[0]); lacc[0] = mfma16(ones, pf[0][1], lacc[0]);
        lacc[1] = mfma16(ones, pf[1][0], lacc[1]); lacc[1] = mfma16(ones, pf[1][1], lacc[1]);
    }
#undef ATT_ISSUE
#pragma unroll
    for (int qt = 0; qt < 2; ++qt) {
        const float l = __shfl(lacc[qt][0], fr);
        const float il = 1.f / l;
        bf16_t* dst = (bf16_t*)(ws + OFF_MIX) + (size_t)(q0 + 16 * qt + fr) * 1024 + head * 64 + 4 * fq;
#pragma unroll
        for (int dt = 0; dt < 4; ++dt) *(u32x2*)(dst + 16 * dt) = (u32x2){pk_bf16(o[dt][qt][0] * il, o[dt][qt][1] * il), pk_bf16(o[dt][qt][2] * il, o[dt][qt][3] * il)};
    }
}

DEVI void readout_phase(const Params& p) {
    const int lane = tidl() & 63, wid = tidl() >> 6;
    const bf16_t* of = (const bf16_t*)(p.ws + OFF_OB); const bf16_t* ob = of + (size_t)NLAT * 512;
    const bf16_t* gh = (const bf16_t*)(p.ws + OFF_GHG);
    bf16_t* mix = (bf16_t*)(p.ws + OFF_MIX);
    const f32x4 g0 = *(const f32x4*)(p.g_hg + (lane & 15) * 8), g1 = *(const f32x4*)(p.g_hg + (lane & 15) * 8 + 4);
    for (int t = blockIdx.x; t * 4 < NLAT; t += gridDim.x) {
        const size_t row = (size_t)t * 4 + wid;
        const u32x4 ua = *(const u32x4*)(of + row * 512 + lane * 8), ub = *(const u32x4*)(ob + row * 512 + lane * 8);
        const u32x4 gg = *(const u32x4*)(gh + row * 512 + lane * 8);
        f32x4 v0 = (f32x4){bflo(ua.x) + bflo(ub.x), bfhi(ua.x) + bfhi(ub.x), bflo(ua.y) + bflo(ub.y), bfhi(ua.y) + bfhi(ub.y)};
        f32x4 v1 = (f32x4){bflo(ua.z) + bflo(ub.z), bfhi(ua.z) + bfhi(ub.z), bflo(ua.w) + bflo(ub.w), bfhi(ua.w) + bfhi(ub.w)};
        float ss = v0[0] * v0[0] + v0[1] * v0[1] + v0[2] * v0[2] + v0[3] * v0[3] + v1[0] * v1[0] + v1[1] * v1[1] + v1[2] * v1[2] + v1[3] * v1[3];
        ss += __shfl_xor(ss, 1); ss += __shfl_xor(ss, 2); ss += __shfl_xor(ss, 4); ss += __shfl_xor(ss, 8);
        const float rstd = rsqrtf(ss * (1.f / 128.f) + EPS);
        v0 = v0 * rstd * g0; v1 = v1 * rstd * g1;
        *(u32x4*)(mix + row * 1024 + 512 + lane * 8) = (u32x4){pk_bf16(v0[0] * bflo(gg.x), v0[1] * bfhi(gg.x)), pk_bf16(v0[2] * bflo(gg.y), v0[3] * bfhi(gg.y)),
                                                              pk_bf16(v1[0] * bflo(gg.z), v1[1] * bfhi(gg.z)), pk_bf16(v1[2] * bflo(gg.w), v1[3] * bfhi(gg.w))};
    }
}

template <bool FUSE_NORM>
DEVI void epi_res(const Params& p, int mt, int nt, int wr, const f32x4 (&acc)[4][4], const float* res, float* dst, int gate_idx) {
    const float* mod = (const float*)(p.ws + OFF_MOD);
    const int lane = tidl() & 63, wid = tidl() >> 6, wc = wid & 1, fr = lane & 15, fq = lane >> 4;
    const int b = mt >> 5, col = nt * 128 + wc * 64 + 4 * fq;
    f32x4 gt[4], gs[4];
#pragma unroll
    for (int n = 0; n < 4; ++n) {
        gt[n] = *(const f32x4*)(mod + b * 6144 + gate_idx * 1024 + col + 16 * n);
        if (FUSE_NORM) gs[n] = *(const f32x4*)(p.g_norm2 + col + 16 * n) * (*(const f32x4*)(mod + b * 6144 + 4 * 1024 + col + 16 * n) + 1.f);
    }
#pragma unroll
    for (int m = 0; m < 4; ++m) {
        const int row = mt * 128 + wr * 64 + 16 * m + fr;
        float ss = 0.f;
#pragma unroll
        for (int n = 0; n < 4; ++n) {
            const size_t off = (size_t)row * DM + col + 16 * n;
            const f32x4 v = *(const f32x4*)(res + off) + gt[n] * acc[m][n];
            *(f32x4*)(dst + off) = v;
            if (FUSE_NORM) {
                ss += v[0] * v[0] + v[1] * v[1] + v[2] * v[2] + v[3] * v[3];
                const f32x4 hh = v * gs[n];
                *(u32x2*)((bf16_t*)(p.ws + OFF_A) + off) = (u32x2){pk_bf16(hh[0], hh[1]), pk_bf16(hh[2], hh[3])};
            }
        }
        if (FUSE_NORM) {
            ss += __shfl_xor(ss, 16); ss += __shfl_xor(ss, 32);
            if (fq == 0) atomicAdd((float*)(p.ws + OFF_RSS) + row, ss);
        }
    }
}
template <bool FUSE_NORM>
DEVI void phase_gemm_res(const Params& p, const bf16_t* A, int lda, const bf16_t* Bt, int K, const float* res, float* dst, int gate_idx, unsigned char* smem) {
    bool first = true; int g0 = 0;
    const int nbx = gridDim.x >> 3, wr = tidl() >> 7;
    for (int j = blockIdx.x >> 3; ; j += nbx) {
        int mt, nt, mtn, ntn;
        if (!xcd_tile2(j, 8, false, mt, nt)) break;
        const bool has_next = xcd_tile2(j + nbx, 8, false, mtn, ntn);
        f32x4 accL[4][4], accH[4][4];
        gemm2_tile(gemm2_src(A, lda, Bt, K, mt * 256, nt * 128), gemm2_src(A, lda, Bt, K, mtn * 256, ntn * 128), has_next, first, g0, lda, K, K, smem, accL, accH);
        first = false;
        epi_res<FUSE_NORM>(p, 2 * mt + wr, nt, 0, accL, res, dst, gate_idx);
        epi_res<FUSE_NORM>(p, 2 * mt + wr, nt, 1, accH, res, dst, gate_idx);
    }
}

DEVI void epi_gu(const Params& p, int mt, int nt, int wr, const f32x4 (&acc)[4][4]) {
    bf16_t* act = (bf16_t*)(p.ws + OFF_ACT);
    const int lane = tidl() & 63, wid = tidl() >> 6, wc = wid & 1, fr = lane & 15, fq = lane >> 4;
    const float* cg = (const float*)(p.ws + OFF_CGU) + (mt >> 5) * 2 * DFF + nt * 128 + wc * 64 + 4 * fq;
    f32x4 cb[4];
#pragma unroll
    for (int n = 0; n < 4; ++n) cb[n] = *(const f32x4*)(cg + 16 * n);
#pragma unroll
    for (int m = 0; m < 4; ++m) {
        const int row = mt * 128 + wr * 64 + 16 * m + fr;
        const float rstd = rsqrtf(((const float*)(p.ws + OFF_RSS))[row] * (1.f / DM) + EPS);
        bf16_t* dst = act + (size_t)row * DFF + nt * 64 + wc * 32 + 4 * fq;
#pragma unroll
        for (int n2 = 0; n2 < 2; ++n2) {
            const f32x4 a = acc[m][2 * n2] * rstd + cb[2 * n2], bq = acc[m][2 * n2 + 1] * rstd + cb[2 * n2 + 1];
            *(u32x2*)(dst + 16 * n2) = (u32x2){pk_bf16(siluf(a[0]) * bq[0], siluf(a[1]) * bq[1]), pk_bf16(siluf(a[2]) * bq[2], siluf(a[3]) * bq[3])};
        }
    }
}
DEVI void phase_gemm_gu(const Params& p, unsigned char* smem) {
    const bf16_t* A = (const bf16_t*)(p.ws + OFF_A);
    const bf16_t* Bt = (const bf16_t*)(p.ws + OFF_WGU);
    bool first = true; int g0 = 0;
    const int nbx = gridDim.x >> 3, wr = tidl() >> 7;
    for (int j = blockIdx.x >> 3; ; j += nbx) {
        int mt, nt, mtn, ntn;
        if (!xcd_tile2(j, 44, false, mt, nt)) break;
        const bool has_next = xcd_tile2(j + nbx, 44, false, mtn, ntn);
        f32x4 accL[4][4], accH[4][4];
        gemm2_tile(gemm2_src(A, DM, Bt, DM, mt * 256, nt * 128), gemm2_src(A, DM, Bt, DM, mtn * 256, ntn * 128), has_next, first, g0, DM, DM, DM, smem, accL, accH);
        first = false;
        epi_gu(p, 2 * mt + wr, nt, 0, accL);
        epi_gu(p, 2 * mt + wr, nt, 1, accH);
    }
}

DEVI void final_norm_phase(const Params& p) {
    const int lane = tidl() & 63, wid = tidl() >> 6;
    for (int t = blockIdx.x; t * 4 < NLAT; t += gridDim.x) {
        const float* srow = (const float*)(p.ws + OFF_X1) + ((size_t)t * 4 + wid) * DM;
        float* row = p.out + ((size_t)t * 4 + wid) * DM;
        f32x4 v[4]; float ss = 0.f;
#pragma unroll
        for (int i = 0; i < 4; ++i) { v[i] = *(const f32x4*)(srow + lane * 4 + 256 * i); ss += v[i][0] * v[i][0] + v[i][1] * v[i][1] + v[i][2] * v[i][2] + v[i][3] * v[i][3]; }
        ss = wave_sum(ss);
        const float rstd = rsqrtf(ss * (1.f / DM) + EPS);
#pragma unroll
        for (int i = 0; i < 4; ++i) { const f32x4 gg = *(const f32x4*)(p.g_final + lane * 4 + 256 * i); *(f32x4*)(row + lane * 4 + 256 * i) = v[i] * rstd * gg; }
    }
}


#define XB_TMO      128
#define XB_XCNT(j)  (256  + 64 * (j))
#define XB_XSUB(j)  (1280 + 64 * (j))
#define XB_XGEN(j)  (2304 + 64 * (j))
#define XB_TOP      3328
#define XB_TOPGEN   3392
#define XB_SPIN_CAP (1u << 22)
#define LAS __attribute__((address_space(3)))
DEVI unsigned xb_ld(unsigned* p)              { return __hip_atomic_load(p, __ATOMIC_RELAXED, __HIP_MEMORY_SCOPE_AGENT); }
DEVI unsigned xb_add(unsigned* p, unsigned v) { return __hip_atomic_fetch_add(p, v, __ATOMIC_RELAXED, __HIP_MEMORY_SCOPE_AGENT); }
DEVI unsigned xb_xcc_id() { return (unsigned)__builtin_amdgcn_s_getreg((3 << 11) | 20) & 0xFu; }
#define XB_SPIN(cond, bar) do { unsigned _sp = 0; while (cond) { __builtin_amdgcn_s_sleep(1); \
    if ((++_sp & 255u) == 0u) { if (xb_ld(&(bar)[XB_TMO])) break; if (_sp > XB_SPIN_CAP) { atomicAdd(&(bar)[XB_TMO], 1u); break; } } } } while (0)
struct XcdBarrier { unsigned* bar; unsigned x; volatile unsigned* st; };
DEVI XcdBarrier xcd_barrier_post(unsigned* bar, volatile unsigned* st) {
    XcdBarrier b; b.bar = bar; b.x = xb_xcc_id(); b.st = st;
    if (threadIdx.x == 0) (void)xb_add(&bar[XB_XCNT(b.x)], 1u);
    return b;
}
DEVI void xcd_barrier_complete(unsigned* bar, unsigned x, unsigned& nloc, unsigned& nx) {
    const unsigned G = gridDim.x * gridDim.y * gridDim.z;
    unsigned sum, cnt, mine, sp = 0u;
    for (;;) {
        sum = 0u; cnt = 0u; mine = 0u;
#pragma unroll
        for (unsigned j = 0; j < 16; ++j) { const unsigned c = xb_ld(&bar[XB_XCNT(j)]); sum += c; cnt += (c > 0u) ? 1u : 0u; mine = (j == x) ? c : mine; }
        if (sum == G) break;
        __builtin_amdgcn_s_sleep(1);
        if ((++sp & 255u) == 0u) { if (xb_ld(&bar[XB_TMO])) break; if (sp > XB_SPIN_CAP) { atomicAdd(&bar[XB_TMO], 1u); break; } }
    }
    nloc = mine > 0u ? mine : 1u; nx = cnt > 0u ? cnt : 1u;
}
DEVI void xcd_barrier(const XcdBarrier& b) {
    asm volatile("s_waitcnt vmcnt(0)" ::: "memory");
    __syncthreads();
    if (threadIdx.x == 0) {
        unsigned* bar = b.bar;
        __builtin_amdgcn_s_waitcnt(0);
        unsigned nloc = b.st[0], nx = b.st[1];
        if (nloc == 0u) { xcd_barrier_complete(bar, b.x, nloc, nx); b.st[0] = nloc; b.st[1] = nx; }
        const unsigned old = xb_add(&bar[XB_XSUB(b.x)], 1u);
        const unsigned gen = old / nloc;
        if (old + 1u == (gen + 1u) * nloc) {
            __builtin_amdgcn_fence(__ATOMIC_RELEASE, "agent");
            asm volatile("s_waitcnt vmcnt(0)" ::: "memory");
            const unsigned og = xb_add(&bar[XB_TOP], 1u);
            const unsigned tg = og / nx;
            if (og + 1u == (tg + 1u) * nx) xb_add(&bar[XB_TOPGEN], 1u);
            else XB_SPIN(xb_ld(&bar[XB_TOPGEN]) == tg, bar);
            __builtin_amdgcn_fence(__ATOMIC_ACQUIRE, "agent");
            xb_add(&bar[XB_XGEN(b.x)], 1u);
            asm volatile("s_waitcnt vmcnt(0)" ::: "memory");
        } else {
            XB_SPIN(xb_ld(&bar[XB_XGEN(b.x)]) == gen, bar);
            __builtin_amdgcn_fence(__ATOMIC_ACQUIRE, "agent");
            asm volatile("s_waitcnt vmcnt(0)" ::: "memory");
        }
    }
    __syncthreads();
}

#define GRID_SYNC() xcd_barrier(xb)

__global__ void __launch_bounds__(256, 2) hymba_fwd(Params p) {
    __shared__ __attribute__((aligned(16))) unsigned char smem[73728];
    __shared__ int s_item;
    __shared__ unsigned xb_st[4];
    if (threadIdx.x < 4) xb_st[threadIdx.x] = 0u;
    __syncthreads();
    const XcdBarrier xb = xcd_barrier_post((unsigned*)p.ws, xb_st);
    unsigned char* ws = p.ws;
    const float* mod = (const float*)(ws + OFF_MOD);

    phase0(p, smem);
    GRID_SYNC();
    norm_mod_phase(p.x, p.ctx, (bf16_t*)(ws + OFF_A), p.g_norm1, mod, 0, 1, MROWS);
    cgu_phase(p);
    GRID_SYNC();
    phase_gemm_in(p, smem);
    GRID_SYNC();
    for (int t = blockIdx.x; t < NTASK; t += gridDim.x) hg_prep_task(p, t, smem);
    GRID_SYNC();
    if (blockIdx.x < 64) scan_block(p, blockIdx.x, smem);
    for (;;) {
        __syncthreads();
        if (threadIdx.x == 0) s_item = (int)atomicAdd((unsigned*)(ws + OFF_CNT), 1u);
        __syncthreads();
        const int item = s_item;
        if (item >= 1024) break;
        attn_item(p, item, smem);
    }
    GRID_SYNC();
    readout_phase(p);
    GRID_SYNC();
    phase_gemm_res<true>(p, (const bf16_t*)(ws + OFF_MIX), DM, (const bf16_t*)(ws + OFF_WOUT), DM, p.x, (float*)(ws + OFF_X1), 2, smem);
    GRID_SYNC();
    phase_gemm_gu(p, smem);
    GRID_SYNC();
    phase_gemm_res<false>(p, (const bf16_t*)(ws + OFF_ACT), DFF, (const bf16_t*)(ws + OFF_WDN), DFF, (const float*)(ws + OFF_X1), (float*)(ws + OFF_X1), 5, smem);
    GRID_SYNC();
    final_norm_phase(p);
}

extern "C" void kernel_launch(void* const* d_in, const int* in_sizes, int n_in, void* d_out, int out_size, void* d_ws, size_t ws_size, hipStream_t stream) {
    static int grid_blocks = 0;
    if (!grid_blocks) {
        int dev = 0, cus = 0, per_cu = 0;
        hipGetDevice(&dev);
        hipDeviceGetAttribute(&cus, hipDeviceAttributeMultiprocessorCount, dev);
        hipOccupancyMaxActiveBlocksPerMultiprocessor(&per_cu, hymba_fwd, 256, 0);
        if (per_cu > 2) per_cu = 2;
        if (per_cu < 1) per_cu = 1;
        grid_blocks = cus * per_cu;
    }
    if (ws_size < WS_NEED) { fprintf(stderr, "workspace too small: %zu < %zu\n", ws_size, (size_t)WS_NEED); return; }
    Params p{};
    p.x = (const float*)d_in[0]; p.c = (const float*)d_in[1]; p.ctx = (const float*)d_in[2]; p.c_ctx = (const float*)d_in[3];
    p.w_mod = (const float*)d_in[4]; p.b_mod = (const float*)d_in[5]; p.g_norm1 = (const float*)d_in[6]; p.w_in = (const float*)d_in[7];
    p.g_q = (const float*)d_in[8]; p.g_k = (const float*)d_in[9]; p.lb_raw = (const float*)d_in[10]; p.g_hg = (const float*)d_in[11];
    p.w_out = (const float*)d_in[12]; p.g_norm2 = (const float*)d_in[13]; p.w_gu = (const float*)d_in[14]; p.w_down = (const float*)d_in[15];
    p.g_final = (const float*)d_in[16];
    p.out = (float*)d_out; p.ws = (unsigned char*)d_ws;
    hipMemsetAsync(d_ws, 0, 32768, stream);
    void* args[] = {&p};
    hipError_t e = hipLaunchCooperativeKernel((void*)hymba_fwd, dim3(grid_blocks), dim3(256), args, 0, stream);
    if (e != hipSuccess) fprintf(stderr, "cooperative launch failed: %s (grid %d)\n", hipGetErrorString(e), grid_blocks);
}
```

```cpp
#include <hip/hip_runtime.h>
#include <hip/hip_cooperative_groups.h>
#include <cstdio>
#include <cstdint>
namespace cg = cooperative_groups;

#define DEVI __device__ __forceinline__
typedef unsigned short bf16_t;
typedef short bf16x8 __attribute__((ext_vector_type(8)));
typedef float f32x4 __attribute__((ext_vector_type(4)));
typedef unsigned u32x4 __attribute__((ext_vector_type(4)));
typedef unsigned u32x2 __attribute__((ext_vector_type(2)));

constexpr int DM = 1024, NB = 4, SEQ = 4096, CTX = 256, NLAT = NB * SEQ, NCTX = NB * CTX, MROWS = NLAT + NCTX;
constexpr int NKEY = CTX + SEQ;
constexpr int INC = 3328, DFF = 2816, NCH = NKEY / 64;
constexpr int NTASK = NB * 4 * 2 * NCH;
constexpr float EPS = 1e-6f;

constexpr size_t OFF_CNT = 16384;
constexpr size_t OFF_MOD = 32768;
constexpr size_t OFF_LB = OFF_MOD + 122880;
constexpr size_t OFF_WIN = OFF_LB + 4096;
constexpr size_t OFF_WOUT = OFF_WIN + 6815744;
constexpr size_t OFF_WGU = OFF_WOUT + 2097152;
constexpr size_t OFF_WDN = OFF_WGU + 11534336;
constexpr size_t OFF_A = OFF_WDN + 5767168;
constexpr size_t OFF_QATT = OFF_A + 35651584;
constexpr size_t OFF_KATT = OFF_QATT + 16777216;
constexpr size_t OFF_VATT = OFF_KATT + 4456448;
constexpr size_t OFF_QHG = OFF_VATT + 4456448;
constexpr size_t OFF_VHG = OFF_QHG + 17825792;
constexpr size_t OFF_LFC = OFF_VHG + 17825792;
constexpr size_t OFF_GHG = OFF_LFC + 4194304;
constexpr size_t OFF_KT = OFF_GHG + 16777216;
constexpr size_t OFF_AM = OFF_KT + 35651584;
constexpr size_t OFF_DV = OFF_AM + 17825792;
constexpr size_t OFF_MIX = OFF_DV + 3342336;
constexpr size_t OFF_END1 = OFF_MIX + 33554432;
constexpr size_t OFF_LF = OFF_MIX;
constexpr size_t OFF_OB = OFF_END1;
constexpr size_t OFF_END3 = OFF_OB + 33554432;
constexpr size_t OFF_RSS = OFF_END3;
constexpr size_t OFF_CGU = OFF_RSS + 65536;
static_assert(OFF_CGU + 90112 <= 268435456, "workspace over 256 MiB");
static_assert(OFF_LF + 67108864 <= 268435456 && OFF_END3 <= 268435456, "workspace over 256 MiB");
constexpr size_t OFF_X1 = OFF_QATT;
constexpr size_t OFF_ACT = OFF_X1 + 67108864;
constexpr size_t OFF_END2 = OFF_ACT + 92274688;
constexpr size_t WS_NEED = 268435456;
static_assert(WS_NEED <= 268435456, "workspace over 256 MiB");

struct Params {
    const float *x, *c, *ctx, *c_ctx, *w_mod, *b_mod, *g_norm1, *w_in, *g_q, *g_k, *lb_raw, *g_hg, *w_out, *g_norm2, *w_gu, *w_down, *g_final;
    float* out; unsigned char* ws;
};

DEVI unsigned pk_bf16(float lo, float hi) { unsigned r; asm("v_cvt_pk_bf16_f32 %0, %1, %2" : "=v"(r) : "v"(lo), "v"(hi)); return r; }
DEVI unsigned pk_bf16_t(float lo, float hi) { unsigned r; asm("s_nop 1\n\tv_cvt_pk_bf16_f32 %0, %1, %2" : "=v"(r) : "v"(lo), "v"(hi)); return r; }
DEVI unsigned pk_bf16_m(float lo, float hi) { unsigned r; asm("v_cvt_pk_bf16_f32 %0, %1, %2\n\ts_nop 1" : "=v"(r) : "v"(lo), "v"(hi)); return r; }
DEVI void mfma_settle() { asm volatile("s_nop 7\n\ts_nop 7" ::: "memory"); }
DEVI float bf2f(bf16_t h) { return __uint_as_float(((unsigned)h) << 16); }
DEVI float bflo(unsigned u) { return __uint_as_float(u << 16); }
DEVI float bfhi(unsigned u) { return __uint_as_float(u & 0xffff0000u); }
DEVI float siluf(float v) { return v * __builtin_amdgcn_rcpf(1.f + __expf(-v)); }
DEVI f32x4 mfma16(u32x4 a, u32x4 b, f32x4 c) {
    return __builtin_amdgcn_mfma_f32_16x16x32_bf16(__builtin_bit_cast(bf16x8, a), __builtin_bit_cast(bf16x8, b), c, 0, 0, 0);
}
DEVI int tidl() { int t = (int)threadIdx.x; asm volatile("" : "+v"(t)); return t; }
DEVI float wave_sum(float v) {
#pragma unroll
    for (int o = 1; o < 64; o <<= 1) v += __shfl_xor(v, o);
    return v;
}

DEVI void p0_transpose(const float* __restrict__ W, int ldw, bf16_t* __restrict__ Wt, int ldt, int k0, int n0, int gu, unsigned char* smem) {
    float* tile = (float*)smem;
    const int tid = tidl();
#pragma unroll
    for (int i = 0; i < 4; ++i) {
        const int kr = (tid >> 4) + 16 * i, nc = (tid & 15) * 4;
        const f32x4 v = *(const f32x4*)(W + (size_t)(k0 + kr) * ldw + n0 + nc);
        tile[kr * 65 + nc + 0] = v[0]; tile[kr * 65 + nc + 1] = v[1]; tile[kr * 65 + nc + 2] = v[2]; tile[kr * 65 + nc + 3] = v[3];
    }
    __syncthreads();
    const int nl = tid >> 2, kc = (tid & 3) * 16;
    unsigned w[8];
#pragma unroll
    for (int i = 0; i < 8; ++i) w[i] = pk_bf16(tile[(kc + 2 * i) * 65 + nl], tile[(kc + 2 * i + 1) * 65 + nl]);
    const int n = n0 + nl; int nrow = n;
    if (gu) { const int isB = n >= DFF; const int jj = isB ? n - DFF : n; nrow = (jj >> 4) * 32 + (jj & 15) + (isB ? 16 : 0); }
    u32x4* dst = (u32x4*)(Wt + (size_t)nrow * ldt + k0 + kc);
    dst[0] = (u32x4){w[0], w[1], w[2], w[3]}; dst[1] = (u32x4){w[4], w[5], w[6], w[7]};
    __syncthreads();
}

DEVI void p0_mod(const Params& p, int tsk, unsigned char* smem) {
    float* sc = (float*)smem;
    float* red = sc + 5 * 1024;
    float* mod = (float*)(p.ws + OFF_MOD);
    const int tid = tidl();
    for (int idx = tid; idx < 5120; idx += 256) { const int r = idx >> 10, k = idx & 1023; const float v = r < 4 ? p.c[r * 1024 + k] : p.c_ctx[k]; sc[idx] = siluf(v); }
    __syncthreads();
    const int cl = tid & 31, kp = tid >> 5, col = tsk * 32 + cl;
    float a0 = 0.f, a1 = 0.f, a2 = 0.f, a3 = 0.f, a4 = 0.f;
#pragma unroll 16
    for (int k = kp * 128; k < kp * 128 + 128; ++k) {
        const float w = p.w_mod[(size_t)k * 6144 + col];
        a0 += sc[k] * w; a1 += sc[1024 + k] * w; a2 += sc[2048 + k] * w; a3 += sc[3072 + k] * w; a4 += sc[4096 + k] * w;
    }
    red[(kp * 5 + 0) * 32 + cl] = a0; red[(kp * 5 + 1) * 32 + cl] = a1; red[(kp * 5 + 2) * 32 + cl] = a2; red[(kp * 5 + 3) * 32 + cl] = a3; red[(kp * 5 + 4) * 32 + cl] = a4;
    __syncthreads();
    if (tid < 160) { const int r = tid >> 5, c2 = tid & 31; float s = 0.f;
#pragma unroll
        for (int q = 0; q < 8; ++q) s += red[(q * 5 + r) * 32 + c2];
        mod[r * 6144 + tsk * 32 + c2] = s + p.b_mod[tsk * 32 + c2]; }
    __syncthreads();
}

DEVI void phase0(const Params& p, unsigned char* smem) {
    constexpr int T_MOD = 192, T_IN = 16 * 52, T_OUT = 16 * 16, T_GU = 16 * 88, T_DN = 44 * 16;
    constexpr int E0 = T_MOD + 1, E1 = E0 + T_IN, E2 = E1 + T_OUT, E3 = E2 + T_GU, E4 = E3 + T_DN;
    for (int t = blockIdx.x; t < E4; t += gridDim.x) {
        if (t < T_MOD) { p0_mod(p, t, smem); }
        else if (t == T_MOD) {
            float* lb = (float*)(p.ws + OFF_LB);
            for (int i = tidl(); i < 1024; i += 256) lb[i] = 1.f / (1.f + __expf(p.lb_raw[1024 + i] - p.lb_raw[i]));
            float* rss = (float*)(p.ws + OFF_RSS);
            for (int i = tidl(); i < NLAT; i += 256) rss[i] = 0.f;
        }
        else if (t < E1) { const int u = t - E0, kt = u / 52, nt = u % 52; p0_transpose(p.w_in, INC, (bf16_t*)(p.ws + OFF_WIN), 1024, kt * 64, nt * 64, 0, smem); }
        else if (t < E2) { const int u = t - E1, kt = u / 16, nt = u % 16; p0_transpose(p.w_out, 1024, (bf16_t*)(p.ws + OFF_WOUT), 1024, kt * 64, nt * 64, 0, smem); }
        else if (t < E3) { const int u = t - E2, kt = u / 88, nt = u % 88; p0_transpose(p.w_gu, 2 * DFF, (bf16_t*)(p.ws + OFF_WGU), 1024, kt * 64, nt * 64, 1, smem); }
        else { const int u = t - E3, kt = u / 16, nt = u % 16; p0_transpose(p.w_down, 1024, (bf16_t*)(p.ws + OFF_WDN), DFF, kt * 64, nt * 64, 0, smem); }
    }
}

DEVI void norm_mod_phase(const float* __restrict__ src_lat, const float* __restrict__ src_ctx, bf16_t* __restrict__ dst, const float* __restrict__ g,
                         const float* __restrict__ mod, int shift_idx, int scale_idx, int nrows) {
    const int lane = tidl() & 63, wid = tidl() >> 6;
    for (int t = blockIdx.x; t * 4 < nrows; t += gridDim.x) {
        const int row = t * 4 + wid;
        const float* src = row < NLAT ? src_lat + (size_t)row * DM : src_ctx + (size_t)(row - NLAT) * DM;
        const int mrow = row < NLAT ? (row >> 12) : 4;
        f32x4 v[4]; float ss = 0.f;
#pragma unroll
        for (int i = 0; i < 4; ++i) { v[i] = *(const f32x4*)(src + lane * 4 + 256 * i); ss += v[i][0] * v[i][0] + v[i][1] * v[i][1] + v[i][2] * v[i][2] + v[i][3] * v[i][3]; }
        ss = wave_sum(ss);
        const float rstd = rsqrtf(ss * (1.f / DM) + EPS);
#pragma unroll
        for (int i = 0; i < 4; ++i) {
            const int col = lane * 4 + 256 * i;
            const f32x4 gg = *(const f32x4*)(g + col), sh = *(const f32x4*)(mod + mrow * 6144 + shift_idx * 1024 + col), sc = *(const f32x4*)(mod + mrow * 6144 + scale_idx * 1024 + col);
            f32x4 h;
#pragma unroll
            for (int j = 0; j < 4; ++j) h[j] = v[i][j] * rstd * gg[j] * (1.f + sc[j]) + sh[j];
            *(u32x2*)(dst + (size_t)row * DM + col) = (u32x2){pk_bf16(h[0], h[1]), pk_bf16(h[2], h[3])};
        }
    }
}


DEVI void cgu_phase(const Params& p) {
    const int lane = tidl() & 63, wid = tidl() >> 6;
    const float* mod = (const float*)(p.ws + OFF_MOD);
    const bf16_t* W = (const bf16_t*)(p.ws + OFF_WGU);
    float* cgu = (float*)(p.ws + OFF_CGU);
    for (int t = blockIdx.x; t * 4 < 2 * DFF; t += gridDim.x) {
        const int n = t * 4 + wid;
        const u32x4 w0 = *(const u32x4*)(W + (size_t)n * DM + lane * 16), w1 = *(const u32x4*)(W + (size_t)n * DM + lane * 16 + 8);
        float wv[16] = {bflo(w0.x), bfhi(w0.x), bflo(w0.y), bfhi(w0.y), bflo(w0.z), bfhi(w0.z), bflo(w0.w), bfhi(w0.w),
                        bflo(w1.x), bfhi(w1.x), bflo(w1.y), bfhi(w1.y), bflo(w1.z), bfhi(w1.z), bflo(w1.w), bfhi(w1.w)};
#pragma unroll
        for (int b = 0; b < 4; ++b) {
            const float* sh = mod + b * 6144 + 3 * 1024 + lane * 16;
            float s = 0.f;
#pragma unroll
            for (int q = 0; q < 4; ++q) { const f32x4 sv = *(const f32x4*)(sh + 4 * q); s += sv[0] * wv[4 * q] + sv[1] * wv[4 * q + 1] + sv[2] * wv[4 * q + 2] + sv[3] * wv[4 * q + 3]; }
            s = wave_sum(s);
            if (lane == 0) cgu[b * 2 * DFF + n] = s;
        }
    }
}

#define LDSP __attribute__((address_space(3)))
#define GLBP __attribute__((address_space(1)))
DEVI void glds16(const void* g, unsigned char* l) {
    __builtin_amdgcn_global_load_lds((const GLBP void*)g, (LDSP void*)l, 16, 0, 0);
}
struct GTile2 { const bf16_t* ga; const bf16_t* gb; };
DEVI GTile2 gemm2_src(const bf16_t* A, int lda, const bf16_t* Bt, int ldb, int row0, int col0) {
    const int tid = tidl(), sr = tid >> 2, scn = (tid & 3) ^ ((tid >> 4) & 3);
    GTile2 t; t.ga = A + (size_t)(row0 + sr) * lda + scn * 8; t.gb = Bt + (size_t)(col0 + sr) * ldb + scn * 8; return t;
}
#define G2_ISSUE_T(T, kt_, slot_) { unsigned char* sb_ = smem + (slot_) * 24576 + st_off; const int ko_ = (kt_) * 32; \
        glds16(T.ga + ko_, sb_); glds16(T.ga + a64 + ko_, sb_ + 4096); glds16(T.ga + 2 * a64 + ko_, sb_ + 8192); glds16(T.ga + 3 * a64 + ko_, sb_ + 12288); \
        glds16(T.gb + ko_, sb_ + 16384); glds16(T.gb + b64 + ko_, sb_ + 20480); }
DEVI int mod3(int v) { return v >= 6 ? v - 6 : (v >= 3 ? v - 3 : v); }
DEVI void gemm2_tile(const GTile2 cur, const GTile2 nxt, const bool has_next, const bool first, int& g0, int lda, int ldb, int K, unsigned char* smem,
                     f32x4 (&accL)[4][4], f32x4 (&accH)[4][4]) {
    const int tid = tidl(), lane = tid & 63, wid = tid >> 6, wr = wid >> 1, wc = wid & 1, fr = lane & 15, fq = lane >> 4;
    const size_t a64 = (size_t)64 * lda, b64 = (size_t)64 * ldb;
    const int st_off = tid * 16;
    const int sw = (fr >> 2) & 3;
    const unsigned lds0 = (unsigned)(size_t)((LDSP unsigned char*)smem);
    const unsigned a_rd = lds0 + (wr * 128 + fr) * 64 + ((fq ^ sw) << 4);
    const unsigned b_rd = lds0 + 16384 + (wc * 64 + fr) * 64 + ((fq ^ sw) << 4);
#pragma unroll
    for (int m = 0; m < 4; ++m)
#pragma unroll
        for (int n = 0; n < 4; ++n) { accL[m][n] = (f32x4){0.f, 0.f, 0.f, 0.f}; accH[m][n] = (f32x4){0.f, 0.f, 0.f, 0.f}; }
    const int nk = K >> 5;
    if (first) {
        asm volatile("s_waitcnt vmcnt(0)" ::: "memory");
        __builtin_amdgcn_s_barrier();
        G2_ISSUE_T(cur, 0, mod3(g0)) G2_ISSUE_T(cur, 1, mod3(g0 + 1))
    }
    int slot = mod3(g0);
    for (int s = 0; s < nk; ++s) {
        if (has_next || s + 1 < nk) asm volatile("s_waitcnt vmcnt(6)" ::: "memory");
        else asm volatile("s_waitcnt vmcnt(0)" ::: "memory");
        __builtin_amdgcn_s_barrier();
        { const int s2 = s + 2; const int sl2 = mod3(slot + 2);
          if (s2 < nk) G2_ISSUE_T(cur, s2, sl2) else if (has_next) G2_ISSUE_T(nxt, s2 - nk, sl2) }
        const unsigned sa = a_rd + slot * 24576, sb = b_rd + slot * 24576;
        u32x4 a0, a1, a2, a3, a4, a5, a6, a7, b0, b1, b2, b3;
        asm volatile("ds_read_b128 %0, %1" : "=v"(a0) : "v"(sa)); asm volatile("ds_read_b128 %0, %1 offset:1024" : "=v"(a1) : "v"(sa));
        asm volatile("ds_read_b128 %0, %1 offset:2048" : "=v"(a2) : "v"(sa)); asm volatile("ds_read_b128 %0, %1 offset:3072" : "=v"(a3) : "v"(sa));
        asm volatile("ds_read_b128 %0, %1" : "=v"(b0) : "v"(sb)); asm volatile("ds_read_b128 %0, %1 offset:1024" : "=v"(b1) : "v"(sb));
        asm volatile("ds_read_b128 %0, %1 offset:2048" : "=v"(b2) : "v"(sb)); asm volatile("ds_read_b128 %0, %1 offset:3072" : "=v"(b3) : "v"(sb));
        asm volatile("ds_read_b128 %0, %1 offset:4096" : "=v"(a4) : "v"(sa)); asm volatile("ds_read_b128 %0, %1 offset:5120" : "=v"(a5) : "v"(sa));
        asm volatile("ds_read_b128 %0, %1 offset:6144" : "=v"(a6) : "v"(sa)); asm volatile("ds_read_b128 %0, %1 offset:7168" : "=v"(a7) : "v"(sa));
        asm volatile("s_waitcnt lgkmcnt(4)" : "+v"(a0), "+v"(a1), "+v"(a2), "+v"(a3), "+v"(b0), "+v"(b1), "+v"(b2), "+v"(b3));
        accL[0][0] = mfma16(b0, a0, accL[0][0]); accL[0][1] = mfma16(b1, a0, accL[0][1]); accL[0][2] = mfma16(b2, a0, accL[0][2]); accL[0][3] = mfma16(b3, a0, accL[0][3]);
        accL[1][0] = mfma16(b0, a1, accL[1][0]); accL[1][1] = mfma16(b1, a1, accL[1][1]); accL[1][2] = mfma16(b2, a1, accL[1][2]); accL[1][3] = mfma16(b3, a1, accL[1][3]);
        accL[2][0] = mfma16(b0, a2, accL[2][0]); accL[2][1] = mfma16(b1, a2, accL[2][1]); accL[2][2] = mfma16(b2, a2, accL[2][2]); accL[2][3] = mfma16(b3, a2, accL[2][3]);
        accL[3][0] = mfma16(b0, a3, accL[3][0]); accL[3][1] = mfma16(b1, a3, accL[3][1]); accL[3][2] = mfma16(b2, a3, accL[3][2]); accL[3][3] = mfma16(b3, a3, accL[3][3]);
        asm volatile("s_waitcnt lgkmcnt(0)" : "+v"(a4), "+v"(a5), "+v"(a6), "+v"(a7), "+v"(b0), "+v"(b1), "+v"(b2), "+v"(b3));
        accH[0][0] = mfma16(b0, a4, accH[0][0]); accH[0][1] = mfma16(b1, a4, accH[0][1]); accH[0][2] = mfma16(b2, a4, accH[0][2]); accH[0][3] = mfma16(b3, a4, accH[0][3]);
        accH[1][0] = mfma16(b0, a5, accH[1][0]); accH[1][1] = mfma16(b1, a5, accH[1][1]); accH[1][2] = mfma16(b2, a5, accH[1][2]); accH[1][3] = mfma16(b3, a5, accH[1][3]);
        accH[2][0] = mfma16(b0, a6, accH[2][0]); accH[2][1] = mfma16(b1, a6, accH[2][1]); accH[2][2] = mfma16(b2, a6, accH[2][2]); accH[2][3] = mfma16(b3, a6, accH[2][3]);
        accH[3][0] = mfma16(b0, a7, accH[3][0]); accH[3][1] = mfma16(b1, a7, accH[3][1]); accH[3][2] = mfma16(b2, a7, accH[3][2]); accH[3][3] = mfma16(b3, a7, accH[3][3]);
        slot = mod3(slot + 1);
    }
    g0 = slot;
}
DEVI bool xcd_tile2(int j, int NT, bool ctx, int& mt, int& nt) {
    const int x = blockIdx.x & 7, band = 8 * NT;
    if (j < band) { nt = j >> 3; mt = 8 * x + (j & 7); return true; }
    const int u = j - band;
    if (ctx && u < 9) { const int w = x * 9 + u; mt = 64 + w / 18; nt = 4 + w % 18; return true; }
    mt = 0; nt = 0; return false;
}

DEVI void epi_in(const Params& p, int mt, int nt, int wr, const f32x4 (&acc)[4][4]) {
    const int lane = tidl() & 63, wid = tidl() >> 6, wc = wid & 1, fr = lane & 15, fq = lane >> 4;
    const int row0 = mt * 128 + wr * 64 + fr;
    const bool lat = mt < 128;
    const int b = lat ? (mt >> 5) : ((mt - 128) >> 1);
    const int ntok0 = lat ? (CTX + ((mt & 31) * 128 + wr * 64 + fr)) : (((mt - 128) & 1) * 128 + wr * 64 + fr);
    unsigned char* ws = p.ws;
    if (nt < 5) {
        const bool isq = nt < 4;
        const float* gg = isq ? p.g_q : p.g_k;
        f32x4 gv[4];
#pragma unroll
        for (int n = 0; n < 4; ++n) gv[n] = *(const f32x4*)(gg + 16 * n + 4 * fq);
        float inv[4];
#pragma unroll
        for (int j = 0; j < 4; ++j) inv[j] = exp2f(-(float)(4 * fq + j) * (13.287712379549449f / 16.f));
        const float osc = isq ? 0.125f * 1.4426950408889634f : 1.f;
#pragma unroll
        for (int m = 0; m < 4; ++m) {
            float ss = 0.f;
#pragma unroll
            for (int n = 0; n < 4; ++n) ss += acc[m][n][0] * acc[m][n][0] + acc[m][n][1] * acc[m][n][1] + acc[m][n][2] * acc[m][n][2] + acc[m][n][3] * acc[m][n][3];
            ss += __shfl_xor(ss, 16); ss += __shfl_xor(ss, 32);
            const float rstd = rsqrtf(ss * (1.f / 64.f) + EPS);
            f32x4 v[4];
#pragma unroll
            for (int n = 0; n < 4; ++n) v[n] = acc[m][n] * rstd * gv[n];
            if (lat) {
                const int t = (mt & 31) * 128 + wr * 64 + fr + 16 * m;
                const float pr = (float)(t >> 6), pc = (float)(t & 63);
#pragma unroll
                for (int a = 0; a < 2; ++a) {
                    const float pos = a == 0 ? pr : pc;
#pragma unroll
                    for (int j = 0; j < 4; ++j) {
                        const float ang = pos * inv[j]; const float cs = __cosf(ang), sn = __sinf(ang);
                        const float x0 = v[2 * a][j], x1 = v[2 * a + 1][j];
                        v[2 * a][j] = x0 * cs - x1 * sn; v[2 * a + 1][j] = x1 * cs + x0 * sn;
                    }
                }
            }
            bf16_t* dst;
            if (isq) dst = (bf16_t*)(ws + OFF_QATT) + (size_t)(row0 + 16 * m) * 512 + (nt * 2 + wc) * 64 + 4 * fq;
            else dst = (bf16_t*)(ws + OFF_KATT) + ((size_t)(b * 2 + wc) * NKEY + ntok0 + 16 * m) * 64 + 4 * fq;
#pragma unroll
            for (int n = 0; n < 4; ++n) *(u32x2*)(dst + 16 * n) = (u32x2){pk_bf16(v[n][0] * osc, v[n][1] * osc), pk_bf16(v[n][2] * osc, v[n][3] * osc)};
        }
    } else if (nt == 5) {
        mfma_settle();
        bf16_t* base = (bf16_t*)(ws + OFF_VATT) + (size_t)(b * 2 + wc) * 64 * NKEY;
#pragma unroll
        for (int m = 0; m < 4; ++m)
#pragma unroll
            for (int n = 0; n < 4; ++n)
#pragma unroll
                for (int j = 0; j < 4; ++j) base[(size_t)(16 * n + 4 * fq + j) * NKEY + ntok0 + 16 * m] = (bf16_t)(pk_bf16(acc[m][n][j], 0.f) & 0xffffu);
    } else if (nt < 10) {
        const int cl = (nt - 6) * 128 + wc * 64 + 4 * fq;
#pragma unroll
        for (int m = 0; m < 4; ++m) {
            bf16_t* dst = (bf16_t*)(ws + OFF_QHG) + (size_t)(row0 + 16 * m) * 512 + cl;
#pragma unroll
            for (int n = 0; n < 4; ++n) {
                const float s = 0.08838834764831845f;
                *(u32x2*)(dst + 16 * n) = (u32x2){pk_bf16(siluf(acc[m][n][0]) * s, siluf(acc[m][n][1]) * s), pk_bf16(siluf(acc[m][n][2]) * s, siluf(acc[m][n][3]) * s)};
            }
        }
    } else if (nt < 14) {
        mfma_settle();
        const int h = nt - 10;
        bf16_t* base = (bf16_t*)(ws + OFF_VHG) + (size_t)((b * 4 + h) * 128 + wc * 64) * NKEY;
#pragma unroll
        for (int m = 0; m < 4; ++m)
#pragma unroll
            for (int n = 0; n < 4; ++n)
#pragma unroll
                for (int j = 0; j < 4; ++j) base[(size_t)(16 * n + 4 * fq + j) * NKEY + ntok0 + 16 * m] = (bf16_t)(pk_bf16(acc[m][n][j], 0.f) & 0xffffu);
    } else if (nt < 22) {
        const int cl = (nt - 14) * 128 + wc * 64 + 4 * fq;
        const float* lb = (const float*)(ws + OFF_LB);
        f32x4 lbv[4];
#pragma unroll
        for (int n = 0; n < 4; ++n) lbv[n] = *(const f32x4*)(lb + cl + 16 * n);
#pragma unroll
        for (int m = 0; m < 4; ++m) {
            float* dst = lat ? (float*)(ws + OFF_LF) + (size_t)(row0 + 16 * m) * 1024 + cl : (float*)(ws + OFF_LFC) + (size_t)(row0 + 16 * m - NLAT) * 1024 + cl;
#pragma unroll
            for (int n = 0; n < 4; ++n) {
                f32x4 o;
#pragma unroll
                for (int j = 0; j < 4; ++j) { const float sg = __builtin_amdgcn_rcpf(1.f + __expf(-acc[m][n][j])); o[j] = __logf(lbv[n][j] + (1.f - lbv[n][j]) * sg); }
                *(f32x4*)(dst + 16 * n) = o;
            }
        }
    } else {
        const int cl = (nt - 22) * 128 + wc * 64 + 4 * fq;
#pragma unroll
        for (int m = 0; m < 4; ++m) {
            bf16_t* dst = (bf16_t*)(ws + OFF_GHG) + (size_t)(row0 + 16 * m) * 512 + cl;
#pragma unroll
            for (int n = 0; n < 4; ++n)
                *(u32x2*)(dst + 16 * n) = (u32x2){pk_bf16(siluf(acc[m][n][0]), siluf(acc[m][n][1])), pk_bf16(siluf(acc[m][n][2]), siluf(acc[m][n][3]))};
        }
    }
}

DEVI void phase_gemm_in(const Params& p, unsigned char* smem) {
    const bf16_t* A = (const bf16_t*)(p.ws + OFF_A);
    const bf16_t* Bt = (const bf16_t*)(p.ws + OFF_WIN);
    bool first = true; int g0 = 0;
    const int nbx = gridDim.x >> 3, wr = tidl() >> 7;
    for (int j = blockIdx.x >> 3; ; j += nbx) {
        int mt, nt, mtn, ntn;
        if (!xcd_tile2(j, 26, true, mt, nt)) break;
        const bool has_next = xcd_tile2(j + nbx, 26, true, mtn, ntn);
        f32x4 accL[4][4], accH[4][4];
        gemm2_tile(gemm2_src(A, DM, Bt, DM, mt * 256, nt * 128), gemm2_src(A, DM, Bt, DM, mtn * 256, ntn * 128), has_next, first, g0, DM, DM, DM, smem, accL, accH);
        first = false;
        epi_in(p, 2 * mt + wr, nt, 0, accL);
        epi_in(p, 2 * mt + wr, nt, 1, accH);
    }
}

DEVI void hg_prep_task(const Params& p, int tk, unsigned char* smem) {
    const int c = tk % NCH, dir = (tk / NCH) & 1, bh = tk / (2 * NCH), h = bh & 3, b = bh >> 2;
    const int tid = tidl(), k = tid & 127, hf = tid >> 7;
    unsigned char* ws = p.ws;
    bf16_t* sQ = (bf16_t*)smem;
    bf16_t* sK = (bf16_t*)(smem + 17408);
    float* tot = (float*)(smem + 34816);
    const bool lat = c >= 4;
    const int rowbase = lat ? (b * SEQ + (c - 4) * 64) : (NLAT + b * CTX + c * 64);
    const float* lfp = lat ? (const float*)(ws + OFF_LF) + (size_t)rowbase * 1024 + dir * 512 + h * 128 + k
                           : (const float*)(ws + OFF_LFC) + (size_t)(rowbase - NLAT) * 1024 + dir * 512 + h * 128 + k;
    const bf16_t* qp = (const bf16_t*)(ws + OFF_QHG) + (size_t)rowbase * 512 + h * 128 + k;
    float lfr[32], qr[32];
#pragma unroll
    for (int i = 0; i < 32; ++i) lfr[i] = lfp[(size_t)(hf * 32 + i) * 1024];
#pragma unroll
    for (int i = 0; i < 32; ++i) qr[i] = bf2f(qp[(size_t)(hf * 32 + i) * 512]);
    float tsum = 0.f;
#pragma unroll
    for (int i = 0; i < 32; ++i) tsum += lfr[i];
    tot[hf * 128 + k] = tsum;
    __syncthreads();
    const float t0 = tot[k], t1 = tot[128 + k];
    const float r = dir == 0 ? t0 : t1, blast = t0 + t1;
    const float addv = (dir == 0) ? (hf == 1 ? t0 : 0.f) : (hf == 0 ? t1 : 0.f);
    bf16_t* Qg = (bf16_t*)(ws + OFF_A) + (size_t)tk * 8192;
    float run = addv - r;
    unsigned kw[16];
#define HG_PAIR(i) { \
        const unsigned qq = pk_bf16(qr[i] * __expf(b0), qr[(i) + 1] * __expf(b1)); \
        const unsigned kq = pk_bf16((1.f - __expf(lfr[i])) * __expf(-b0), (1.f - __expf(lfr[(i) + 1])) * __expf(-b1)); \
        kw[(i) >> 1] = kq; \
        const int tok = hf * 32 + (i); \
        sQ[tok * 136 + k] = (bf16_t)(qq & 0xffffu); sQ[(tok + 1) * 136 + k] = (bf16_t)(qq >> 16); \
        sK[tok * 136 + k] = (bf16_t)(kq & 0xffffu); sK[(tok + 1) * 136 + k] = (bf16_t)(kq >> 16); }
    if (dir == 0) {
#pragma unroll
        for (int i = 0; i < 32; i += 2) { const float b0 = run + lfr[i], b1 = b0 + lfr[i + 1]; run = b1; HG_PAIR(i) }
    } else {
#pragma unroll
        for (int i = 30; i >= 0; i -= 2) { const float b1 = run + lfr[i + 1], b0 = b1 + lfr[i]; run = b0; HG_PAIR(i) }
    }
#undef HG_PAIR
    {
        u32x4* kd = (u32x4*)((bf16_t*)(ws + OFF_KT) + (size_t)tk * 8192 + k * 64 + hf * 32);
#pragma unroll
        for (int g = 0; g < 4; ++g) kd[g] = (u32x4){kw[4 * g], kw[4 * g + 1], kw[4 * g + 2], kw[4 * g + 3]};
    }
    if (hf == 0) {
        float* dv = (float*)(ws + OFF_DV) + (size_t)tk * 384;
        dv[k] = __expf(r); dv[128 + k] = __expf(blast - r); dv[256 + k] = __expf(blast);
    }
    __syncthreads();
#pragma unroll
    for (int j = 0; j < 4; ++j) { const int idx = tid + 256 * j, rq = idx >> 4, cq = idx & 15; *(u32x4*)(Qg + rq * 128 + cq * 8) = *(const u32x4*)(smem + rq * 272 + cq * 16); }
    const int lane = tid & 63, w = tid >> 6, fr = lane & 15, fq = lane >> 4;
    f32x4 a[4];
#pragma unroll
    for (int sn = 0; sn < 4; ++sn) a[sn] = (f32x4){0.f, 0.f, 0.f, 0.f};
#pragma unroll
    for (int kk = 0; kk < 4; ++kk) {
        const u32x4 qf = *(const u32x4*)(smem + (16 * w + fr) * 272 + (32 * kk + 8 * fq) * 2);
#pragma unroll
        for (int sn = 0; sn < 4; ++sn) {
            const u32x4 kf = *(const u32x4*)(smem + 17408 + (16 * sn + fr) * 272 + (32 * kk + 8 * fq) * 2);
            a[sn] = mfma16(kf, qf, a[sn]);
        }
    }
    bf16_t* Ag = (bf16_t*)(ws + OFF_AM) + (size_t)tk * 4096;
    const int t = 16 * w + fr;
#pragma unroll
    for (int sn = 0; sn < 4; ++sn) {
        float o[4];
#pragma unroll
        for (int j = 0; j < 4; ++j) { const int s = 16 * sn + 4 * fq + j; const bool keep = dir == 0 ? (s <= t) : (s >= t); o[j] = keep ? a[sn][j] : 0.f; }
        *(u32x2*)(Ag + t * 64 + 16 * sn + 4 * fq) = (u32x2){pk_bf16(o[0], o[1]), pk_bf16(o[2], o[3])};
    }
    __syncthreads();
}

constexpr int SC_KT = 0, SC_QT = 16384, SC_DV = 16384 + 17408, SC_BUF = 16384 + 17408 + 1536;
DEVI int scan_chunk(int dir, int i) { return dir == 0 ? i : (i < 4 ? 3 - i : 71 - i); }
DEVI void scan_block(const Params& p, int blk, unsigned char* smem) {
    const int tid = tidl(), lane = tid & 63, wid = tid >> 6, fr = lane & 15, fq = lane >> 4;
    const int vs = (blk & 1) * 4 + wid, dir = (blk >> 1) & 1, h = (blk >> 2) & 3, b = blk >> 4;
    unsigned char* ws = p.ws;
    const unsigned char* Qt = ws + OFF_A;
    const unsigned char* KtT = ws + OFF_KT;
    const bf16_t* Am = (const bf16_t*)(ws + OFF_AM);
    const unsigned char* dvb = ws + OFF_DV;
    bf16_t* obuf = (bf16_t*)(ws + OFF_OB) + (dir ? (size_t)NLAT * 512 : 0);
    const bf16_t* vrow = (const bf16_t*)(ws + OFF_VHG) + (size_t)((b * 4 + h) * 128 + vs * 16 + fr) * NKEY;
    const int tk0 = ((b * 4 + h) * 2 + dir) * NCH;
    int kt_dst[4], qt_dst[4];
#pragma unroll
    for (int j = 0; j < 4; ++j) {
        const int idx = tid + 256 * j;
        const int rk = idx >> 3, ck = idx & 7; kt_dst[j] = SC_KT + rk * 128 + ((ck ^ ((rk >> 1) & 7)) << 4);
        const int rq = idx >> 4, cq = idx & 15; qt_dst[j] = SC_QT + rq * 272 + cq * 16;
    }
    const int sw = (fr >> 1) & 7;
    const int kt_rd = SC_KT + fr * 128 + ((fq ^ sw) << 4);
    const int qt_rd = SC_QT + fr * 272 + 8 * fq;
    f32x4 S[8];
#pragma unroll
    for (int m = 0; m < 8; ++m) S[m] = (f32x4){0.f, 0.f, 0.f, 0.f};
    u32x4 stK[4], stQ[4], stD, vN[2], aC[8], vC[2];
    unsigned dummy = 0u;
    {
        const int c = scan_chunk(dir, 0); const size_t tk = tk0 + c;
#pragma unroll
        for (int j = 0; j < 4; ++j) { stK[j] = *(const u32x4*)(KtT + tk * 16384 + (tid + 256 * j) * 16); stQ[j] = *(const u32x4*)(Qt + tk * 16384 + (tid + 256 * j) * 16); }
        stD = (tid < 96) ? *(const u32x4*)(dvb + tk * 1536 + tid * 16) : (u32x4){0u, 0u, 0u, 0u};
        vC[0] = *(const u32x4*)(vrow + 64 * c + 8 * fq); vC[1] = *(const u32x4*)(vrow + 64 * c + 32 + 8 * fq);
#pragma unroll
        for (int q = 0; q < 8; ++q) aC[q] = *(const u32x4*)(Am + tk * 4096 + (16 * (q >> 1) + fr) * 64 + 32 * (q & 1) + 8 * fq);
#pragma unroll
        for (int j = 0; j < 4; ++j) { *(u32x4*)(smem + kt_dst[j]) = stK[j]; *(u32x4*)(smem + qt_dst[j]) = stQ[j]; }
        if (tid < 96) *(u32x4*)(smem + SC_DV + tid * 16) = stD;
        __syncthreads();
    }
#pragma unroll 1
    for (int i = 0; i < NCH; ++i) {
        const int c = scan_chunk(dir, i);
        const unsigned char* buf = smem + (i & 1) * SC_BUF;
        const int cn = scan_chunk(dir, i + 1 < NCH ? i + 1 : NCH - 1);
        const int c3 = scan_chunk(dir, i + 3 < NCH ? i + 3 : NCH - 1);
        const size_t tkn = tk0 + cn, tk3 = tk0 + c3;
#pragma unroll
        for (int j = 0; j < 4; ++j) { stK[j] = *(const u32x4*)(KtT + tkn * 16384 + (tid + 256 * j) * 16); stQ[j] = *(const u32x4*)(Qt + tkn * 16384 + (tid + 256 * j) * 16); }
        stD = *(const u32x4*)(dvb + tkn * 1536 + (tid < 96 ? tid : 0) * 16);
        vN[0] = *(const u32x4*)(vrow + 64 * cn + 8 * fq); vN[1] = *(const u32x4*)(vrow + 64 * cn + 32 + 8 * fq);
        const unsigned t0 = *(const unsigned*)((tid < 128 ? Qt : KtT) + tk3 * 16384 + (tid & 127) * 128);
        const unsigned t1 = *(const unsigned*)((const unsigned char*)Am + tk3 * 8192 + (tid & 63) * 128);
        const unsigned t2 = *(const unsigned*)(vrow + 64 * c3);
        f32x4 o[4];
#pragma unroll
        for (int nt = 0; nt < 4; ++nt) o[nt] = (f32x4){0.f, 0.f, 0.f, 0.f};
#pragma unroll
        for (int nt = 0; nt < 4; ++nt) { o[nt] = mfma16(vC[0], aC[2 * nt], o[nt]); o[nt] = mfma16(vC[1], aC[2 * nt + 1], o[nt]); }
        __builtin_amdgcn_sched_barrier(0);
#pragma unroll
        for (int q = 0; q < 8; ++q) aC[q] = *(const u32x4*)(Am + tkn * 4096 + (16 * (q >> 1) + fr) * 64 + 32 * (q & 1) + 8 * fq);
#pragma unroll
        for (int kk = 0; kk < 4; ++kk) {
            const f32x4 da = *(const f32x4*)(buf + SC_DV + (32 * kk + 4 * fq) * 4), db = *(const f32x4*)(buf + SC_DV + (32 * kk + 16 + 4 * fq) * 4);
            const u32x4 sf = (u32x4){pk_bf16_m(S[2 * kk][0] * da[0], S[2 * kk][1] * da[1]), pk_bf16_m(S[2 * kk][2] * da[2], S[2 * kk][3] * da[3]),
                                     pk_bf16_m(S[2 * kk + 1][0] * db[0], S[2 * kk + 1][1] * db[1]), pk_bf16_m(S[2 * kk + 1][2] * db[2], S[2 * kk + 1][3] * db[3])};
#pragma unroll
            for (int nt = 0; nt < 4; ++nt) {
                const u32x2 qa = *(const u32x2*)(buf + qt_rd + nt * 4352 + 64 * kk), qb = *(const u32x2*)(buf + qt_rd + nt * 4352 + 64 * kk + 32);
                o[nt] = mfma16(sf, (u32x4){qa.x, qa.y, qb.x, qb.y}, o[nt]);
            }
        }
        if (c >= 4) {
            mfma_settle();
            bf16_t* od = obuf + (size_t)(b * SEQ + (c - 4) * 64 + fr) * 512 + h * 128 + vs * 16 + 4 * fq;
#pragma unroll
            for (int nt = 0; nt < 4; ++nt) *(u32x2*)(od + (size_t)(16 * nt) * 512) = (u32x2){pk_bf16(o[nt][0], o[nt][1]), pk_bf16(o[nt][2], o[nt][3])};
        }
        __builtin_amdgcn_sched_barrier(0);
#pragma unroll
        for (int mt = 0; mt < 8; ++mt) {
            f32x4 u = (f32x4){0.f, 0.f, 0.f, 0.f};
#pragma unroll
            for (int kk = 0; kk < 2; ++kk) { const u32x4 kf = *(const u32x4*)(buf + ((kt_rd + mt * 2048) ^ (kk << 6))); u = mfma16(kf, vC[kk], u); }
            const f32x4 d2 = *(const f32x4*)(buf + SC_DV + (128 + 16 * mt + 4 * fq) * 4), d3 = *(const f32x4*)(buf + SC_DV + (256 + 16 * mt + 4 * fq) * 4);
            S[mt] = d3 * S[mt] + d2 * u;
        }
        dummy |= t0 | t1 | t2;
        {
            unsigned char* nb = smem + ((i + 1) & 1) * SC_BUF;
#pragma unroll
            for (int j = 0; j < 4; ++j) { *(u32x4*)(nb + kt_dst[j]) = stK[j]; *(u32x4*)(nb + qt_dst[j]) = stQ[j]; }
            if (tid < 96) *(u32x4*)(nb + SC_DV + tid * 16) = stD;
            vC[0] = vN[0]; vC[1] = vN[1];
        }
        __syncthreads();
    }
    if (dummy == 0x9e3779b9u) p.out[0] = 0.f;
}

DEVI void attn_item(const Params& p, int item, unsigned char* smem) {
    const int g = item & 3, qb = (item >> 2) & 31, bk = item >> 7, b = bk >> 1, kvh = bk & 1, head = kvh * 4 + g;
    const int tid = tidl(), lane = tid & 63, wid = tid >> 6, fr = lane & 15, fq = lane >> 4;
    unsigned char* ws = p.ws;
    const int r0 = tid >> 3, cl = (tid & 7) ^ ((tid >> 4) & 7);
    const unsigned char* kg0 = ws + OFF_KATT + (size_t)bk * NKEY * 64 * 2 + r0 * 128 + cl * 16;
    const unsigned char* vg0 = ws + OFF_VATT + (size_t)bk * 64 * NKEY * 2 + (size_t)r0 * NKEY * 2 + cl * 16;
    const int st_off = tid * 16;
#define ATT_ISSUE(kt_) { unsigned char* sb_ = smem + ((kt_) & 3) * 16384 + st_off; \
        glds16(kg0 + (size_t)(kt_) * 8192, sb_); glds16(kg0 + (size_t)(kt_) * 8192 + 4096, sb_ + 4096); \
        glds16(vg0 + (kt_) * 128, sb_ + 8192); glds16(vg0 + (size_t)32 * NKEY * 2 + (kt_) * 128, sb_ + 12288); }
    const int q0 = b * SEQ + qb * 128 + wid * 32;
    u32x4 qf[2][2];
#pragma unroll
    for (int qt = 0; qt < 2; ++qt)
#pragma unroll
        for (int kk = 0; kk < 2; ++kk) qf[qt][kk] = *(const u32x4*)((const bf16_t*)(ws + OFF_QATT) + (size_t)(q0 + 16 * qt + fr) * 512 + head * 64 + 32 * kk + 8 * fq);
    f32x4 o[4][2];
#pragma unroll
    for (int dt = 0; dt < 4; ++dt) { o[dt][0] = (f32x4){0.f, 0.f, 0.f, 0.f}; o[dt][1] = (f32x4){0.f, 0.f, 0.f, 0.f}; }
    float gqm = fabsf(p.g_q[lane]), gkm = fabsf(p.g_k[lane]);
#pragma unroll
    for (int of2 = 1; of2 < 64; of2 <<= 1) { gqm = fmaxf(gqm, __shfl_xor(gqm, of2)); gkm = fmaxf(gkm, __shfl_xor(gkm, of2)); }
    const float Mst = 64.f * gqm * gkm * (0.125f * 1.4426950408889634f) * 1.01f;
    f32x4 lacc[2] = {(f32x4){0.f, 0.f, 0.f, 0.f}, (f32x4){0.f, 0.f, 0.f, 0.f}};
    const unsigned one2 = fr == 0 ? 0x3f803f80u : 0u;
    const u32x4 ones = (u32x4){one2, one2, one2, one2};
    const int sw = (fr >> 1) & 7;
    const unsigned lds0 = (unsigned)(size_t)((LDSP unsigned char*)smem);
    const unsigned k_rd = lds0 + fr * 128 + ((fq ^ sw) << 4);
    const unsigned v_rd = lds0 + 8192 + fr * 128 + (((fq >> 1) ^ sw) << 4) + (fq & 1) * 8;
    asm volatile("s_waitcnt vmcnt(0)" ::: "memory");
    __builtin_amdgcn_s_barrier();
    ATT_ISSUE(0) ATT_ISSUE(1) ATT_ISSUE(2)
    for (int kt = 0; kt < NCH; ++kt) {
        if (kt + 2 < NCH) asm volatile("s_waitcnt vmcnt(8)" ::: "memory");
        else if (kt + 1 < NCH) asm volatile("s_waitcnt vmcnt(4)" ::: "memory");
        else asm volatile("s_waitcnt vmcnt(0)" ::: "memory");
        __builtin_amdgcn_s_barrier();
        if (kt + 3 < NCH) ATT_ISSUE(kt + 3)
        const unsigned kb = k_rd + (kt & 3) * 16384, vb = v_rd + (kt & 3) * 16384;
        u32x4 k0, k1, k2, k3, k4, k5, k6, k7;
        asm volatile("ds_read_b128 %0, %1" : "=v"(k0) : "v"(kb));
        asm volatile("ds_read_b128 %0, %1 offset:2048" : "=v"(k1) : "v"(kb));
        asm volatile("ds_read_b128 %0, %1 offset:4096" : "=v"(k2) : "v"(kb));
        asm volatile("ds_read_b128 %0, %1 offset:6144" : "=v"(k3) : "v"(kb));
        asm volatile("ds_read_b128 %0, %1" : "=v"(k4) : "v"(kb ^ 64u));
        asm volatile("ds_read_b128 %0, %1 offset:2048" : "=v"(k5) : "v"(kb ^ 64u));
        asm volatile("ds_read_b128 %0, %1 offset:4096" : "=v"(k6) : "v"(kb ^ 64u));
        asm volatile("ds_read_b128 %0, %1 offset:6144" : "=v"(k7) : "v"(kb ^ 64u));
        asm volatile("s_waitcnt lgkmcnt(0)" : "+v"(k0), "+v"(k1), "+v"(k2), "+v"(k3), "+v"(k4), "+v"(k5), "+v"(k6), "+v"(k7));
        f32x4 s[4][2];
        const f32x4 z4 = (f32x4){-Mst, -Mst, -Mst, -Mst};
        s[0][0] = mfma16(k0, qf[0][0], z4); s[0][1] = mfma16(k0, qf[1][0], z4);
        s[1][0] = mfma16(k1, qf[0][0], z4); s[1][1] = mfma16(k1, qf[1][0], z4);
        s[2][0] = mfma16(k2, qf[0][0], z4); s[2][1] = mfma16(k2, qf[1][0], z4);
        s[3][0] = mfma16(k3, qf[0][0], z4); s[3][1] = mfma16(k3, qf[1][0], z4);
        s[0][0] = mfma16(k4, qf[0][1], s[0][0]); s[0][1] = mfma16(k4, qf[1][1], s[0][1]);
        s[1][0] = mfma16(k5, qf[0][1], s[1][0]); s[1][1] = mfma16(k5, qf[1][1], s[1][1]);
        s[2][0] = mfma16(k6, qf[0][1], s[2][0]); s[2][1] = mfma16(k6, qf[1][1], s[2][1]);
        s[3][0] = mfma16(k7, qf[0][1], s[3][0]); s[3][1] = mfma16(k7, qf[1][1], s[3][1]);
        u32x2 va[8], vbq[8];
#pragma unroll
        for (int kk = 0; kk < 2; ++kk)
#pragma unroll
            for (int dt = 0; dt < 4; ++dt) {
                const unsigned ad = (vb + dt * 2048) ^ (kk << 6);
                asm volatile("ds_read_b64 %0, %1" : "=v"(va[kk * 4 + dt]) : "v"(ad));
                asm volatile("ds_read_b64 %0, %1" : "=v"(vbq[kk * 4 + dt]) : "v"(ad ^ 32u));
            }
        u32x4 pf[2][2];
#pragma unroll
        for (int qt = 0; qt < 2; ++qt) {
#pragma unroll
            for (int ks = 0; ks < 4; ++ks)
#pragma unroll
                for (int j = 0; j < 4; ++j) s[ks][qt][j] = __builtin_amdgcn_exp2f(s[ks][qt][j]);
#pragma unroll
            for (int kk = 0; kk < 2; ++kk)
                pf[qt][kk] = (u32x4){pk_bf16_t(s[2 * kk][qt][0], s[2 * kk][qt][1]), pk_bf16_t(s[2 * kk][qt][2], s[2 * kk][qt][3]),
                                     pk_bf16_t(s[2 * kk + 1][qt][0], s[2 * kk + 1][qt][1]), pk_bf16_t(s[2 * kk + 1][qt][2], s[2 * kk + 1][qt][3])};
        }
        asm volatile("s_nop 1" ::: "memory");
        asm volatile("s_waitcnt lgkmcnt(0)" : "+v"(va[0]), "+v"(va[1]), "+v"(va[2]), "+v"(va[3]), "+v"(va[4]), "+v"(va[5]), "+v"(va[6]), "+v"(va[7]),
                     "+v"(vbq[0]), "+v"(vbq[1]), "+v"(vbq[2]), "+v"(vbq[3]), "+v"(vbq[4]), "+v"(vbq[5]), "+v"(vbq[6]), "+v"(vbq[7]));
#pragma unroll
        for (int kk = 0; kk < 2; ++kk)
#pragma unroll
            for (int dt = 0; dt < 4; ++dt) {
                const u32x4 vfr = (u32x4){va[kk * 4 + dt].x, va[kk * 4 + dt].y, vbq[kk * 4 + dt].x, vbq[kk * 4 + dt].y};
                o[dt][0] = mfma16(vfr, pf[0][kk], o[dt][0]); o[dt][1] = mfma16(vfr, pf[1][kk], o[dt][1]);
            }
        lacc[0] = mfma16(ones, pf[0][0], lacc[0]); lacc[0] = mfma16(ones, pf[0][1], lacc[0]);
        lacc[1] = mfma16(ones, pf[1][0], lacc[1]); lacc[1] = mfma16(ones, pf[1][1], lacc[1]);
    }
#undef ATT_ISSUE
#pragma unroll
    for (int qt = 0; qt < 2; ++qt) {
        const float l = __shfl(lacc[qt][0], fr);
        const float il = 1.f / l;
        bf16_t* dst = (bf16_t*)(ws + OFF_MIX) + (size_t)(q0 + 16 * qt + fr) * 1024 + head * 64 + 4 * fq;
#pragma unroll
        for (int dt = 0; dt < 4; ++dt) *(u32x2*)(dst + 16 * dt) = (u32x2){pk_bf16(o[dt][qt][0] * il, o[dt][qt][1] * il), pk_bf16(o[dt][qt][2] * il, o[dt][qt][3] * il)};
    }
}

DEVI void readout_phase(const Params& p) {
    const int lane = tidl() & 63, wid = tidl() >> 6;
    const bf16_t* of = (const bf16_t*)(p.ws + OFF_OB); const bf16_t* ob = of + (size_t)NLAT * 512;
    const bf16_t* gh = (const bf16_t*)(p.ws + OFF_GHG);
    bf16_t* mix = (bf16_t*)(p.ws + OFF_MIX);
    const f32x4 g0 = *(const f32x4*)(p.g_hg + (lane & 15) * 8), g1 = *(const f32x4*)(p.g_hg + (lane & 15) * 8 + 4);
    for (int t = blockIdx.x; t * 4 < NLAT; t += gridDim.x) {
        const size_t row = (size_t)t * 4 + wid;
        const u32x4 ua = *(const u32x4*)(of + row * 512 + lane * 8), ub = *(const u32x4*)(ob + row * 512 + lane * 8);
        const u32x4 gg = *(const u32x4*)(gh + row * 512 + lane * 8);
        f32x4 v0 = (f32x4){bflo(ua.x) + bflo(ub.x), bfhi(ua.x) + bfhi(ub.x), bflo(ua.y) + bflo(ub.y), bfhi(ua.y) + bfhi(ub.y)};
        f32x4 v1 = (f32x4){bflo(ua.z) + bflo(ub.z), bfhi(ua.z) + bfhi(ub.z), bflo(ua.w) + bflo(ub.w), bfhi(ua.w) + bfhi(ub.w)};
        float ss = v0[0] * v0[0] + v0[1] * v0[1] + v0[2] * v0[2] + v0[3] * v0[3] + v1[0] * v1[0] + v1[1] * v1[1] + v1[2] * v1[2] + v1[3] * v1[3];
        ss += __shfl_xor(ss, 1); ss += __shfl_xor(ss, 2); ss += __shfl_xor(ss, 4); ss += __shfl_xor(ss, 8);
        const float rstd = rsqrtf(ss * (1.f / 128.f) + EPS);
        v0 = v0 * rstd * g0; v1 = v1 * rstd * g1;
        *(u32x4*)(mix + row * 1024 + 512 + lane * 8) = (u32x4){pk_bf16(v0[0] * bflo(gg.x), v0[1] * bfhi(gg.x)), pk_bf16(v0[2] * bflo(gg.y), v0[3] * bfhi(gg.y)),
                                                              pk_bf16(v1[0] * bflo(gg.z), v1[1] * bfhi(gg.z)), pk_bf16(v1[2] * bflo(gg.w), v1[3] * bfhi(gg.w))};
    }
}

template <bool FUSE_NORM>
DEVI void epi_res(const Params& p, int mt, int nt, int wr, const f32x4 (&acc)[4][4], const float* res, float* dst, int gate_idx) {
    const float* mod = (const float*)(p.ws + OFF_MOD);
    const int lane = tidl() & 63, wid = tidl() >> 6, wc = wid & 1, fr = lane & 15, fq = lane >> 4;
    const int b = mt >> 5, col = nt * 128 + wc * 64 + 4 * fq;
    f32x4 gt[4], gs[4];
#pragma unroll
    for (int n = 0; n < 4; ++n) {
        gt[n] = *(const f32x4*)(mod + b * 6144 + gate_idx * 1024 + col + 16 * n);
        if (FUSE_NORM) gs[n] = *(const f32x4*)(p.g_norm2 + col + 16 * n) * (*(const f32x4*)(mod + b * 6144 + 4 * 1024 + col + 16 * n) + 1.f);
    }
#pragma unroll
    for (int m = 0; m < 4; ++m) {
        const int row = mt * 128 + wr * 64 + 16 * m + fr;
        float ss = 0.f;
#pragma unroll
        for (int n = 0; n < 4; ++n) {
            const size_t off = (size_t)row * DM + col + 16 * n;
            const f32x4 v = *(const f32x4*)(res + off) + gt[n] * acc[m][n];
            *(f32x4*)(dst + off) = v;
            if (FUSE_NORM) {
                ss += v[0] * v[0] + v[1] * v[1] + v[2] * v[2] + v[3] * v[3];
                const f32x4 hh = v * gs[n];
                *(u32x2*)((bf16_t*)(p.ws + OFF_A) + off) = (u32x2){pk_bf16(hh[0], hh[1]), pk_bf16(hh[2], hh[3])};
            }
        }
        if (FUSE_NORM) {
            ss += __shfl_xor(ss, 16); ss += __shfl_xor(ss, 32);
            if (fq == 0) atomicAdd((float*)(p.ws + OFF_RSS) + row, ss);
        }
    }
}
template <bool FUSE_NORM>
DEVI void phase_gemm_res(const Params& p, const bf16_t* A, int lda, const bf16_t* Bt, int K, const float* res, float* dst, int gate_idx, unsigned char* smem) {
    bool first = true; int g0 = 0;
    const int nbx = gridDim.x >> 3, wr = tidl() >> 7;
    for (int j = blockIdx.x >> 3; ; j += nbx) {
        int mt, nt, mtn, ntn;
        if (!xcd_tile2(j, 8, false, mt, nt)) break;
        const bool has_next = xcd_tile2(j + nbx, 8, false, mtn, ntn);
        f32x4 accL[4][4], accH[4][4];
        gemm2_tile(gemm2_src(A, lda, Bt, K, mt * 256, nt * 128), gemm2_src(A, lda, Bt, K, mtn * 256, ntn * 128), has_next, first, g0, lda, K, K, smem, accL, accH);
        first = false;
        epi_res<FUSE_NORM>(p, 2 * mt + wr, nt, 0, accL, res, dst, gate_idx);
        epi_res<FUSE_NORM>(p, 2 * mt + wr, nt, 1, accH, res, dst, gate_idx);
    }
}

DEVI void epi_gu(const Params& p, int mt, int nt, int wr, const f32x4 (&acc)[4][4]) {
    bf16_t* act = (bf16_t*)(p.ws + OFF_ACT);
    const int lane = tidl() & 63, wid = tidl() >> 6, wc = wid & 1, fr = lane & 15, fq = lane >> 4;
    const float* cg = (const float*)(p.ws + OFF_CGU) + (mt >> 5) * 2 * DFF + nt * 128 + wc * 64 + 4 * fq;
    f32x4 cb[4];
#pragma unroll
    for (int n = 0; n < 4; ++n) cb[n] = *(const f32x4*)(cg + 16 * n);
#pragma unroll
    for (int m = 0; m < 4; ++m) {
        const int row = mt * 128 + wr * 64 + 16 * m + fr;
        const float rstd = rsqrtf(((const float*)(p.ws + OFF_RSS))[row] * (1.f / DM) + EPS);
        bf16_t* dst = act + (size_t)row * DFF + nt * 64 + wc * 32 + 4 * fq;
#pragma unroll
        for (int n2 = 0; n2 < 2; ++n2) {
            const f32x4 a = acc[m][2 * n2] * rstd + cb[2 * n2], bq = acc[m][2 * n2 + 1] * rstd + cb[2 * n2 + 1];
            *(u32x2*)(dst + 16 * n2) = (u32x2){pk_bf16(siluf(a[0]) * bq[0], siluf(a[1]) * bq[1]), pk_bf16(siluf(a[2]) * bq[2], siluf(a[3]) * bq[3])};
        }
    }
}
DEVI void phase_gemm_gu(const Params& p, unsigned char* smem) {
    const bf16_t* A = (const bf16_t*)(p.ws + OFF_A);
    const bf16_t* Bt = (const bf16_t*)(p.ws + OFF_WGU);
    bool first = true; int g0 = 0;
    const int nbx = gridDim.x >> 3, wr = tidl() >> 7;
    for (int j = blockIdx.x >> 3; ; j += nbx) {
        int mt, nt, mtn, ntn;
        if (!xcd_tile2(j, 44, false, mt, nt)) break;
        const bool has_next = xcd_tile2(j + nbx, 44, false, mtn, ntn);
        f32x4 accL[4][4], accH[4][4];
        gemm2_tile(gemm2_src(A, DM, Bt, DM, mt * 256, nt * 128), gemm2_src(A, DM, Bt, DM, mtn * 256, ntn * 128), has_next, first, g0, DM, DM, DM, smem, accL, accH);
        first = false;
        epi_gu(p, 2 * mt + wr, nt, 0, accL);
        epi_gu(p, 2 * mt + wr, nt, 1, accH);
    }
}

DEVI void final_norm_phase(const Params& p) {
    const int lane = tidl() & 63, wid = tidl() >> 6;
    for (int t = blockIdx.x; t * 4 < NLAT; t += gridDim.x) {
        const float* srow = (const float*)(p.ws + OFF_X1) + ((size_t)t * 4 + wid) * DM;
        float* row = p.out + ((size_t)t * 4 + wid) * DM;
        f32x4 v[4]; float ss = 0.f;
#pragma unroll
        for (int i = 0; i < 4; ++i) { v[i] = *(const f32x4*)(srow + lane * 4 + 256 * i); ss += v[i][0] * v[i][0] + v[i][1] * v[i][1] + v[i][2] * v[i][2] + v[i][3] * v[i][3]; }
        ss = wave_sum(ss);
        const float rstd = rsqrtf(ss * (1.f / DM) + EPS);
#pragma unroll
        for (int i = 0; i < 4; ++i) { const f32x4 gg = *(const f32x4*)(p.g_final + lane * 4 + 256 * i); *(f32x4*)(row + lane * 4 + 256 * i) = v[i] * rstd * gg; }
    }
}


#define XB_TMO      128
#define XB_XCNT(j)  (256  + 64 * (j))
#define XB_XSUB(j)  (1280 + 64 * (j))
#define XB_XGEN(j)  (2304 + 64 * (j))
#define XB_TOP      3328
#define XB_TOPGEN   3392
#define XB_SPIN_CAP (1u << 22)
#define LAS __attribute__((address_space(3)))
DEVI unsigned xb_ld(unsigned* p)              { return __hip_atomic_load(p, __ATOMIC_RELAXED, __HIP_MEMORY_SCOPE_AGENT); }
DEVI unsigned xb_add(unsigned* p, unsigned v) { return __hip_atomic_fetch_add(p, v, __ATOMIC_RELAXED, __HIP_MEMORY_SCOPE_AGENT); }
DEVI unsigned xb_xcc_id() { return (unsigned)__builtin_amdgcn_s_getreg((3 << 11) | 20) & 0xFu; }
#define XB_SPIN(cond, bar) do { unsigned _sp = 0; while (cond) { __builtin_amdgcn_s_sleep(1); \
    if ((++_sp & 255u) == 0u) { if (xb_ld(&(bar)[XB_TMO])) break; if (_sp > XB_SPIN_CAP) { atomicAdd(&(bar)[XB_TMO], 1u); break; } } } } while (0)
struct XcdBarrier { unsigned* bar; unsigned x; volatile unsigned* st; };
DEVI XcdBarrier xcd_barrier_post(unsigned* bar, volatile unsigned* st) {
    XcdBarrier b; b.bar = bar; b.x = xb_xcc_id(); b.st = st;
    if (threadIdx.x == 0) (void)xb_add(&bar[XB_XCNT(b.x)], 1u);
    return b;
}
DEVI void xcd_barrier_complete(unsigned* bar, unsigned x, unsigned& nloc, unsigned& nx) {
    const unsigned G = gridDim.x * gridDim.y * gridDim.z;
    unsigned sum, cnt, mine, sp = 0u;
    for (;;) {
        sum = 0u; cnt = 0u; mine = 0u;
#pragma unroll
        for (unsigned j = 0; j < 16; ++j) { const unsigned c = xb_ld(&bar[XB_XCNT(j)]); sum += c; cnt += (c > 0u) ? 1u : 0u; mine = (j == x) ? c : mine; }
        if (sum == G) break;
        __builtin_amdgcn_s_sleep(1);
        if ((++sp & 255u) == 0u) { if (xb_ld(&bar[XB_TMO])) break; if (sp > XB_SPIN_CAP) { atomicAdd(&bar[XB_TMO], 1u); break; } }
    }
    nloc = mine > 0u ? mine : 1u; nx = cnt > 0u ? cnt : 1u;
}
DEVI void xcd_barrier(const XcdBarrier& b) {
    asm volatile("s_waitcnt vmcnt(0)" ::: "memory");
    __syncthreads();
    if (threadIdx.x == 0) {
        unsigned* bar = b.bar;
        __builtin_amdgcn_s_waitcnt(0);
        unsigned nloc = b.st[0], nx = b.st[1];
        if (nloc == 0u) { xcd_barrier_complete(bar, b.x, nloc, nx); b.st[0] = nloc; b.st[1] = nx; }
        const unsigned old = xb_add(&bar[XB_XSUB(b.x)], 1u);
        const unsigned gen = old / nloc;
        if (old + 1u == (gen + 1u) * nloc) {
            __builtin_amdgcn_fence(__ATOMIC_RELEASE, "agent");
            asm volatile("s_waitcnt vmcnt(0)" ::: "memory");
            const unsigned og = xb_add(&bar[XB_TOP], 1u);
            const unsigned tg = og / nx;
            if (og + 1u == (tg + 1u) * nx) xb_add(&bar[XB_TOPGEN], 1u);
            else XB_SPIN(xb_ld(&bar[XB_TOPGEN]) == tg, bar);
            __builtin_amdgcn_fence(__ATOMIC_ACQUIRE, "agent");
            xb_add(&bar[XB_XGEN(b.x)], 1u);
            asm volatile("s_waitcnt vmcnt(0)" ::: "memory");
        } else {
            XB_SPIN(xb_ld(&bar[XB_XGEN(b.x)]) == gen, bar);
            __builtin_amdgcn_fence(__ATOMIC_ACQUIRE, "agent");
            asm volatile("s_waitcnt vmcnt(0)" ::: "memory");
        }
    }
    __syncthreads();
}

#define GRID_SYNC() xcd_barrier(xb)

__global__ void __launch_bounds__(256, 2) hymba_fwd(Params p) {
    __shared__ __attribute__((aligned(16))) unsigned char smem[73728];
    __shared__ int s_item;
    __shared__ unsigned xb_st[4];
    if (threadIdx.x < 4) xb_st[threadIdx.x] = 0u;
    __syncthreads();
    const XcdBarrier xb = xcd_barrier_post((unsigned*)p.ws, xb_st);
    unsigned char* ws = p.ws;
    const float* mod = (const float*)(ws + OFF_MOD);

    phase0(p, smem);
    GRID_SYNC();
    norm_mod_phase(p.x, p.ctx, (bf16_t*)(ws + OFF_A), p.g_norm1, mod, 0, 1, MROWS);
    cgu_phase(p);
    GRID_SYNC();
    phase_gemm_in(p, smem);
    GRID_SYNC();
    for (int t = blockIdx.x; t < NTASK; t += gridDim.x) hg_prep_task(p, t, smem);
    GRID_SYNC();
    if (blockIdx.x < 64) scan_block(p, blockIdx.x, smem);
    for (;;) {
        __syncthreads();
        if (threadIdx.x == 0) s_item = (int)atomicAdd((unsigned*)(ws + OFF_CNT), 1u);
        __syncthreads();
        const int item = s_item;
        if (item >= 1024) break;
        attn_item(p, item, smem);
    }
    GRID_SYNC();
    readout_phase(p);
    GRID_SYNC();
    phase_gemm_res<true>(p, (const bf16_t*)(ws + OFF_MIX), DM, (const bf16_t*)(ws + OFF_WOUT), DM, p.x, (float*)(ws + OFF_X1), 2, smem);
    GRID_SYNC();
    phase_gemm_gu(p, smem);
    GRID_SYNC();
    phase_gemm_res<false>(p, (const bf16_t*)(ws + OFF_ACT), DFF, (const bf16_t*)(ws + OFF_WDN), DFF, (const float*)(ws + OFF_X1), (float*)(ws + OFF_X1), 5, smem);
    GRID_SYNC();
    final_norm_phase(p);
}

extern "C" void kernel_launch(void* const* d_in, const int* in_sizes, int n_in, void* d_out, int out_size, void* d_ws, size_t ws_size, hipStream_t stream) {
    static int grid_blocks = 0;
    if (!grid_blocks) {
        int dev = 0, cus = 0, per_cu = 0;
        hipGetDevice(&dev);
        hipDeviceGetAttribute(&cus, hipDeviceAttributeMultiprocessorCount, dev);
        hipOccupancyMaxActiveBlocksPerMultiprocessor(&per_cu, hymba_fwd, 256, 0);
        if (per_cu > 2) per_cu = 2;
        if (per_cu < 1) per_cu = 1;
        grid_blocks = cus * per_cu;
    }
    if (ws_size < WS_NEED) { fprintf(stderr, "workspace too small: %zu < %zu\n", ws_size, (size_t)WS_NEED); return; }
    Params p{};
    p.x = (const float*)d_in[0]; p.c = (const float*)d_in[1]; p.ctx = (const float*)d_in[2]; p.c_ctx = (const float*)d_in[3];
    p.w_mod = (const float*)d_in[4]; p.b_mod = (const float*)d_in[5]; p.g_norm1 = (const float*)d_in[6]; p.w_in = (const float*)d_in[7];
    p.g_q = (const float*)d_in[8]; p.g_k = (const float*)d_in[9]; p.lb_raw = (const float*)d_in[10]; p.g_hg = (const float*)d_in[11];
    p.w_out = (const float*)d_in[12]; p.g_norm2 = (const float*)d_in[13]; p.w_gu = (const float*)d_in[14]; p.w_down = (const float*)d_in[15];
    p.g_final = (const float*)d_in[16];
    p.out = (float*)d_out; p.ws = (unsigned char*)d_ws;
    hipMemsetAsync(d_ws, 0, 32768, stream);
    void* args[] = {&p};
    hipError_t e = hipLaunchCooperativeKernel((void*)hymba_fwd, dim3(grid_blocks), dim3(256), args, 0, stream);
    if (e != hipSuccess) fprintf(stderr, "cooperative launch failed: %s (grid %d)\n", hipGetErrorString(e), grid_blocks);
}
```

```cpp
#include <hip/hip_runtime.h>
#include <hip/hip_cooperative_groups.h>
#include <cstdio>
#include <cstdint>
namespace cg = cooperative_groups;

#define DEVI __device__ __forceinline__
typedef unsigned short bf16_t;
typedef short bf16x8 __attribute__((ext_vector_type(8)));
typedef float f32x4 __attribute__((ext_vector_type(4)));
typedef unsigned u32x4 __attribute__((ext_vector_type(4)));
typedef unsigned u32x2 __attribute__((ext_vector_type(2)));

constexpr int DM = 1024, NB = 4, SEQ = 4096, CTX = 256, NLAT = NB * SEQ, NCTX = NB * CTX, MROWS = NLAT + NCTX;
constexpr int NKEY = CTX + SEQ;
constexpr int INC = 3328, DFF = 2816, NCH = NKEY / 64;
constexpr int NTASK = NB * 4 * 2 * NCH;
constexpr float EPS = 1e-6f;

constexpr size_t OFF_CNT = 16384;
constexpr size_t OFF_MOD = 32768;
constexpr size_t OFF_LB = OFF_MOD + 122880;
constexpr size_t OFF_WIN = OFF_LB + 4096;
constexpr size_t OFF_WOUT = OFF_WIN + 6815744;
constexpr size_t OFF_WGU = OFF_WOUT + 2097152;
constexpr size_t OFF_WDN = OFF_WGU + 11534336;
constexpr size_t OFF_A = OFF_WDN + 5767168;
constexpr size_t OFF_QATT = OFF_A + 35651584;
constexpr size_t OFF_KATT = OFF_QATT + 16777216;
constexpr size_t OFF_VATT = OFF_KATT + 4456448;
constexpr size_t OFF_QHG = OFF_VATT + 4456448;
constexpr size_t OFF_VHG = OFF_QHG + 17825792;
constexpr size_t OFF_LFC = OFF_VHG + 17825792;
constexpr size_t OFF_GHG = OFF_LFC + 4194304;
constexpr size_t OFF_KT = OFF_GHG + 16777216;
constexpr size_t OFF_AM = OFF_KT + 35651584;
constexpr size_t OFF_DV = OFF_AM + 17825792;
constexpr size_t OFF_MIX = OFF_DV + 3342336;
constexpr size_t OFF_END1 = OFF_MIX + 33554432;
constexpr size_t OFF_LF = OFF_MIX;
constexpr size_t OFF_OB = OFF_END1;
constexpr size_t OFF_END3 = OFF_OB + 33554432;
constexpr size_t OFF_RSS = OFF_END3;
constexpr size_t OFF_CGU = OFF_RSS + 65536;
static_assert(OFF_CGU + 90112 <= 268435456, "workspace over 256 MiB");
static_assert(OFF_LF + 67108864 <= 268435456 && OFF_END3 <= 268435456, "workspace over 256 MiB");
constexpr size_t OFF_X1 = OFF_QATT;
constexpr size_t OFF_ACT = OFF_X1 + 67108864;
constexpr size_t OFF_END2 = OFF_ACT + 92274688;
constexpr size_t WS_NEED = 268435456;
static_assert(WS_NEED <= 268435456, "workspace over 256 MiB");

struct Params {
    const float *x, *c, *ctx, *c_ctx, *w_mod, *b_mod, *g_norm1, *w_in, *g_q, *g_k, *lb_raw, *g_hg, *w_out, *g_norm2, *w_gu, *w_down, *g_final;
    float* out; unsigned char* ws;
};

DEVI unsigned pk_bf16(float lo, float hi) { unsigned r; asm("v_cvt_pk_bf16_f32 %0, %1, %2" : "=v"(r) : "v"(lo), "v"(hi)); return r; }
DEVI unsigned pk_bf16_t(float lo, float hi) { unsigned r; asm("s_nop 1\n\tv_cvt_pk_bf16_f32 %0, %1, %2" : "=v"(r) : "v"(lo), "v"(hi)); return r; }
DEVI unsigned pk_bf16_m(float lo, float hi) { unsigned r; asm("v_cvt_pk_bf16_f32 %0, %1, %2\n\ts_nop 1" : "=v"(r) : "v"(lo), "v"(hi)); return r; }
DEVI void mfma_settle() { asm volatile("s_nop 7\n\ts_nop 7" ::: "memory"); }
DEVI float bf2f(bf16_t h) { return __uint_as_float(((unsigned)h) << 16); }
DEVI float bflo(unsigned u) { return __uint_as_float(u << 16); }
DEVI float bfhi(unsigned u) { return __uint_as_float(u & 0xffff0000u); }
DEVI float siluf(float v) { return v * __builtin_amdgcn_rcpf(1.f + __expf(-v)); }
DEVI f32x4 mfma16(u32x4 a, u32x4 b, f32x4 c) {
    return __builtin_amdgcn_mfma_f32_16x16x32_bf16(__builtin_bit_cast(bf16x8, a), __builtin_bit_cast(bf16x8, b), c, 0, 0, 0);
}
DEVI int tidl() { int t = (int)threadIdx.x; asm volatile("" : "+v"(t)); return t; }
DEVI float wave_sum(float v) {
#pragma unroll
    for (int o = 1; o < 64; o <<= 1) v += __shfl_xor(v, o);
    return v;
}

DEVI void p0_transpose(const float* __restrict__ W, int ldw, bf16_t* __restrict__ Wt, int ldt, int k0, int n0, int gu, unsigned char* smem) {
    float* tile = (float*)smem;
    const int tid = tidl();
#pragma unroll
    for (int i = 0; i < 4; ++i) {
        const int kr = (tid >> 4) + 16 * i, nc = (tid & 15) * 4;
        const f32x4 v = *(const f32x4*)(W + (size_t)(k0 + kr) * ldw + n0 + nc);
        tile[kr * 65 + nc + 0] = v[0]; tile[kr * 65 + nc + 1] = v[1]; tile[kr * 65 + nc + 2] = v[2]; tile[kr * 65 + nc + 3] = v[3];
    }
    __syncthreads();
    const int nl = tid >> 2, kc = (tid & 3) * 16;
    unsigned w[8];
#pragma unroll
    for (int i = 0; i < 8; ++i) w[i] = pk_bf16(tile[(kc + 2 * i) * 65 + nl], tile[(kc + 2 * i + 1) * 65 + nl]);
    const int n = n0 + nl; int nrow = n;
    if (gu) { const int isB = n >= DFF; const int jj = isB ? n - DFF : n; nrow = (jj >> 4) * 32 + (jj & 15) + (isB ? 16 : 0); }
    u32x4* dst = (u32x4*)(Wt + (size_t)nrow * ldt + k0 + kc);
    dst[0] = (u32x4){w[0], w[1], w[2], w[3]}; dst[1] = (u32x4){w[4], w[5], w[6], w[7]};
    __syncthreads();
}

DEVI void p0_mod(const Params& p, int tsk, unsigned char* smem) {
    float* sc = (float*)smem;
    float* red = sc + 5 * 1024;
    float* mod = (float*)(p.ws + OFF_MOD);
    const int tid = tidl();
    for (int idx = tid; idx < 5120; idx += 256) { const int r = idx >> 10, k = idx & 1023; const float v = r < 4 ? p.c[r * 1024 + k] : p.c_ctx[k]; sc[idx] = siluf(v); }
    __syncthreads();
    const int cl = tid & 31, kp = tid >> 5, col = tsk * 32 + cl;
    float a0 = 0.f, a1 = 0.f, a2 = 0.f, a3 = 0.f, a4 = 0.f;
#pragma unroll 16
    for (int k = kp * 128; k < kp * 128 + 128; ++k) {
        const float w = p.w_mod[(size_t)k * 6144 + col];
        a0 += sc[k] * w; a1 += sc[1024 + k] * w; a2 += sc[2048 + k] * w; a3 += sc[3072 + k] * w; a4 += sc[4096 + k] * w;
    }
    red[(kp * 5 + 0) * 32 + cl] = a0; red[(kp * 5 + 1) * 32 + cl] = a1; red[(kp * 5 + 2) * 32 + cl] = a2; red[(kp * 5 + 3) * 32 + cl] = a3; red[(kp * 5 + 4) * 32 + cl] = a4;
    __syncthreads();
    if (tid < 160) { const int r = tid >> 5, c2 = tid & 31; float s = 0.f;
#pragma unroll
        for (int q = 0; q < 8; ++q) s += red[(q * 5 + r) * 32 + c2];
        mod[r * 6144 + tsk * 32 + c2] = s + p.b_mod[tsk * 32 + c2]; }
    __syncthreads();
}

DEVI void phase0(const Params& p, unsigned char* smem) {
    constexpr int T_MOD = 192, T_IN = 16 * 52;
    constexpr int E0 = T_MOD + 1, E1 = E0 + T_IN;
    for (int t = blockIdx.x; t < E1; t += gridDim.x) {
        if (t < T_MOD) { p0_mod(p, t, smem); }
        else if (t == T_MOD) {
            float* lb = (float*)(p.ws + OFF_LB);
            for (int i = tidl(); i < 1024; i += 256) lb[i] = 1.f / (1.f + __expf(p.lb_raw[1024 + i] - p.lb_raw[i]));
            float* rss = (float*)(p.ws + OFF_RSS);
            for (int i = tidl(); i < NLAT; i += 256) rss[i] = 0.f;
        }
        else { const int u = t - E0, kt = u / 52, nt = u % 52; p0_transpose(p.w_in, INC, (bf16_t*)(p.ws + OFF_WIN), 1024, kt * 64, nt * 64, 0, smem); }
    }
}
DEVI void late_transposes(const Params& p, unsigned char* smem) {
    constexpr int T_OUT = 16 * 16, T_GU = 16 * 88, T_DN = 44 * 16;
    constexpr int E2 = T_OUT, E3 = E2 + T_GU, E4 = E3 + T_DN;
    for (int t = blockIdx.x; t < E4; t += gridDim.x) {
        if (t < E2) { const int kt = t / 16, nt = t % 16; p0_transpose(p.w_out, 1024, (bf16_t*)(p.ws + OFF_WOUT), 1024, kt * 64, nt * 64, 0, smem); }
        else if (t < E3) { const int u = t - E2, kt = u / 88, nt = u % 88; p0_transpose(p.w_gu, 2 * DFF, (bf16_t*)(p.ws + OFF_WGU), 1024, kt * 64, nt * 64, 1, smem); }
        else { const int u = t - E3, kt = u / 16, nt = u % 16; p0_transpose(p.w_down, 1024, (bf16_t*)(p.ws + OFF_WDN), DFF, kt * 64, nt * 64, 0, smem); }
    }
}

DEVI void norm_mod_phase(const float* __restrict__ src_lat, const float* __restrict__ src_ctx, bf16_t* __restrict__ dst, const float* __restrict__ g,
                         const float* __restrict__ mod, int shift_idx, int scale_idx, int nrows) {
    const int lane = tidl() & 63, wid = tidl() >> 6;
    for (int t = blockIdx.x; t * 4 < nrows; t += gridDim.x) {
        const int row = t * 4 + wid;
        const float* src = row < NLAT ? src_lat + (size_t)row * DM : src_ctx + (size_t)(row - NLAT) * DM;
        const int mrow = row < NLAT ? (row >> 12) : 4;
        f32x4 v[4]; float ss = 0.f;
#pragma unroll
        for (int i = 0; i < 4; ++i) { v[i] = *(const f32x4*)(src + lane * 4 + 256 * i); ss += v[i][0] * v[i][0] + v[i][1] * v[i][1] + v[i][2] * v[i][2] + v[i][3] * v[i][3]; }
        ss = wave_sum(ss);
        const float rstd = rsqrtf(ss * (1.f / DM) + EPS);
#pragma unroll
        for (int i = 0; i < 4; ++i) {
            const int col = lane * 4 + 256 * i;
            const f32x4 gg = *(const f32x4*)(g + col), sh = *(const f32x4*)(mod + mrow * 6144 + shift_idx * 1024 + col), sc = *(const f32x4*)(mod + mrow * 6144 + scale_idx * 1024 + col);
            f32x4 h;
#pragma unroll
            for (int j = 0; j < 4; ++j) h[j] = v[i][j] * rstd * gg[j] * (1.f + sc[j]) + sh[j];
            *(u32x2*)(dst + (size_t)row * DM + col) = (u32x2){pk_bf16(h[0], h[1]), pk_bf16(h[2], h[3])};
        }
    }
}


DEVI void cgu_phase(const Params& p) {
    const int lane = tidl() & 63, wid = tidl() >> 6;
    const float* mod = (const float*)(p.ws + OFF_MOD);
    const bf16_t* W = (const bf16_t*)(p.ws + OFF_WGU);
    float* cgu = (float*)(p.ws + OFF_CGU);
    for (int t = blockIdx.x; t * 4 < 2 * DFF; t += gridDim.x) {
        const int n = t * 4 + wid;
        const u32x4 w0 = *(const u32x4*)(W + (size_t)n * DM + lane * 16), w1 = *(const u32x4*)(W + (size_t)n * DM + lane * 16 + 8);
        float wv[16] = {bflo(w0.x), bfhi(w0.x), bflo(w0.y), bfhi(w0.y), bflo(w0.z), bfhi(w0.z), bflo(w0.w), bfhi(w0.w),
                        bflo(w1.x), bfhi(w1.x), bflo(w1.y), bfhi(w1.y), bflo(w1.z), bfhi(w1.z), bflo(w1.w), bfhi(w1.w)};
#pragma unroll
        for (int b = 0; b < 4; ++b) {
            const float* sh = mod + b * 6144 + 3 * 1024 + lane * 16;
            float s = 0.f;
#pragma unroll
            for (int q = 0; q < 4; ++q) { const f32x4 sv = *(const f32x4*)(sh + 4 * q); s += sv[0] * wv[4 * q] + sv[1] * wv[4 * q + 1] + sv[2] * wv[4 * q + 2] + sv[3] * wv[4 * q + 3]; }
            s = wave_sum(s);
            if (lane == 0) cgu[b * 2 * DFF + n] = s;
        }
    }
}

#define LDSP __attribute__((address_space(3)))
#define GLBP __attribute__((address_space(1)))
DEVI void glds16(const void* g, unsigned char* l) {
    __builtin_amdgcn_global_load_lds((const GLBP void*)g, (LDSP void*)l, 16, 0, 0);
}
struct GTile2 { const bf16_t* ga; const bf16_t* gb; };
DEVI GTile2 gemm2_src(const bf16_t* A, int lda, const bf16_t* Bt, int ldb, int row0, int col0) {
    const int tid = tidl(), sr = tid >> 2, scn = (tid & 3) ^ ((tid >> 4) & 3);
    GTile2 t; t.ga = A + (size_t)(row0 + sr) * lda + scn * 8; t.gb = Bt + (size_t)(col0 + sr) * ldb + scn * 8; return t;
}
#define G2_ISSUE_T(T, kt_, slot_) { unsigned char* sb_ = smem + (slot_) * 24576 + st_off; const int ko_ = (kt_) * 32; \
        glds16(T.ga + ko_, sb_); glds16(T.ga + a64 + ko_, sb_ + 4096); glds16(T.ga + 2 * a64 + ko_, sb_ + 8192); glds16(T.ga + 3 * a64 + ko_, sb_ + 12288); \
        glds16(T.gb + ko_, sb_ + 16384); glds16(T.gb + b64 + ko_, sb_ + 20480); }
DEVI int mod3(int v) { return v >= 6 ? v - 6 : (v >= 3 ? v - 3 : v); }
DEVI void gemm2_tile(const GTile2 cur, const GTile2 nxt, const bool has_next, const bool first, int& g0, int lda, int ldb, int K, unsigned char* smem,
                     f32x4 (&accL)[4][4], f32x4 (&accH)[4][4]) {
    const int tid = tidl(), lane = tid & 63, wid = tid >> 6, wr = wid >> 1, wc = wid & 1, fr = lane & 15, fq = lane >> 4;
    const size_t a64 = (size_t)64 * lda, b64 = (size_t)64 * ldb;
    const int st_off = tid * 16;
    const int sw = (fr >> 2) & 3;
    const unsigned lds0 = (unsigned)(size_t)((LDSP unsigned char*)smem);
    const unsigned a_rd = lds0 + (wr * 128 + fr) * 64 + ((fq ^ sw) << 4);
    const unsigned b_rd = lds0 + 16384 + (wc * 64 + fr) * 64 + ((fq ^ sw) << 4);
#pragma unroll
    for (int m = 0; m < 4; ++m)
#pragma unroll
        for (int n = 0; n < 4; ++n) { accL[m][n] = (f32x4){0.f, 0.f, 0.f, 0.f}; accH[m][n] = (f32x4){0.f, 0.f, 0.f, 0.f}; }
    const int nk = K >> 5;
    if (first) {
        asm volatile("s_waitcnt vmcnt(0)" ::: "memory");
        __builtin_amdgcn_s_barrier();
        G2_ISSUE_T(cur, 0, mod3(g0)) G2_ISSUE_T(cur, 1, mod3(g0 + 1))
    }
    int slot = mod3(g0);
    for (int s = 0; s < nk; ++s) {
        if (has_next || s + 1 < nk) asm volatile("s_waitcnt vmcnt(6)" ::: "memory");
        else asm volatile("s_waitcnt vmcnt(0)" ::: "memory");
        __builtin_amdgcn_s_barrier();
        { const int s2 = s + 2; const int sl2 = mod3(slot + 2);
          if (s2 < nk) G2_ISSUE_T(cur, s2, sl2) else if (has_next) G2_ISSUE_T(nxt, s2 - nk, sl2) }
        const unsigned sa = a_rd + slot * 24576, sb = b_rd + slot * 24576;
        u32x4 a0, a1, a2, a3, a4, a5, a6, a7, b0, b1, b2, b3;
        asm volatile("ds_read_b128 %0, %1" : "=v"(a0) : "v"(sa)); asm volatile("ds_read_b128 %0, %1 offset:1024" : "=v"(a1) : "v"(sa));
        asm volatile("ds_read_b128 %0, %1 offset:2048" : "=v"(a2) : "v"(sa)); asm volatile("ds_read_b128 %0, %1 offset:3072" : "=v"(a3) : "v"(sa));
        asm volatile("ds_read_b128 %0, %1" : "=v"(b0) : "v"(sb)); asm volatile("ds_read_b128 %0, %1 offset:1024" : "=v"(b1) : "v"(sb));
        asm volatile("ds_read_b128 %0, %1 offset:2048" : "=v"(b2) : "v"(sb)); asm volatile("ds_read_b128 %0, %1 offset:3072" : "=v"(b3) : "v"(sb));
        asm volatile("ds_read_b128 %0, %1 offset:4096" : "=v"(a4) : "v"(sa)); asm volatile("ds_read_b128 %0, %1 offset:5120" : "=v"(a5) : "v"(sa));
        asm volatile("ds_read_b128 %0, %1 offset:6144" : "=v"(a6) : "v"(sa)); asm volatile("ds_read_b128 %0, %1 offset:7168" : "=v"(a7) : "v"(sa));
        asm volatile("s_waitcnt lgkmcnt(4)" : "+v"(a0), "+v"(a1), "+v"(a2), "+v"(a3), "+v"(b0), "+v"(b1), "+v"(b2), "+v"(b3));
        accL[0][0] = mfma16(b0, a0, accL[0][0]); accL[0][1] = mfma16(b1, a0, accL[0][1]); accL[0][2] = mfma16(b2, a0, accL[0][2]); accL[0][3] = mfma16(b3, a0, accL[0][3]);
        accL[1][0] = mfma16(b0, a1, accL[1][0]); accL[1][1] = mfma16(b1, a1, accL[1][1]); accL[1][2] = mfma16(b2, a1, accL[1][2]); accL[1][3] = mfma16(b3, a1, accL[1][3]);
        accL[2][0] = mfma16(b0, a2, accL[2][0]); accL[2][1] = mfma16(b1, a2, accL[2][1]); accL[2][2] = mfma16(b2, a2, accL[2][2]); accL[2][3] = mfma16(b3, a2, accL[2][3]);
        accL[3][0] = mfma16(b0, a3, accL[3][0]); accL[3][1] = mfma16(b1, a3, accL[3][1]); accL[3][2] = mfma16(b2, a3, accL[3][2]); accL[3][3] = mfma16(b3, a3, accL[3][3]);
        asm volatile("s_waitcnt lgkmcnt(0)" : "+v"(a4), "+v"(a5), "+v"(a6), "+v"(a7), "+v"(b0), "+v"(b1), "+v"(b2), "+v"(b3));
        accH[0][0] = mfma16(b0, a4, accH[0][0]); accH[0][1] = mfma16(b1, a4, accH[0][1]); accH[0][2] = mfma16(b2, a4, accH[0][2]); accH[0][3] = mfma16(b3, a4, accH[0][3]);
        accH[1][0] = mfma16(b0, a5, accH[1][0]); accH[1][1] = mfma16(b1, a5, accH[1][1]); accH[1][2] = mfma16(b2, a5, accH[1][2]); accH[1][3] = mfma16(b3, a5, accH[1][3]);
        accH[2][0] = mfma16(b0, a6, accH[2][0]); accH[2][1] = mfma16(b1, a6, accH[2][1]); accH[2][2] = mfma16(b2, a6, accH[2][2]); accH[2][3] = mfma16(b3, a6, accH[2][3]);
        accH[3][0] = mfma16(b0, a7, accH[3][0]); accH[3][1] = mfma16(b1, a7, accH[3][1]); accH[3][2] = mfma16(b2, a7, accH[3][2]); accH[3][3] = mfma16(b3, a7, accH[3][3]);
        slot = mod3(slot + 1);
    }
    g0 = slot;
}
DEVI bool xcd_tile2(int j, int NT, bool ctx, int& mt, int& nt) {
    const int x = blockIdx.x & 7, band = 8 * NT;
    if (j < band) { nt = j >> 3; mt = 8 * x + (j & 7); return true; }
    const int u = j - band;
    if (ctx && u < 9) { const int w = x * 9 + u; mt = 64 + w / 18; nt = 4 + w % 18; return true; }
    mt = 0; nt = 0; return false;
}

DEVI void epi_in(const Params& p, int mt, int nt, int wr, const f32x4 (&acc)[4][4]) {
    const int lane = tidl() & 63, wid = tidl() >> 6, wc = wid & 1, fr = lane & 15, fq = lane >> 4;
    const int row0 = mt * 128 + wr * 64 + fr;
    const bool lat = mt < 128;
    const int b = lat ? (mt >> 5) : ((mt - 128) >> 1);
    const int ntok0 = lat ? (CTX + ((mt & 31) * 128 + wr * 64 + fr)) : (((mt - 128) & 1) * 128 + wr * 64 + fr);
    unsigned char* ws = p.ws;
    if (nt < 5) {
        const bool isq = nt < 4;
        const float* gg = isq ? p.g_q : p.g_k;
        f32x4 gv[4];
#pragma unroll
        for (int n = 0; n < 4; ++n) gv[n] = *(const f32x4*)(gg + 16 * n + 4 * fq);
        float inv[4];
#pragma unroll
        for (int j = 0; j < 4; ++j) inv[j] = exp2f(-(float)(4 * fq + j) * (13.287712379549449f / 16.f));
        const float osc = isq ? 0.125f * 1.4426950408889634f : 1.f;
#pragma unroll
        for (int m = 0; m < 4; ++m) {
            float ss = 0.f;
#pragma unroll
            for (int n = 0; n < 4; ++n) ss += acc[m][n][0] * acc[m][n][0] + acc[m][n][1] * acc[m][n][1] + acc[m][n][2] * acc[m][n][2] + acc[m][n][3] * acc[m][n][3];
            ss += __shfl_xor(ss, 16); ss += __shfl_xor(ss, 32);
            const float rstd = rsqrtf(ss * (1.f / 64.f) + EPS);
            f32x4 v[4];
#pragma unroll
            for (int n = 0; n < 4; ++n) v[n] = acc[m][n] * rstd * gv[n];
            if (lat) {
                const int t = (mt & 31) * 128 + wr * 64 + fr + 16 * m;
                const float pr = (float)(t >> 6), pc = (float)(t & 63);
#pragma unroll
                for (int a = 0; a < 2; ++a) {
                    const float pos = a == 0 ? pr : pc;
#pragma unroll
                    for (int j = 0; j < 4; ++j) {
                        const float ang = pos * inv[j]; const float cs = __cosf(ang), sn = __sinf(ang);
                        const float x0 = v[2 * a][j], x1 = v[2 * a + 1][j];
                        v[2 * a][j] = x0 * cs - x1 * sn; v[2 * a + 1][j] = x1 * cs + x0 * sn;
                    }
                }
            }
            bf16_t* dst;
            if (isq) dst = (bf16_t*)(ws + OFF_QATT) + (size_t)(row0 + 16 * m) * 512 + (nt * 2 + wc) * 64 + 4 * fq;
            else dst = (bf16_t*)(ws + OFF_KATT) + ((size_t)(b * 2 + wc) * NKEY + ntok0 + 16 * m) * 64 + 4 * fq;
#pragma unroll
            for (int n = 0; n < 4; ++n) *(u32x2*)(dst + 16 * n) = (u32x2){pk_bf16(v[n][0] * osc, v[n][1] * osc), pk_bf16(v[n][2] * osc, v[n][3] * osc)};
        }
    } else if (nt == 5) {
        mfma_settle();
        bf16_t* base = (bf16_t*)(ws + OFF_VATT) + (size_t)(b * 2 + wc) * 64 * NKEY;
#pragma unroll
        for (int m = 0; m < 4; ++m)
#pragma unroll
            for (int n = 0; n < 4; ++n)
#pragma unroll
                for (int j = 0; j < 4; ++j) base[(size_t)(16 * n + 4 * fq + j) * NKEY + ntok0 + 16 * m] = (bf16_t)(pk_bf16(acc[m][n][j], 0.f) & 0xffffu);
    } else if (nt < 10) {
        const int cl = (nt - 6) * 128 + wc * 64 + 4 * fq;
#pragma unroll
        for (int m = 0; m < 4; ++m) {
            bf16_t* dst = (bf16_t*)(ws + OFF_QHG) + (size_t)(row0 + 16 * m) * 512 + cl;
#pragma unroll
            for (int n = 0; n < 4; ++n) {
                const float s = 0.08838834764831845f;
                *(u32x2*)(dst + 16 * n) = (u32x2){pk_bf16(siluf(acc[m][n][0]) * s, siluf(acc[m][n][1]) * s), pk_bf16(siluf(acc[m][n][2]) * s, siluf(acc[m][n][3]) * s)};
            }
        }
    } else if (nt < 14) {
        mfma_settle();
        const int h = nt - 10;
        bf16_t* base = (bf16_t*)(ws + OFF_VHG) + (size_t)((b * 4 + h) * 128 + wc * 64) * NKEY;
#pragma unroll
        for (int m = 0; m < 4; ++m)
#pragma unroll
            for (int n = 0; n < 4; ++n)
#pragma unroll
                for (int j = 0; j < 4; ++j) base[(size_t)(16 * n + 4 * fq + j) * NKEY + ntok0 + 16 * m] = (bf16_t)(pk_bf16(acc[m][n][j], 0.f) & 0xffffu);
    } else if (nt < 22) {
        const int cl = (nt - 14) * 128 + wc * 64 + 4 * fq;
        const float* lb = (const float*)(ws + OFF_LB);
        f32x4 lbv[4], qs[4];
#pragma unroll
        for (int n = 0; n < 4; ++n) {
            lbv[n] = *(const f32x4*)(lb + cl + 16 * n);
#pragma unroll
            for (int j = 0; j < 4; ++j) qs[n][j] = 65535.f * __builtin_amdgcn_rcpf(__logf(lbv[n][j]));
        }
#pragma unroll
        for (int m = 0; m < 4; ++m) {
            bf16_t* dst = lat ? (bf16_t*)(ws + OFF_LF) + (size_t)(row0 + 16 * m) * 1024 + cl : (bf16_t*)(ws + OFF_LFC) + (size_t)(row0 + 16 * m - NLAT) * 1024 + cl;
#pragma unroll
            for (int n = 0; n < 4; ++n) {
                unsigned q[4];
#pragma unroll
                for (int j = 0; j < 4; ++j) {
                    const float sg = __builtin_amdgcn_rcpf(1.f + __expf(-acc[m][n][j]));
                    const float lf = __logf(lbv[n][j] + (1.f - lbv[n][j]) * sg);
                    q[j] = (unsigned)fminf(fmaxf(lf * qs[n][j] + 0.5f, 0.f), 65535.f);
                }
                *(u32x2*)(dst + 16 * n) = (u32x2){q[0] | (q[1] << 16), q[2] | (q[3] << 16)};
            }
        }
    } else {
        const int cl = (nt - 22) * 128 + wc * 64 + 4 * fq;
#pragma unroll
        for (int m = 0; m < 4; ++m) {
            bf16_t* dst = (bf16_t*)(ws + OFF_GHG) + (size_t)(row0 + 16 * m) * 512 + cl;
#pragma unroll
            for (int n = 0; n < 4; ++n)
                *(u32x2*)(dst + 16 * n) = (u32x2){pk_bf16(siluf(acc[m][n][0]), siluf(acc[m][n][1])), pk_bf16(siluf(acc[m][n][2]), siluf(acc[m][n][3]))};
        }
    }
}

DEVI void phase_gemm_in(const Params& p, unsigned char* smem) {
    const bf16_t* A = (const bf16_t*)(p.ws + OFF_A);
    const bf16_t* Bt = (const bf16_t*)(p.ws + OFF_WIN);
    bool first = true; int g0 = 0;
    const int nbx = gridDim.x >> 3, wr = tidl() >> 7;
    for (int j = blockIdx.x >> 3; ; j += nbx) {
        int mt, nt, mtn, ntn;
        if (!xcd_tile2(j, 26, true, mt, nt)) break;
        const bool has_next = xcd_tile2(j + nbx, 26, true, mtn, ntn);
        f32x4 accL[4][4], accH[4][4];
        gemm2_tile(gemm2_src(A, DM, Bt, DM, mt * 256, nt * 128), gemm2_src(A, DM, Bt, DM, mtn * 256, ntn * 128), has_next, first, g0, DM, DM, DM, smem, accL, accH);
        first = false;
        epi_in(p, 2 * mt + wr, nt, 0, accL);
        epi_in(p, 2 * mt + wr, nt, 1, accH);
    }
}

DEVI void hg_prep_task(const Params& p, int tk, unsigned char* smem) {
    const int c = tk % NCH, dir = (tk / NCH) & 1, bh = tk / (2 * NCH), h = bh & 3, b = bh >> 2;
    const int tid = tidl(), k = tid & 127, hf = tid >> 7;
    unsigned char* ws = p.ws;
    bf16_t* sQ = (bf16_t*)smem;
    bf16_t* sK = (bf16_t*)(smem + 17408);
    float* tot = (float*)(smem + 34816);
    const bool lat = c >= 4;
    const int rowbase = lat ? (b * SEQ + (c - 4) * 64) : (NLAT + b * CTX + c * 64);
    const bf16_t* lfp = lat ? (const bf16_t*)(ws + OFF_LF) + (size_t)rowbase * 1024 + dir * 512 + h * 128 + k
                            : (const bf16_t*)(ws + OFF_LFC) + (size_t)(rowbase - NLAT) * 1024 + dir * 512 + h * 128 + k;
    const float lfs = __logf(((const float*)(ws + OFF_LB))[dir * 512 + h * 128 + k]) * (1.f / 65535.f);
    const bf16_t* qp = (const bf16_t*)(ws + OFF_QHG) + (size_t)rowbase * 512 + h * 128 + k;
    float lfr[32], qr[32];
#pragma unroll
    for (int i = 0; i < 32; ++i) lfr[i] = (float)lfp[(size_t)(hf * 32 + i) * 1024] * lfs;
#pragma unroll
    for (int i = 0; i < 32; ++i) qr[i] = bf2f(qp[(size_t)(hf * 32 + i) * 512]);
    float tsum = 0.f;
#pragma unroll
    for (int i = 0; i < 32; ++i) tsum += lfr[i];
    tot[hf * 128 + k] = tsum;
    __syncthreads();
    const float t0 = tot[k], t1 = tot[128 + k];
    const float r = dir == 0 ? t0 : t1, blast = t0 + t1;
    const float addv = (dir == 0) ? (hf == 1 ? t0 : 0.f) : (hf == 0 ? t1 : 0.f);
    bf16_t* Qg = (bf16_t*)(ws + OFF_A) + (size_t)tk * 8192;
    float run = addv - r;
    unsigned kw[16];
#define HG_PAIR(i) { \
        const unsigned qq = pk_bf16(qr[i] * __expf(b0), qr[(i) + 1] * __expf(b1)); \
        const unsigned kq = pk_bf16((1.f - __expf(lfr[i])) * __expf(-b0), (1.f - __expf(lfr[(i) + 1])) * __expf(-b1)); \
        kw[(i) >> 1] = kq; \
        const int tok = hf * 32 + (i); \
        sQ[tok * 136 + k] = (bf16_t)(qq & 0xffffu); sQ[(tok + 1) * 136 + k] = (bf16_t)(qq >> 16); \
        sK[tok * 136 + k] = (bf16_t)(kq & 0xffffu); sK[(tok + 1) * 136 + k] = (bf16_t)(kq >> 16); }
    if (dir == 0) {
#pragma unroll
        for (int i = 0; i < 32; i += 2) { const float b0 = run + lfr[i], b1 = b0 + lfr[i + 1]; run = b1; HG_PAIR(i) }
    } else {
#pragma unroll
        for (int i = 30; i >= 0; i -= 2) { const float b1 = run + lfr[i + 1], b0 = b1 + lfr[i]; run = b0; HG_PAIR(i) }
    }
#undef HG_PAIR
    {
        u32x4* kd = (u32x4*)((bf16_t*)(ws + OFF_KT) + (size_t)tk * 8192 + k * 64 + hf * 32);
#pragma unroll
        for (int g = 0; g < 4; ++g) kd[g] = (u32x4){kw[4 * g], kw[4 * g + 1], kw[4 * g + 2], kw[4 * g + 3]};
    }
    if (hf == 0) {
        float* dv = (float*)(ws + OFF_DV) + (size_t)tk * 384;
        dv[k] = __expf(r); dv[128 + k] = __expf(blast - r); dv[256 + k] = __expf(blast);
    }
    __syncthreads();
#pragma unroll
    for (int j = 0; j < 4; ++j) { const int idx = tid + 256 * j, rq = idx >> 4, cq = idx & 15; *(u32x4*)(Qg + rq * 128 + cq * 8) = *(const u32x4*)(smem + rq * 272 + cq * 16); }
    const int lane = tid & 63, w = tid >> 6, fr = lane & 15, fq = lane >> 4;
    f32x4 a[4];
#pragma unroll
    for (int sn = 0; sn < 4; ++sn) a[sn] = (f32x4){0.f, 0.f, 0.f, 0.f};
#pragma unroll
    for (int kk = 0; kk < 4; ++kk) {
        const u32x4 qf = *(const u32x4*)(smem + (16 * w + fr) * 272 + (32 * kk + 8 * fq) * 2);
#pragma unroll
        for (int sn = 0; sn < 4; ++sn) {
            const u32x4 kf = *(const u32x4*)(smem + 17408 + (16 * sn + fr) * 272 + (32 * kk + 8 * fq) * 2);
            a[sn] = mfma16(kf, qf, a[sn]);
        }
    }
    bf16_t* Ag = (bf16_t*)(ws + OFF_AM) + (size_t)tk * 4096;
    const int t = 16 * w + fr;
#pragma unroll
    for (int sn = 0; sn < 4; ++sn) {
        float o[4];
#pragma unroll
        for (int j = 0; j < 4; ++j) { const int s = 16 * sn + 4 * fq + j; const bool keep = dir == 0 ? (s <= t) : (s >= t); o[j] = keep ? a[sn][j] : 0.f; }
        *(u32x2*)(Ag + t * 64 + 16 * sn + 4 * fq) = (u32x2){pk_bf16(o[0], o[1]), pk_bf16(o[2], o[3])};
    }
    __syncthreads();
}

constexpr int SC_KT = 0, SC_QT = 16384, SC_DV = 16384 + 17408, SC_BUF = 16384 + 17408 + 1536;
DEVI int scan_chunk(int dir, int i) { return dir == 0 ? i : (i < 4 ? 3 - i : 71 - i); }
DEVI void scan_block(const Params& p, int blk, unsigned char* smem) {
    const int tid = tidl(), lane = tid & 63, wid = tid >> 6, fr = lane & 15, fq = lane >> 4;
    const int vs = (blk & 1) * 4 + wid, dir = (blk >> 1) & 1, h = (blk >> 2) & 3, b = blk >> 4;
    unsigned char* ws = p.ws;
    const unsigned char* Qt = ws + OFF_A;
    const unsigned char* KtT = ws + OFF_KT;
    const bf16_t* Am = (const bf16_t*)(ws + OFF_AM);
    const unsigned char* dvb = ws + OFF_DV;
    bf16_t* obuf = (bf16_t*)(ws + OFF_OB) + (dir ? (size_t)NLAT * 512 : 0);
    const bf16_t* vrow = (const bf16_t*)(ws + OFF_VHG) + (size_t)((b * 4 + h) * 128 + vs * 16 + fr) * NKEY;
    const int tk0 = ((b * 4 + h) * 2 + dir) * NCH;
    int kt_dst[4], qt_dst[4];
#pragma unroll
    for (int j = 0; j < 4; ++j) {
        const int idx = tid + 256 * j;
        const int rk = idx >> 3, ck = idx & 7; kt_dst[j] = SC_KT + rk * 128 + ((ck ^ ((rk >> 1) & 7)) << 4);
        const int rq = idx >> 4, cq = idx & 15; qt_dst[j] = SC_QT + rq * 272 + cq * 16;
    }
    const int sw = (fr >> 1) & 7;
    const int kt_rd = SC_KT + fr * 128 + ((fq ^ sw) << 4);
    const int qt_rd = SC_QT + fr * 272 + 8 * fq;
    f32x4 S[8];
#pragma unroll
    for (int m = 0; m < 8; ++m) S[m] = (f32x4){0.f, 0.f, 0.f, 0.f};
    u32x4 stK[4], stQ[4], stD, vN[2], aC[8], vC[2];
    unsigned dummy = 0u;
    {
        const int c = scan_chunk(dir, 0); const size_t tk = tk0 + c;
#pragma unroll
        for (int j = 0; j < 4; ++j) { stK[j] = *(const u32x4*)(KtT + tk * 16384 + (tid + 256 * j) * 16); stQ[j] = *(const u32x4*)(Qt + tk * 16384 + (tid + 256 * j) * 16); }
        stD = (tid < 96) ? *(const u32x4*)(dvb + tk * 1536 + tid * 16) : (u32x4){0u, 0u, 0u, 0u};
        vC[0] = *(const u32x4*)(vrow + 64 * c + 8 * fq); vC[1] = *(const u32x4*)(vrow + 64 * c + 32 + 8 * fq);
#pragma unroll
        for (int q = 0; q < 8; ++q) aC[q] = *(const u32x4*)(Am + tk * 4096 + (16 * (q >> 1) + fr) * 64 + 32 * (q & 1) + 8 * fq);
#pragma unroll
        for (int j = 0; j < 4; ++j) { *(u32x4*)(smem + kt_dst[j]) = stK[j]; *(u32x4*)(smem + qt_dst[j]) = stQ[j]; }
        if (tid < 96) *(u32x4*)(smem + SC_DV + tid * 16) = stD;
        __syncthreads();
    }
#pragma unroll 1
    for (int i = 0; i < NCH; ++i) {
        const int c = scan_chunk(dir, i);
        const unsigned char* buf = smem + (i & 1) * SC_BUF;
        const int cn = scan_chunk(dir, i + 1 < NCH ? i + 1 : NCH - 1);
        const int c3 = scan_chunk(dir, i + 3 < NCH ? i + 3 : NCH - 1);
        const size_t tkn = tk0 + cn, tk3 = tk0 + c3;
#pragma unroll
        for (int j = 0; j < 4; ++j) { stK[j] = *(const u32x4*)(KtT + tkn * 16384 + (tid + 256 * j) * 16); stQ[j] = *(const u32x4*)(Qt + tkn * 16384 + (tid + 256 * j) * 16); }
        stD = *(const u32x4*)(dvb + tkn * 1536 + (tid < 96 ? tid : 0) * 16);
        vN[0] = *(const u32x4*)(vrow + 64 * cn + 8 * fq); vN[1] = *(const u32x4*)(vrow + 64 * cn + 32 + 8 * fq);
        const unsigned t0 = *(const unsigned*)((tid < 128 ? Qt : KtT) + tk3 * 16384 + (tid & 127) * 128);
        const unsigned t1 = *(const unsigned*)((const unsigned char*)Am + tk3 * 8192 + (tid & 63) * 128);
        const unsigned t2 = *(const unsigned*)(vrow + 64 * c3);
        f32x4 o[4];
#pragma unroll
        for (int nt = 0; nt < 4; ++nt) o[nt] = (f32x4){0.f, 0.f, 0.f, 0.f};
#pragma unroll
        for (int nt = 0; nt < 4; ++nt) { o[nt] = mfma16(vC[0], aC[2 * nt], o[nt]); o[nt] = mfma16(vC[1], aC[2 * nt + 1], o[nt]); }
        __builtin_amdgcn_sched_barrier(0);
#pragma unroll
        for (int q = 0; q < 8; ++q) aC[q] = *(const u32x4*)(Am + tkn * 4096 + (16 * (q >> 1) + fr) * 64 + 32 * (q & 1) + 8 * fq);
#pragma unroll
        for (int kk = 0; kk < 4; ++kk) {
            const f32x4 da = *(const f32x4*)(buf + SC_DV + (32 * kk + 4 * fq) * 4), db = *(const f32x4*)(buf + SC_DV + (32 * kk + 16 + 4 * fq) * 4);
            const u32x4 sf = (u32x4){pk_bf16_m(S[2 * kk][0] * da[0], S[2 * kk][1] * da[1]), pk_bf16_m(S[2 * kk][2] * da[2], S[2 * kk][3] * da[3]),
                                     pk_bf16_m(S[2 * kk + 1][0] * db[0], S[2 * kk + 1][1] * db[1]), pk_bf16_m(S[2 * kk + 1][2] * db[2], S[2 * kk + 1][3] * db[3])};
#pragma unroll
            for (int nt = 0; nt < 4; ++nt) {
                const u32x2 qa = *(const u32x2*)(buf + qt_rd + nt * 4352 + 64 * kk), qb = *(const u32x2*)(buf + qt_rd + nt * 4352 + 64 * kk + 32);
                o[nt] = mfma16(sf, (u32x4){qa.x, qa.y, qb.x, qb.y}, o[nt]);
            }
        }
        if (c >= 4) {
            mfma_settle();
            bf16_t* od = obuf + (size_t)(b * SEQ + (c - 4) * 64 + fr) * 512 + h * 128 + vs * 16 + 4 * fq;
#pragma unroll
            for (int nt = 0; nt < 4; ++nt) *(u32x2*)(od + (size_t)(16 * nt) * 512) = (u32x2){pk_bf16(o[nt][0], o[nt][1]), pk_bf16(o[nt][2], o[nt][3])};
        }
        __builtin_amdgcn_sched_barrier(0);
#pragma unroll
        for (int mt = 0; mt < 8; ++mt) {
            f32x4 u = (f32x4){0.f, 0.f, 0.f, 0.f};
#pragma unroll
            for (int kk = 0; kk < 2; ++kk) { const u32x4 kf = *(const u32x4*)(buf + ((kt_rd + mt * 2048) ^ (kk << 6))); u = mfma16(kf, vC[kk], u); }
            const f32x4 d2 = *(const f32x4*)(buf + SC_DV + (128 + 16 * mt + 4 * fq) * 4), d3 = *(const f32x4*)(buf + SC_DV + (256 + 16 * mt + 4 * fq) * 4);
            S[mt] = d3 * S[mt] + d2 * u;
        }
        dummy |= t0 | t1 | t2;
        {
            unsigned char* nb = smem + ((i + 1) & 1) * SC_BUF;
#pragma unroll
            for (int j = 0; j < 4; ++j) { *(u32x4*)(nb + kt_dst[j]) = stK[j]; *(u32x4*)(nb + qt_dst[j]) = stQ[j]; }
            if (tid < 96) *(u32x4*)(nb + SC_DV + tid * 16) = stD;
            vC[0] = vN[0]; vC[1] = vN[1];
        }
        __syncthreads();
    }
    if (dummy == 0x9e3779b9u) p.out[0] = 0.f;
}

DEVI void attn_item(const Params& p, int item, unsigned char* smem) {
    const int g = item & 3, qb = (item >> 2) & 31, bk = item >> 7, b = bk >> 1, kvh = bk & 1, head = kvh * 4 + g;
    const int tid = tidl(), lane = tid & 63, wid = tid >> 6, fr = lane & 15, fq = lane >> 4;
    unsigned char* ws = p.ws;
    const int r0 = tid >> 3, cl = (tid & 7) ^ ((tid >> 4) & 7);
    const unsigned char* kg0 = ws + OFF_KATT + (size_t)bk * NKEY * 64 * 2 + r0 * 128 + cl * 16;
    const unsigned char* vg0 = ws + OFF_VATT + (size_t)bk * 64 * NKEY * 2 + (size_t)r0 * NKEY * 2 + cl * 16;
    const int st_off = tid * 16;
#define ATT_ISSUE(kt_) { unsigned char* sb_ = smem + ((kt_) & 3) * 16384 + st_off; \
        glds16(kg0 + (size_t)(kt_) * 8192, sb_); glds16(kg0 + (size_t)(kt_) * 8192 + 4096, sb_ + 4096); \
        glds16(vg0 + (kt_) * 128, sb_ + 8192); glds16(vg0 + (size_t)32 * NKEY * 2 + (kt_) * 128, sb_ + 12288); }
    const int q0 = b * SEQ + qb * 128 + wid * 32;
    u32x4 qf[2][2];
#pragma unroll
    for (int qt = 0; qt < 2; ++qt)
#pragma unroll
        for (int kk = 0; kk < 2; ++kk) qf[qt][kk] = *(const u32x4*)((const bf16_t*)(ws + OFF_QATT) + (size_t)(q0 + 16 * qt + fr) * 512 + head * 64 + 32 * kk + 8 * fq);
    f32x4 o[4][2];
#pragma unroll
    for (int dt = 0; dt < 4; ++dt) { o[dt][0] = (f32x4){0.f, 0.f, 0.f, 0.f}; o[dt][1] = (f32x4){0.f, 0.f, 0.f, 0.f}; }
    float gqm = fabsf(p.g_q[lane]), gkm = fabsf(p.g_k[lane]);
#pragma unroll
    for (int of2 = 1; of2 < 64; of2 <<= 1) { gqm = fmaxf(gqm, __shfl_xor(gqm, of2)); gkm = fmaxf(gkm, __shfl_xor(gkm, of2)); }
    const float Mst = 64.f * gqm * gkm * (0.125f * 1.4426950408889634f) * 1.01f;
    f32x4 lacc[2] = {(f32x4){0.f, 0.f, 0.f, 0.f}, (f32x4){0.f, 0.f, 0.f, 0.f}};
    const unsigned one2 = fr == 0 ? 0x3f803f80u : 0u;
    const u32x4 ones = (u32x4){one2, one2, one2, one2};
    const int sw = (fr >> 1) & 7;
    const unsigned lds0 = (unsigned)(size_t)((LDSP unsigned char*)smem);
    const unsigned k_rd = lds0 + fr * 128 + ((fq ^ sw) << 4);
    const unsigned v_rd = lds0 + 8192 + fr * 128 + (((fq >> 1) ^ sw) << 4) + (fq & 1) * 8;
    asm volatile("s_waitcnt vmcnt(0)" ::: "memory");
    __builtin_amdgcn_s_barrier();
    ATT_ISSUE(0) ATT_ISSUE(1) ATT_ISSUE(2)
    for (int kt = 0; kt < NCH; ++kt) {
        if (kt + 2 < NCH) asm volatile("s_waitcnt vmcnt(8)" ::: "memory");
        else if (kt + 1 < NCH) asm volatile("s_waitcnt vmcnt(4)" ::: "memory");
        else asm volatile("s_waitcnt vmcnt(0)" ::: "memory");
        __builtin_amdgcn_s_barrier();
        if (kt + 3 < NCH) ATT_ISSUE(kt + 3)
        const unsigned kb = k_rd + (kt & 3) * 16384, vb = v_rd + (kt & 3) * 16384;
        u32x4 k0, k1, k2, k3, k4, k5, k6, k7;
        asm volatile("ds_read_b128 %0, %1" : "=v"(k0) : "v"(kb));
        asm volatile("ds_read_b128 %0, %1 offset:2048" : "=v"(k1) : "v"(kb));
        asm volatile("ds_read_b128 %0, %1 offset:4096" : "=v"(k2) : "v"(kb));
        asm volatile("ds_read_b128 %0, %1 offset:6144" : "=v"(k3) : "v"(kb));
        asm volatile("ds_read_b128 %0, %1" : "=v"(k4) : "v"(kb ^ 64u));
        asm volatile("ds_read_b128 %0, %1 offset:2048" : "=v"(k5) : "v"(kb ^ 64u));
        asm volatile("ds_read_b128 %0, %1 offset:4096" : "=v"(k6) : "v"(kb ^ 64u));
        asm volatile("ds_read_b128 %0, %1 offset:6144" : "=v"(k7) : "v"(kb ^ 64u));
        asm volatile("s_waitcnt lgkmcnt(0)" : "+v"(k0), "+v"(k1), "+v"(k2), "+v"(k3), "+v"(k4), "+v"(k5), "+v"(k6), "+v"(k7));
        f32x4 s[4][2];
        const f32x4 z4 = (f32x4){-Mst, -Mst, -Mst, -Mst};
        s[0][0] = mfma16(k0, qf[0][0], z4); s[0][1] = mfma16(k0, qf[1][0], z4);
        s[1][0] = mfma16(k1, qf[0][0], z4); s[1][1] = mfma16(k1, qf[1][0], z4);
        s[2][0] = mfma16(k2, qf[0][0], z4); s[2][1] = mfma16(k2, qf[1][0], z4);
        s[3][0] = mfma16(k3, qf[0][0], z4); s[3][1] = mfma16(k3, qf[1][0], z4);
        s[0][0] = mfma16(k4, qf[0][1], s[0][0]); s[0][1] = mfma16(k4, qf[1][1], s[0][1]);
        s[1][0] = mfma16(k5, qf[0][1], s[1][0]); s[1][1] = mfma16(k5, qf[1][1], s[1][1]);
        s[2][0] = mfma16(k6, qf[0][1], s[2][0]); s[2][1] = mfma16(k6, qf[1][1], s[2][1]);
        s[3][0] = mfma16(k7, qf[0][1], s[3][0]); s[3][1] = mfma16(k7, qf[1][1], s[3][1]);
        u32x2 va[8], vbq[8];
#pragma unroll
        for (int kk = 0; kk < 2; ++kk)
#pragma unroll
            for (int dt = 0; dt < 4; ++dt) {
                const unsigned ad = (vb + dt * 2048) ^ (kk << 6);
                asm volatile("ds_read_b64 %0, %1" : "=v"(va[kk * 4 + dt]) : "v"(ad));
                asm volatile("ds_read_b64 %0, %1" : "=v"(vbq[kk * 4 + dt]) : "v"(ad ^ 32u));
            }
        u32x4 pf[2][2];
#pragma unroll
        for (int qt = 0; qt < 2; ++qt) {
#pragma unroll
            for (int ks = 0; ks < 4; ++ks)
#pragma unroll
                for (int j = 0; j < 4; ++j) s[ks][qt][j] = __builtin_amdgcn_exp2f(s[ks][qt][j]);
#pragma unroll
            for (int kk = 0; kk < 2; ++kk)
                pf[qt][kk] = (u32x4){pk_bf16_t(s[2 * kk][qt][0], s[2 * kk][qt][1]), pk_bf16_t(s[2 * kk][qt][2], s[2 * kk][qt][3]),
                                     pk_bf16_t(s[2 * kk + 1][qt][0], s[2 * kk + 1][qt][1]), pk_bf16_t(s[2 * kk + 1][qt][2], s[2 * kk + 1][qt][3])};
        }
        asm volatile("s_nop 1" ::: "memory");
        asm volatile("s_waitcnt lgkmcnt(0)" : "+v"(va[0]), "+v"(va[1]), "+v"(va[2]), "+v"(va[3]), "+v"(va[4]), "+v"(va[5]), "+v"(va[6]), "+v"(va[7]),
                     "+v"(vbq[0]), "+v"(vbq[1]), "+v"(vbq[2]), "+v"(vbq[3]), "+v"(vbq[4]), "+v"(vbq[5]), "+v"(vbq[6]), "+v"(vbq[7]));
#pragma unroll
        for (int kk = 0; kk < 2; ++kk)
#pragma unroll
            for (int dt = 0; dt < 4; ++dt) {
                const u32x4 vfr = (u32x4){va[kk * 4 + dt].x, va[kk * 4 + dt].y, vbq[kk * 4 + dt].x, vbq[kk * 4 + dt].y};
                o[dt][0] = mfma16(vfr, pf[0][kk], o[dt][0]); o[dt][1] = mfma16(vfr, pf[1][kk], o[dt][1]);
            }
        lacc[0] = mfma16(ones, pf[0][0], lacc[0]); lacc[0] = mfma16(ones, pf[0][1], lacc[0]);
        lacc[1] = mfma16(ones, pf[1][0], lacc[1]); lacc[1] = mfma16(ones, pf[1][1], lacc[1]);
    }
#undef ATT_ISSUE
#pragma unroll
    for (int qt = 0; qt < 2; ++qt) {
        const float l = __shfl(lacc[qt][0], fr);
        const float il = 1.f / l;
        bf16_t* dst = (bf16_t*)(ws + OFF_MIX) + (size_t)(q0 + 16 * qt + fr) * 1024 + head * 64 + 4 * fq;
#pragma unroll
        for (int dt = 0; dt < 4; ++dt) *(u32x2*)(dst + 16 * dt) = (u32x2){pk_bf16(o[dt][qt][0] * il, o[dt][qt][1] * il), pk_bf16(o[dt][qt][2] * il, o[dt][qt][3] * il)};
    }
}

DEVI void readout_phase(const Params& p) {
    const int lane = tidl() & 63, wid = tidl() >> 6;
    const bf16_t* of = (const bf16_t*)(p.ws + OFF_OB); const bf16_t* ob = of + (size_t)NLAT * 512;
    const bf16_t* gh = (const bf16_t*)(p.ws + OFF_GHG);
    bf16_t* mix = (bf16_t*)(p.ws + OFF_MIX);
    const f32x4 g0 = *(const f32x4*)(p.g_hg + (lane & 15) * 8), g1 = *(const f32x4*)(p.g_hg + (lane & 15) * 8 + 4);
    for (int t = blockIdx.x; t * 4 < NLAT; t += gridDim.x) {
        const size_t row = (size_t)t * 4 + wid;
        const u32x4 ua = *(const u32x4*)(of + row * 512 + lane * 8), ub = *(const u32x4*)(ob + row * 512 + lane * 8);
        const u32x4 gg = *(const u32x4*)(gh + row * 512 + lane * 8);
        f32x4 v0 = (f32x4){bflo(ua.x) + bflo(ub.x), bfhi(ua.x) + bfhi(ub.x), bflo(ua.y) + bflo(ub.y), bfhi(ua.y) + bfhi(ub.y)};
        f32x4 v1 = (f32x4){bflo(ua.z) + bflo(ub.z), bfhi(ua.z) + bfhi(ub.z), bflo(ua.w) + bflo(ub.w), bfhi(ua.w) + bfhi(ub.w)};
        float ss = v0[0] * v0[0] + v0[1] * v0[1] + v0[2] * v0[2] + v0[3] * v0[3] + v1[0] * v1[0] + v1[1] * v1[1] + v1[2] * v1[2] + v1[3] * v1[3];
        ss += __shfl_xor(ss, 1); ss += __shfl_xor(ss, 2); ss += __shfl_xor(ss, 4); ss += __shfl_xor(ss, 8);
        const float rstd = rsqrtf(ss * (1.f / 128.f) + EPS);
        v0 = v0 * rstd * g0; v1 = v1 * rstd * g1;
        *(u32x4*)(mix + row * 1024 + 512 + lane * 8) = (u32x4){pk_bf16(v0[0] * bflo(gg.x), v0[1] * bfhi(gg.x)), pk_bf16(v0[2] * bflo(gg.y), v0[3] * bfhi(gg.y)),
                                                              pk_bf16(v1[0] * bflo(gg.z), v1[1] * bfhi(gg.z)), pk_bf16(v1[2] * bflo(gg.w), v1[3] * bfhi(gg.w))};
    }
}

template <bool FUSE_NORM>
DEVI void epi_res(const Params& p, int mt, int nt, int wr, const f32x4 (&acc)[4][4], const float* res, float* dst, int gate_idx) {
    const float* mod = (const float*)(p.ws + OFF_MOD);
    const int lane = tidl() & 63, wid = tidl() >> 6, wc = wid & 1, fr = lane & 15, fq = lane >> 4;
    const int b = mt >> 5, col = nt * 128 + wc * 64 + 4 * fq;
    f32x4 gt[4], gs[4];
#pragma unroll
    for (int n = 0; n < 4; ++n) {
        gt[n] = *(const f32x4*)(mod + b * 6144 + gate_idx * 1024 + col + 16 * n);
        if (FUSE_NORM) gs[n] = *(const f32x4*)(p.g_norm2 + col + 16 * n) * (*(const f32x4*)(mod + b * 6144 + 4 * 1024 + col + 16 * n) + 1.f);
    }
#pragma unroll
    for (int m = 0; m < 4; ++m) {
        const int row = mt * 128 + wr * 64 + 16 * m + fr;
        float ss = 0.f;
#pragma unroll
        for (int n = 0; n < 4; ++n) {
            const size_t off = (size_t)row * DM + col + 16 * n;
            const f32x4 v = *(const f32x4*)(res + off) + gt[n] * acc[m][n];
            *(f32x4*)(dst + off) = v;
            if (FUSE_NORM) {
                ss += v[0] * v[0] + v[1] * v[1] + v[2] * v[2] + v[3] * v[3];
                const f32x4 hh = v * gs[n];
                *(u32x2*)((bf16_t*)(p.ws + OFF_A) + off) = (u32x2){pk_bf16(hh[0], hh[1]), pk_bf16(hh[2], hh[3])};
            }
        }
        if (FUSE_NORM) {
            ss += __shfl_xor(ss, 16); ss += __shfl_xor(ss, 32);
            if (fq == 0) atomicAdd((float*)(p.ws + OFF_RSS) + row, ss);
        }
    }
}
template <bool FUSE_NORM>
DEVI void phase_gemm_res(const Params& p, const bf16_t* A, int lda, const bf16_t* Bt, int K, const float* res, float* dst, int gate_idx, unsigned char* smem) {
    bool first = true; int g0 = 0;
    const int nbx = gridDim.x >> 3, wr = tidl() >> 7;
    for (int j = blockIdx.x >> 3; ; j += nbx) {
        int mt, nt, mtn, ntn;
        if (!xcd_tile2(j, 8, false, mt, nt)) break;
        const bool has_next = xcd_tile2(j + nbx, 8, false, mtn, ntn);
        f32x4 accL[4][4], accH[4][4];
        gemm2_tile(gemm2_src(A, lda, Bt, K, mt * 256, nt * 128), gemm2_src(A, lda, Bt, K, mtn * 256, ntn * 128), has_next, first, g0, lda, K, K, smem, accL, accH);
        first = false;
        epi_res<FUSE_NORM>(p, 2 * mt + wr, nt, 0, accL, res, dst, gate_idx);
        epi_res<FUSE_NORM>(p, 2 * mt + wr, nt, 1, accH, res, dst, gate_idx);
    }
}

DEVI void epi_gu(const Params& p, int mt, int nt, int wr, const f32x4 (&acc)[4][4]) {
    bf16_t* act = (bf16_t*)(p.ws + OFF_ACT);
    const int lane = tidl() & 63, wid = tidl() >> 6, wc = wid & 1, fr = lane & 15, fq = lane >> 4;
    const float* cg = (const float*)(p.ws + OFF_CGU) + (mt >> 5) * 2 * DFF + nt * 128 + wc * 64 + 4 * fq;
    f32x4 cb[4];
#pragma unroll
    for (int n = 0; n < 4; ++n) cb[n] = *(const f32x4*)(cg + 16 * n);
#pragma unroll
    for (int m = 0; m < 4; ++m) {
        const int row = mt * 128 + wr * 64 + 16 * m + fr;
        const float rstd = rsqrtf(((const float*)(p.ws + OFF_RSS))[row] * (1.f / DM) + EPS);
        bf16_t* dst = act + (size_t)row * DFF + nt * 64 + wc * 32 + 4 * fq;
#pragma unroll
        for (int n2 = 0; n2 < 2; ++n2) {
            const f32x4 a = acc[m][2 * n2] * rstd + cb[2 * n2], bq = acc[m][2 * n2 + 1] * rstd + cb[2 * n2 + 1];
            *(u32x2*)(dst + 16 * n2) = (u32x2){pk_bf16(siluf(a[0]) * bq[0], siluf(a[1]) * bq[1]), pk_bf16(siluf(a[2]) * bq[2], siluf(a[3]) * bq[3])};
        }
    }
}
DEVI void phase_gemm_gu(const Params& p, unsigned char* smem) {
    const bf16_t* A = (const bf16_t*)(p.ws + OFF_A);
    const bf16_t* Bt = (const bf16_t*)(p.ws + OFF_WGU);
    bool first = true; int g0 = 0;
    const int nbx = gridDim.x >> 3, wr = tidl() >> 7;
    for (int j = blockIdx.x >> 3; ; j += nbx) {
        int mt, nt, mtn, ntn;
        if (!xcd_tile2(j, 44, false, mt, nt)) break;
        const bool has_next = xcd_tile2(j + nbx, 44, false, mtn, ntn);
        f32x4 accL[4][4], accH[4][4];
        gemm2_tile(gemm2_src(A, DM, Bt, DM, mt * 256, nt * 128), gemm2_src(A, DM, Bt, DM, mtn * 256, ntn * 128), has_next, first, g0, DM, DM, DM, smem, accL, accH);
        first = false;
        epi_gu(p, 2 * mt + wr, nt, 0, accL);
        epi_gu(p, 2 * mt + wr, nt, 1, accH);
    }
}

DEVI void final_norm_phase(const Params& p) {
    const int lane = tidl() & 63, wid = tidl() >> 6;
    for (int t = blockIdx.x; t * 4 < NLAT; t += gridDim.x) {
        const float* srow = (const float*)(p.ws + OFF_X1) + ((size_t)t * 4 + wid) * DM;
        float* row = p.out + ((size_t)t * 4 + wid) * DM;
        f32x4 v[4]; float ss = 0.f;
#pragma unroll
        for (int i = 0; i < 4; ++i) { v[i] = *(const f32x4*)(srow + lane * 4 + 256 * i); ss += v[i][0] * v[i][0] + v[i][1] * v[i][1] + v[i][2] * v[i][2] + v[i][3] * v[i][3]; }
        ss = wave_sum(ss);
        const float rstd = rsqrtf(ss * (1.f / DM) + EPS);
#pragma unroll
        for (int i = 0; i < 4; ++i) { const f32x4 gg = *(const f32x4*)(p.g_final + lane * 4 + 256 * i); *(f32x4*)(row + lane * 4 + 256 * i) = v[i] * rstd * gg; }
    }
}


#define XB_TMO      128
#define XB_XCNT(j)  (256  + 64 * (j))
#define XB_XSUB(j)  (1280 + 64 * (j))
#define XB_XGEN(j)  (2304 + 64 * (j))
#define XB_TOP      3328
#define XB_TOPGEN   3392
#define XB_SPIN_CAP (1u << 22)
#define LAS __attribute__((address_space(3)))
DEVI unsigned xb_ld(unsigned* p)              { return __hip_atomic_load(p, __ATOMIC_RELAXED, __HIP_MEMORY_SCOPE_AGENT); }
DEVI unsigned xb_add(unsigned* p, unsigned v) { return __hip_atomic_fetch_add(p, v, __ATOMIC_RELAXED, __HIP_MEMORY_SCOPE_AGENT); }
DEVI unsigned xb_xcc_id() { return (unsigned)__builtin_amdgcn_s_getreg((3 << 11) | 20) & 0xFu; }
#define XB_SPIN(cond, bar) do { unsigned _sp = 0; while (cond) { __builtin_amdgcn_s_sleep(1); \
    if ((++_sp & 255u) == 0u) { if (xb_ld(&(bar)[XB_TMO])) break; if (_sp > XB_SPIN_CAP) { atomicAdd(&(bar)[XB_TMO], 1u); break; } } } } while (0)
struct XcdBarrier { unsigned* bar; unsigned x; volatile unsigned* st; };
DEVI XcdBarrier xcd_barrier_post(unsigned* bar, volatile unsigned* st) {
    XcdBarrier b; b.bar = bar; b.x = xb_xcc_id(); b.st = st;
    if (threadIdx.x == 0) (void)xb_add(&bar[XB_XCNT(b.x)], 1u);
    return b;
}
DEVI void xcd_barrier_complete(unsigned* bar, unsigned x, unsigned& nloc, unsigned& nx) {
    const unsigned G = gridDim.x * gridDim.y * gridDim.z;
    unsigned sum, cnt, mine, sp = 0u;
    for (;;) {
        sum = 0u; cnt = 0u; mine = 0u;
#pragma unroll
        for (unsigned j = 0; j < 16; ++j) { const unsigned c = xb_ld(&bar[XB_XCNT(j)]); sum += c; cnt += (c > 0u) ? 1u : 0u; mine = (j == x) ? c : mine; }
        if (sum == G) break;
        __builtin_amdgcn_s_sleep(1);
        if ((++sp & 255u) == 0u) { if (xb_ld(&bar[XB_TMO])) break; if (sp > XB_SPIN_CAP) { atomicAdd(&bar[XB_TMO], 1u); break; } }
    }
    nloc = mine > 0u ? mine : 1u; nx = cnt > 0u ? cnt : 1u;
}
DEVI void xcd_barrier(const XcdBarrier& b) {
    asm volatile("s_waitcnt vmcnt(0)" ::: "memory");
    __syncthreads();
    if (threadIdx.x == 0) {
        unsigned* bar = b.bar;
        __builtin_amdgcn_s_waitcnt(0);
        unsigned nloc = b.st[0], nx = b.st[1];
        if (nloc == 0u) { xcd_barrier_complete(bar, b.x, nloc, nx); b.st[0] = nloc; b.st[1] = nx; }
        const unsigned old = xb_add(&bar[XB_XSUB(b.x)], 1u);
        const unsigned gen = old / nloc;
        if (old + 1u == (gen + 1u) * nloc) {
            __builtin_amdgcn_fence(__ATOMIC_RELEASE, "agent");
            asm volatile("s_waitcnt vmcnt(0)" ::: "memory");
            const unsigned og = xb_add(&bar[XB_TOP], 1u);
            const unsigned tg = og / nx;
            if (og + 1u == (tg + 1u) * nx) xb_add(&bar[XB_TOPGEN], 1u);
            else XB_SPIN(xb_ld(&bar[XB_TOPGEN]) == tg, bar);
            __builtin_amdgcn_fence(__ATOMIC_ACQUIRE, "agent");
            xb_add(&bar[XB_XGEN(b.x)], 1u);
            asm volatile("s_waitcnt vmcnt(0)" ::: "memory");
        } else {
            XB_SPIN(xb_ld(&bar[XB_XGEN(b.x)]) == gen, bar);
            __builtin_amdgcn_fence(__ATOMIC_ACQUIRE, "agent");
            asm volatile("s_waitcnt vmcnt(0)" ::: "memory");
        }
    }
    __syncthreads();
}

#define GRID_SYNC() xcd_barrier(xb)

__global__ void __launch_bounds__(256, 2) hymba_fwd(Params p) {
    __shared__ __attribute__((aligned(16))) unsigned char smem[73728];
    __shared__ int s_item;
    __shared__ unsigned xb_st[4];
    if (threadIdx.x < 4) xb_st[threadIdx.x] = 0u;
    __syncthreads();
    const XcdBarrier xb = xcd_barrier_post((unsigned*)p.ws, xb_st);
    unsigned char* ws = p.ws;
    const float* mod = (const float*)(ws + OFF_MOD);

    phase0(p, smem);
    GRID_SYNC();
    norm_mod_phase(p.x, p.ctx, (bf16_t*)(ws + OFF_A), p.g_norm1, mod, 0, 1, MROWS);
    late_transposes(p, smem);
    GRID_SYNC();
    phase_gemm_in(p, smem);
    GRID_SYNC();
    for (int t = blockIdx.x; t < NTASK; t += gridDim.x) hg_prep_task(p, t, smem);
    GRID_SYNC();
    if (blockIdx.x < 64) scan_block(p, blockIdx.x, smem);
    for (;;) {
        __syncthreads();
        if (threadIdx.x == 0) s_item = (int)atomicAdd((unsigned*)(ws + OFF_CNT), 1u);
        __syncthreads();
        const int item = s_item;
        if (item >= 1024) break;
        attn_item(p, item, smem);
    }
    GRID_SYNC();
    readout_phase(p);
    cgu_phase(p);
    GRID_SYNC();
    phase_gemm_res<true>(p, (const bf16_t*)(ws + OFF_MIX), DM, (const bf16_t*)(ws + OFF_WOUT), DM, p.x, (float*)(ws + OFF_X1), 2, smem);
    GRID_SYNC();
    phase_gemm_gu(p, smem);
    GRID_SYNC();
    phase_gemm_res<false>(p, (const bf16_t*)(ws + OFF_ACT), DFF, (const bf16_t*)(ws + OFF_WDN), DFF, (const float*)(ws + OFF_X1), (float*)(ws + OFF_X1), 5, smem);
    GRID_SYNC();
    final_norm_phase(p);
}

extern "C" void kernel_launch(void* const* d_in, const int* in_sizes, int n_in, void* d_out, int out_size, void* d_ws, size_t ws_size, hipStream_t stream) {
    static int grid_blocks = 0;
    if (!grid_blocks) {
        int dev = 0, cus = 0, per_cu = 0;
        hipGetDevice(&dev);
        hipDeviceGetAttribute(&cus, hipDeviceAttributeMultiprocessorCount, dev);
        hipOccupancyMaxActiveBlocksPerMultiprocessor(&per_cu, hymba_fwd, 256, 0);
        if (per_cu > 2) per_cu = 2;
        if (per_cu < 1) per_cu = 1;
        grid_blocks = cus * per_cu;
    }
    if (ws_size < WS_NEED) { fprintf(stderr, "workspace too small: %zu < %zu\n", ws_size, (size_t)WS_NEED); return; }
    Params p{};
    p.x = (const float*)d_in[0]; p.c = (const float*)d_in[1]; p.ctx = (const float*)d_in[2]; p.c_ctx = (const float*)d_in[3];
    p.w_mod = (const float*)d_in[4]; p.b_mod = (const float*)d_in[5]; p.g_norm1 = (const float*)d_in[6]; p.w_in = (const float*)d_in[7];
    p.g_q = (const float*)d_in[8]; p.g_k = (const float*)d_in[9]; p.lb_raw = (const float*)d_in[10]; p.g_hg = (const float*)d_in[11];
    p.w_out = (const float*)d_in[12]; p.g_norm2 = (const float*)d_in[13]; p.w_gu = (const float*)d_in[14]; p.w_down = (const float*)d_in[15];
    p.g_final = (const float*)d_in[16];
    p.out = (float*)d_out; p.ws = (unsigned char*)d_ws;
    hipMemsetAsync(d_ws, 0, 32768, stream);
    void* args[] = {&p};
    hipError_t e = hipLaunchCooperativeKernel((void*)hymba_fwd, dim3(grid_blocks), dim3(256), args, 0, stream);
    if (e != hipSuccess) fprintf(stderr, "cooperative launch failed: %s (grid %d)\n", hipGetErrorString(e), grid_blocks);
}
```

```cpp
#include <hip/hip_runtime.h>
#include <hip/hip_cooperative_groups.h>
#include <cstdio>
#include <cstdint>
namespace cg = cooperative_groups;

#define DEVI __device__ __forceinline__
typedef unsigned short bf16_t;
typedef short bf16x8 __attribute__((ext_vector_type(8)));
typedef float f32x4 __attribute__((ext_vector_type(4)));
typedef unsigned u32x4 __attribute__((ext_vector_type(4)));
typedef unsigned u32x2 __attribute__((ext_vector_type(2)));

constexpr int DM = 1024, NB = 4, SEQ = 4096, CTX = 256, NLAT = NB * SEQ, NCTX = NB * CTX, MROWS = NLAT + NCTX;
constexpr int NKEY = CTX + SEQ;
constexpr int INC = 3328, DFF = 2816, NCH = NKEY / 64;
constexpr int NTASK = NB * 4 * 2 * NCH;
constexpr float EPS = 1e-6f;

constexpr size_t OFF_CNT = 16384;
constexpr size_t OFF_MOD = 32768;
constexpr size_t OFF_LB = OFF_MOD + 122880;
constexpr size_t OFF_WIN = OFF_LB + 4096;
constexpr size_t OFF_WOUT = OFF_WIN + 6815744;
constexpr size_t OFF_WGU = OFF_WOUT + 2097152;
constexpr size_t OFF_WDN = OFF_WGU + 11534336;
constexpr size_t OFF_A = OFF_WDN + 5767168;
constexpr size_t OFF_QATT = OFF_A + 35651584;
constexpr size_t OFF_KATT = OFF_QATT + 16777216;
constexpr size_t OFF_VATT = OFF_KATT + 4456448;
constexpr size_t OFF_QHG = OFF_VATT + 4456448;
constexpr size_t OFF_VHG = OFF_QHG + 17825792;
constexpr size_t OFF_LFC = OFF_VHG + 17825792;
constexpr size_t OFF_GHG = OFF_LFC + 4194304;
constexpr size_t OFF_KT = OFF_GHG + 16777216;
constexpr size_t OFF_AM = OFF_KT + 35651584;
constexpr size_t OFF_DV = OFF_AM + 17825792;
constexpr size_t OFF_MIX = OFF_DV + 3342336;
constexpr size_t OFF_END1 = OFF_MIX + 33554432;
constexpr size_t OFF_LF = OFF_MIX;
constexpr size_t OFF_OB = OFF_END1;
constexpr size_t OFF_END3 = OFF_OB + 33554432;
constexpr size_t OFF_RSS = OFF_END3;
constexpr size_t OFF_CGU = OFF_RSS + 65536;
static_assert(OFF_CGU + 90112 <= 268435456, "workspace over 256 MiB");
static_assert(OFF_LF + 67108864 <= 268435456 && OFF_END3 <= 268435456, "workspace over 256 MiB");
constexpr size_t OFF_X1 = OFF_QATT;
constexpr size_t OFF_ACT = OFF_X1 + 67108864;
constexpr size_t OFF_END2 = OFF_ACT + 92274688;
constexpr size_t WS_NEED = 268435456;
static_assert(WS_NEED <= 268435456, "workspace over 256 MiB");

struct Params {
    const float *x, *c, *ctx, *c_ctx, *w_mod, *b_mod, *g_norm1, *w_in, *g_q, *g_k, *lb_raw, *g_hg, *w_out, *g_norm2, *w_gu, *w_down, *g_final;
    float* out; unsigned char* ws;
};

DEVI unsigned pk_bf16(float lo, float hi) { unsigned r; asm("v_cvt_pk_bf16_f32 %0, %1, %2" : "=v"(r) : "v"(lo), "v"(hi)); return r; }
DEVI unsigned pk_bf16_t(float lo, float hi) { unsigned r; asm("s_nop 1\n\tv_cvt_pk_bf16_f32 %0, %1, %2" : "=v"(r) : "v"(lo), "v"(hi)); return r; }
DEVI unsigned pk_bf16_m(float lo, float hi) { unsigned r; asm("v_cvt_pk_bf16_f32 %0, %1, %2\n\ts_nop 1" : "=v"(r) : "v"(lo), "v"(hi)); return r; }
DEVI void mfma_settle() { asm volatile("s_nop 7\n\ts_nop 7" ::: "memory"); }
DEVI float bf2f(bf16_t h) { return __uint_as_float(((unsigned)h) << 16); }
DEVI float bflo(unsigned u) { return __uint_as_float(u << 16); }
DEVI float bfhi(unsigned u) { return __uint_as_float(u & 0xffff0000u); }
DEVI float siluf(float v) { return v * __builtin_amdgcn_rcpf(1.f + __expf(-v)); }
DEVI f32x4 mfma16(u32x4 a, u32x4 b, f32x4 c) {
    return __builtin_amdgcn_mfma_f32_16x16x32_bf16(__builtin_bit_cast(bf16x8, a), __builtin_bit_cast(bf16x8, b), c, 0, 0, 0);
}
DEVI int tidl() { int t = (int)threadIdx.x; asm volatile("" : "+v"(t)); return t; }
DEVI float wave_sum(float v) {
#pragma unroll
    for (int o = 1; o < 64; o <<= 1) v += __shfl_xor(v, o);
    return v;
}

DEVI void p0_transpose(const float* __restrict__ W, int ldw, bf16_t* __restrict__ Wt, int ldt, int k0, int n0, int gu, unsigned char* smem) {
    float* tile = (float*)smem;
    const int tid = tidl();
#pragma unroll
    for (int i = 0; i < 4; ++i) {
        const int kr = (tid >> 4) + 16 * i, nc = (tid & 15) * 4;
        const f32x4 v = *(const f32x4*)(W + (size_t)(k0 + kr) * ldw + n0 + nc);
        tile[kr * 65 + nc + 0] = v[0]; tile[kr * 65 + nc + 1] = v[1]; tile[kr * 65 + nc + 2] = v[2]; tile[kr * 65 + nc + 3] = v[3];
    }
    __syncthreads();
    const int nl = tid >> 2, kc = (tid & 3) * 16;
    unsigned w[8];
#pragma unroll
    for (int i = 0; i < 8; ++i) w[i] = pk_bf16(tile[(kc + 2 * i) * 65 + nl], tile[(kc + 2 * i + 1) * 65 + nl]);
    const int n = n0 + nl; int nrow = n;
    if (gu) { const int isB = n >= DFF; const int jj = isB ? n - DFF : n; nrow = (jj >> 4) * 32 + (jj & 15) + (isB ? 16 : 0); }
    u32x4* dst = (u32x4*)(Wt + (size_t)nrow * ldt + k0 + kc);
    dst[0] = (u32x4){w[0], w[1], w[2], w[3]}; dst[1] = (u32x4){w[4], w[5], w[6], w[7]};
    __syncthreads();
}

DEVI void p0_mod(const Params& p, int tsk, unsigned char* smem) {
    float* sc = (float*)smem;
    float* red = sc + 5 * 1024;
    float* mod = (float*)(p.ws + OFF_MOD);
    const int tid = tidl();
    for (int idx = tid; idx < 5120; idx += 256) { const int r = idx >> 10, k = idx & 1023; const float v = r < 4 ? p.c[r * 1024 + k] : p.c_ctx[k]; sc[idx] = siluf(v); }
    __syncthreads();
    const int cl = tid & 31, kp = tid >> 5, col = tsk * 32 + cl;
    float a0 = 0.f, a1 = 0.f, a2 = 0.f, a3 = 0.f, a4 = 0.f;
#pragma unroll 16
    for (int k = kp * 128; k < kp * 128 + 128; ++k) {
        const float w = p.w_mod[(size_t)k * 6144 + col];
        a0 += sc[k] * w; a1 += sc[1024 + k] * w; a2 += sc[2048 + k] * w; a3 += sc[3072 + k] * w; a4 += sc[4096 + k] * w;
    }
    red[(kp * 5 + 0) * 32 + cl] = a0; red[(kp * 5 + 1) * 32 + cl] = a1; red[(kp * 5 + 2) * 32 + cl] = a2; red[(kp * 5 + 3) * 32 + cl] = a3; red[(kp * 5 + 4) * 32 + cl] = a4;
    __syncthreads();
    if (tid < 160) { const int r = tid >> 5, c2 = tid & 31; float s = 0.f;
#pragma unroll
        for (int q = 0; q < 8; ++q) s += red[(q * 5 + r) * 32 + c2];
        mod[r * 6144 + tsk * 32 + c2] = s + p.b_mod[tsk * 32 + c2]; }
    __syncthreads();
}

DEVI void phase0(const Params& p, unsigned char* smem) {
    constexpr int T_MOD = 192, T_IN = 16 * 52;
    constexpr int E0 = T_MOD + 1, E1 = E0 + T_IN;
    for (int t = blockIdx.x; t < E1; t += gridDim.x) {
        if (t < T_MOD) { p0_mod(p, t, smem); }
        else if (t == T_MOD) {
            float* lb = (float*)(p.ws + OFF_LB);
            for (int i = tidl(); i < 1024; i += 256) lb[i] = 1.f / (1.f + __expf(p.lb_raw[1024 + i] - p.lb_raw[i]));
            float* rss = (float*)(p.ws + OFF_RSS);
            for (int i = tidl(); i < NLAT; i += 256) rss[i] = 0.f;
        }
        else { const int u = t - E0, kt = u / 52, nt = u % 52; p0_transpose(p.w_in, INC, (bf16_t*)(p.ws + OFF_WIN), 1024, kt * 64, nt * 64, 0, smem); }
    }
}
DEVI void late_transposes(const Params& p, unsigned char* smem) {
    constexpr int T_OUT = 16 * 16, T_GU = 16 * 88, T_DN = 44 * 16;
    constexpr int E2 = T_OUT, E3 = E2 + T_GU, E4 = E3 + T_DN;
    for (int t = blockIdx.x; t < E4; t += gridDim.x) {
        if (t < E2) { const int kt = t / 16, nt = t % 16; p0_transpose(p.w_out, 1024, (bf16_t*)(p.ws + OFF_WOUT), 1024, kt * 64, nt * 64, 0, smem); }
        else if (t < E3) { const int u = t - E2, kt = u / 88, nt = u % 88; p0_transpose(p.w_gu, 2 * DFF, (bf16_t*)(p.ws + OFF_WGU), 1024, kt * 64, nt * 64, 1, smem); }
        else { const int u = t - E3, kt = u / 16, nt = u % 16; p0_transpose(p.w_down, 1024, (bf16_t*)(p.ws + OFF_WDN), DFF, kt * 64, nt * 64, 0, smem); }
    }
}

DEVI void norm_mod_phase(const float* __restrict__ src_lat, const float* __restrict__ src_ctx, bf16_t* __restrict__ dst, const float* __restrict__ g,
                         const float* __restrict__ mod, int shift_idx, int scale_idx, int nrows) {
    const int lane = tidl() & 63, wid = tidl() >> 6;
    for (int t = blockIdx.x; t * 4 < nrows; t += gridDim.x) {
        const int row = t * 4 + wid;
        const float* src = row < NLAT ? src_lat + (size_t)row * DM : src_ctx + (size_t)(row - NLAT) * DM;
        const int mrow = row < NLAT ? (row >> 12) : 4;
        f32x4 v[4]; float ss = 0.f;
#pragma unroll
        for (int i = 0; i < 4; ++i) { v[i] = *(const f32x4*)(src + lane * 4 + 256 * i); ss += v[i][0] * v[i][0] + v[i][1] * v[i][1] + v[i][2] * v[i][2] + v[i][3] * v[i][3]; }
        ss = wave_sum(ss);
        const float rstd = rsqrtf(ss * (1.f / DM) + EPS);
#pragma unroll
        for (int i = 0; i < 4; ++i) {
            const int col = lane * 4 + 256 * i;
            const f32x4 gg = *(const f32x4*)(g + col), sh = *(const f32x4*)(mod + mrow * 6144 + shift_idx * 1024 + col), sc = *(const f32x4*)(mod + mrow * 6144 + scale_idx * 1024 + col);
            f32x4 h;
#pragma unroll
            for (int j = 0; j < 4; ++j) h[j] = v[i][j] * rstd * gg[j] * (1.f + sc[j]) + sh[j];
            *(u32x2*)(dst + (size_t)row * DM + col) = (u32x2){pk_bf16(h[0], h[1]), pk_bf16(h[2], h[3])};
        }
    }
}


DEVI void cgu_phase(const Params& p) {
    const int lane = tidl() & 63, wid = tidl() >> 6;
    const float* mod = (const float*)(p.ws + OFF_MOD);
    const bf16_t* W = (const bf16_t*)(p.ws + OFF_WGU);
    float* cgu = (float*)(p.ws + OFF_CGU);
    for (int t = blockIdx.x; t * 4 < 2 * DFF; t += gridDim.x) {
        const int n = t * 4 + wid;
        const u32x4 w0 = *(const u32x4*)(W + (size_t)n * DM + lane * 16), w1 = *(const u32x4*)(W + (size_t)n * DM + lane * 16 + 8);
        float wv[16] = {bflo(w0.x), bfhi(w0.x), bflo(w0.y), bfhi(w0.y), bflo(w0.z), bfhi(w0.z), bflo(w0.w), bfhi(w0.w),
                        bflo(w1.x), bfhi(w1.x), bflo(w1.y), bfhi(w1.y), bflo(w1.z), bfhi(w1.z), bflo(w1.w), bfhi(w1.w)};
#pragma unroll
        for (int b = 0; b < 4; ++b) {
            const float* sh = mod + b * 6144 + 3 * 1024 + lane * 16;
            float s = 0.f;
#pragma unroll
            for (int q = 0; q < 4; ++q) { const f32x4 sv = *(const f32x4*)(sh + 4 * q); s += sv[0] * wv[4 * q] + sv[1] * wv[4 * q + 1] + sv[2] * wv[4 * q + 2] + sv[3] * wv[4 * q + 3]; }
            s = wave_sum(s);
            if (lane == 0) cgu[b * 2 * DFF + n] = s;
        }
    }
}

#define LDSP __attribute__((address_space(3)))
#define GLBP __attribute__((address_space(1)))
DEVI void glds16(const void* g, unsigned char* l) {
    __builtin_amdgcn_global_load_lds((const GLBP void*)g, (LDSP void*)l, 16, 0, 0);
}
struct GTile2 { const bf16_t* ga; const bf16_t* gb; };
DEVI GTile2 gemm2_src(const bf16_t* A, int lda, const bf16_t* Bt, int ldb, int row0, int col0) {
    const int tid = tidl(), sr = tid >> 2, scn = (tid & 3) ^ ((tid >> 4) & 3);
    GTile2 t; t.ga = A + (size_t)(row0 + sr) * lda + scn * 8; t.gb = Bt + (size_t)(col0 + sr) * ldb + scn * 8; return t;
}
#define G2_ISSUE_T(T, kt_, slot_) { unsigned char* sb_ = smem + (slot_) * 24576 + st_off; const int ko_ = (kt_) * 32; \
        glds16(T.ga + ko_, sb_); glds16(T.ga + a64 + ko_, sb_ + 4096); glds16(T.ga + 2 * a64 + ko_, sb_ + 8192); glds16(T.ga + 3 * a64 + ko_, sb_ + 12288); \
        glds16(T.gb + ko_, sb_ + 16384); glds16(T.gb + b64 + ko_, sb_ + 20480); }
DEVI int mod3(int v) { return v >= 6 ? v - 6 : (v >= 3 ? v - 3 : v); }
DEVI void gemm2_tile(const GTile2 cur, const GTile2 nxt, const bool has_next, const bool first, int& g0, int lda, int ldb, int K, unsigned char* smem,
                     f32x4 (&accL)[4][4], f32x4 (&accH)[4][4]) {
    const int tid = tidl(), lane = tid & 63, wid = tid >> 6, wr = wid >> 1, wc = wid & 1, fr = lane & 15, fq = lane >> 4;
    const size_t a64 = (size_t)64 * lda, b64 = (size_t)64 * ldb;
    const int st_off = tid * 16;
    const int sw = (fr >> 2) & 3;
    const unsigned lds0 = (unsigned)(size_t)((LDSP unsigned char*)smem);
    const unsigned a_rd = lds0 + (wr * 128 + fr) * 64 + ((fq ^ sw) << 4);
    const unsigned b_rd = lds0 + 16384 + (wc * 64 + fr) * 64 + ((fq ^ sw) << 4);
#pragma unroll
    for (int m = 0; m < 4; ++m)
#pragma unroll
        for (int n = 0; n < 4; ++n) { accL[m][n] = (f32x4){0.f, 0.f, 0.f, 0.f}; accH[m][n] = (f32x4){0.f, 0.f, 0.f, 0.f}; }
    const int nk = K >> 5;
    if (first) {
        asm volatile("s_waitcnt vmcnt(0)" ::: "memory");
        __builtin_amdgcn_s_barrier();
        G2_ISSUE_T(cur, 0, mod3(g0)) G2_ISSUE_T(cur, 1, mod3(g0 + 1))
    }
    int slot = mod3(g0);
    for (int s = 0; s < nk; ++s) {
        if (has_next || s + 1 < nk) asm volatile("s_waitcnt vmcnt(6)" ::: "memory");
        else asm volatile("s_waitcnt vmcnt(0)" ::: "memory");
        __builtin_amdgcn_s_barrier();
        { const int s2 = s + 2; const int sl2 = mod3(slot + 2);
          if (s2 < nk) G2_ISSUE_T(cur, s2, sl2) else if (has_next) G2_ISSUE_T(nxt, s2 - nk, sl2) }
        const unsigned sa = a_rd + slot * 24576, sb = b_rd + slot * 24576;
        u32x4 a0, a1, a2, a3, a4, a5, a6, a7, b0, b1, b2, b3;
        asm volatile("ds_read_b128 %0, %1" : "=v"(a0) : "v"(sa)); asm volatile("ds_read_b128 %0, %1 offset:1024" : "=v"(a1) : "v"(sa));
        asm volatile("ds_read_b128 %0, %1 offset:2048" : "=v"(a2) : "v"(sa)); asm volatile("ds_read_b128 %0, %1 offset:3072" : "=v"(a3) : "v"(sa));
        asm volatile("ds_read_b128 %0, %1" : "=v"(b0) : "v"(sb)); asm volatile("ds_read_b128 %0, %1 offset:1024" : "=v"(b1) : "v"(sb));
        asm volatile("ds_read_b128 %0, %1 offset:2048" : "=v"(b2) : "v"(sb)); asm volatile("ds_read_b128 %0, %1 offset:3072" : "=v"(b3) : "v"(sb));
        asm volatile("ds_read_b128 %0, %1 offset:4096" : "=v"(a4) : "v"(sa)); asm volatile("ds_read_b128 %0, %1 offset:5120" : "=v"(a5) : "v"(sa));
        asm volatile("ds_read_b128 %0, %1 offset:6144" : "=v"(a6) : "v"(sa)); asm volatile("ds_read_b128 %0, %1 offset:7168" : "=v"(a7) : "v"(sa));
        asm volatile("s_waitcnt lgkmcnt(4)" : "+v"(a0), "+v"(a1), "+v"(a2), "+v"(a3), "+v"(b0), "+v"(b1), "+v"(b2), "+v"(b3));
        accL[0][0] = mfma16(b0, a0, accL[0][0]); accL[0][1] = mfma16(b1, a0, accL[0][1]); accL[0][2] = mfma16(b2, a0, accL[0][2]); accL[0][3] = mfma16(b3, a0, accL[0][3]);
        accL[1][0] = mfma16(b0, a1, accL[1][0]); accL[1][1] = mfma16(b1, a1, accL[1][1]); accL[1][2] = mfma16(b2, a1, accL[1][2]); accL[1][3] = mfma16(b3, a1, accL[1][3]);
        accL[2][0] = mfma16(b0, a2, accL[2][0]); accL[2][1] = mfma16(b1, a2, accL[2][1]); accL[2][2] = mfma16(b2, a2, accL[2][2]); accL[2][3] = mfma16(b3, a2, accL[2][3]);
        accL[3][0] = mfma16(b0, a3, accL[3][0]); accL[3][1] = mfma16(b1, a3, accL[3][1]); accL[3][2] = mfma16(b2, a3, accL[3][2]); accL[3][3] = mfma16(b3, a3, accL[3][3]);
        asm volatile("s_waitcnt lgkmcnt(0)" : "+v"(a4), "+v"(a5), "+v"(a6), "+v"(a7), "+v"(b0), "+v"(b1), "+v"(b2), "+v"(b3));
        accH[0][0] = mfma16(b0, a4, accH[0][0]); accH[0][1] = mfma16(b1, a4, accH[0][1]); accH[0][2] = mfma16(b2, a4, accH[0][2]); accH[0][3] = mfma16(b3, a4, accH[0][3]);
        accH[1][0] = mfma16(b0, a5, accH[1][0]); accH[1][1] = mfma16(b1, a5, accH[1][1]); accH[1][2] = mfma16(b2, a5, accH[1][2]); accH[1][3] = mfma16(b3, a5, accH[1][3]);
        accH[2][0] = mfma16(b0, a6, accH[2][0]); accH[2][1] = mfma16(b1, a6, accH[2][1]); accH[2][2] = mfma16(b2, a6, accH[2][2]); accH[2][3] = mfma16(b3, a6, accH[2][3]);
        accH[3][0] = mfma16(b0, a7, accH[3][0]); accH[3][1] = mfma16(b1, a7, accH[3][1]); accH[3][2] = mfma16(b2, a7, accH[3][2]); accH[3][3] = mfma16(b3, a7, accH[3][3]);
        slot = mod3(slot + 1);
    }
    g0 = slot;
}
DEVI bool xcd_tile2(int j, int NT, bool ctx, int& mt, int& nt) {
    const int x = blockIdx.x & 7, band = 8 * NT;
    if (j < band) { nt = j >> 3; mt = 8 * x + (j & 7); return true; }
    const int u = j - band;
    if (ctx && u < 9) { const int w = x * 9 + u; mt = 64 + w / 18; nt = 4 + w % 18; return true; }
    mt = 0; nt = 0; return false;
}

DEVI void epi_in(const Params& p, int mt, int nt, int wr, const f32x4 (&acc)[4][4]) {
    const int lane = tidl() & 63, wid = tidl() >> 6, wc = wid & 1, fr = lane & 15, fq = lane >> 4;
    const int row0 = mt * 128 + wr * 64 + fr;
    const bool lat = mt < 128;
    const int b = lat ? (mt >> 5) : ((mt - 128) >> 1);
    const int ntok0 = lat ? (CTX + ((mt & 31) * 128 + wr * 64 + fr)) : (((mt - 128) & 1) * 128 + wr * 64 + fr);
    unsigned char* ws = p.ws;
    if (nt < 5) {
        const bool isq = nt < 4;
        const float* gg = isq ? p.g_q : p.g_k;
        f32x4 gv[4];
#pragma unroll
        for (int n = 0; n < 4; ++n) gv[n] = *(const f32x4*)(gg + 16 * n + 4 * fq);
        float inv[4];
#pragma unroll
        for (int j = 0; j < 4; ++j) inv[j] = exp2f(-(float)(4 * fq + j) * (13.287712379549449f / 16.f));
        const float osc = isq ? 0.125f * 1.4426950408889634f : 1.f;
#pragma unroll
        for (int m = 0; m < 4; ++m) {
            float ss = 0.f;
#pragma unroll
            for (int n = 0; n < 4; ++n) ss += acc[m][n][0] * acc[m][n][0] + acc[m][n][1] * acc[m][n][1] + acc[m][n][2] * acc[m][n][2] + acc[m][n][3] * acc[m][n][3];
            ss += __shfl_xor(ss, 16); ss += __shfl_xor(ss, 32);
            const float rstd = rsqrtf(ss * (1.f / 64.f) + EPS);
            f32x4 v[4];
#pragma unroll
            for (int n = 0; n < 4; ++n) v[n] = acc[m][n] * rstd * gv[n];
            if (lat) {
                const int t = (mt & 31) * 128 + wr * 64 + fr + 16 * m;
                const float pr = (float)(t >> 6), pc = (float)(t & 63);
#pragma unroll
                for (int a = 0; a < 2; ++a) {
                    const float pos = a == 0 ? pr : pc;
#pragma unroll
                    for (int j = 0; j < 4; ++j) {
                        const float ang = pos * inv[j]; const float cs = __cosf(ang), sn = __sinf(ang);
                        const float x0 = v[2 * a][j], x1 = v[2 * a + 1][j];
                        v[2 * a][j] = x0 * cs - x1 * sn; v[2 * a + 1][j] = x1 * cs + x0 * sn;
                    }
                }
            }
            bf16_t* dst;
            if (isq) dst = (bf16_t*)(ws + OFF_QATT) + (size_t)(row0 + 16 * m) * 512 + (nt * 2 + wc) * 64 + 4 * fq;
            else dst = (bf16_t*)(ws + OFF_KATT) + ((size_t)(b * 2 + wc) * NKEY + ntok0 + 16 * m) * 64 + 4 * fq;
#pragma unroll
            for (int n = 0; n < 4; ++n) *(u32x2*)(dst + 16 * n) = (u32x2){pk_bf16(v[n][0] * osc, v[n][1] * osc), pk_bf16(v[n][2] * osc, v[n][3] * osc)};
        }
    } else if (nt == 5) {
        mfma_settle();
        bf16_t* base = (bf16_t*)(ws + OFF_VATT) + (size_t)(b * 2 + wc) * 64 * NKEY;
#pragma unroll
        for (int m = 0; m < 4; ++m)
#pragma unroll
            for (int n = 0; n < 4; ++n)
#pragma unroll
                for (int j = 0; j < 4; ++j) base[(size_t)(16 * n + 4 * fq + j) * NKEY + ntok0 + 16 * m] = (bf16_t)(pk_bf16(acc[m][n][j], 0.f) & 0xffffu);
    } else if (nt < 10) {
        const int cl = (nt - 6) * 128 + wc * 64 + 4 * fq;
#pragma unroll
        for (int m = 0; m < 4; ++m) {
            bf16_t* dst = (bf16_t*)(ws + OFF_QHG) + (size_t)(row0 + 16 * m) * 512 + cl;
#pragma unroll
            for (int n = 0; n < 4; ++n) {
                const float s = 0.08838834764831845f;
                *(u32x2*)(dst + 16 * n) = (u32x2){pk_bf16(siluf(acc[m][n][0]) * s, siluf(acc[m][n][1]) * s), pk_bf16(siluf(acc[m][n][2]) * s, siluf(acc[m][n][3]) * s)};
            }
        }
    } else if (nt < 14) {
        mfma_settle();
        const int h = nt - 10;
        bf16_t* base = (bf16_t*)(ws + OFF_VHG) + (size_t)((b * 4 + h) * 128 + wc * 64) * NKEY;
#pragma unroll
        for (int m = 0; m < 4; ++m)
#pragma unroll
            for (int n = 0; n < 4; ++n)
#pragma unroll
                for (int j = 0; j < 4; ++j) base[(size_t)(16 * n + 4 * fq + j) * NKEY + ntok0 + 16 * m] = (bf16_t)(pk_bf16(acc[m][n][j], 0.f) & 0xffffu);
    } else if (nt < 22) {
        const int cl = (nt - 14) * 128 + wc * 64 + 4 * fq;
        const float* lb = (const float*)(ws + OFF_LB);
        f32x4 lbv[4], qs[4];
#pragma unroll
        for (int n = 0; n < 4; ++n) {
            lbv[n] = *(const f32x4*)(lb + cl + 16 * n);
#pragma unroll
            for (int j = 0; j < 4; ++j) qs[n][j] = 65535.f * __builtin_amdgcn_rcpf(__logf(lbv[n][j]));
        }
#pragma unroll
        for (int m = 0; m < 4; ++m) {
            bf16_t* dst = lat ? (bf16_t*)(ws + OFF_LF) + (size_t)(row0 + 16 * m) * 1024 + cl : (bf16_t*)(ws + OFF_LFC) + (size_t)(row0 + 16 * m - NLAT) * 1024 + cl;
#pragma unroll
            for (int n = 0; n < 4; ++n) {
                unsigned q[4];
#pragma unroll
                for (int j = 0; j < 4; ++j) {
                    const float sg = __builtin_amdgcn_rcpf(1.f + __expf(-acc[m][n][j]));
                    const float lf = __logf(lbv[n][j] + (1.f - lbv[n][j]) * sg);
                    q[j] = (unsigned)fminf(fmaxf(lf * qs[n][j] + 0.5f, 0.f), 65535.f);
                }
                *(u32x2*)(dst + 16 * n) = (u32x2){q[0] | (q[1] << 16), q[2] | (q[3] << 16)};
            }
        }
    } else {
        const int cl = (nt - 22) * 128 + wc * 64 + 4 * fq;
#pragma unroll
        for (int m = 0; m < 4; ++m) {
            bf16_t* dst = (bf16_t*)(ws + OFF_GHG) + (size_t)(row0 + 16 * m) * 512 + cl;
#pragma unroll
            for (int n = 0; n < 4; ++n)
                *(u32x2*)(dst + 16 * n) = (u32x2){pk_bf16(siluf(acc[m][n][0]), siluf(acc[m][n][1])), pk_bf16(siluf(acc[m][n][2]), siluf(acc[m][n][3]))};
        }
    }
}

DEVI void phase_gemm_in(const Params& p, unsigned char* smem) {
    const bf16_t* A = (const bf16_t*)(p.ws + OFF_A);
    const bf16_t* Bt = (const bf16_t*)(p.ws + OFF_WIN);
    bool first = true; int g0 = 0;
    const int nbx = gridDim.x >> 3, wr = tidl() >> 7;
    for (int j = blockIdx.x >> 3; ; j += nbx) {
        int mt, nt, mtn, ntn;
        if (!xcd_tile2(j, 26, true, mt, nt)) break;
        const bool has_next = xcd_tile2(j + nbx, 26, true, mtn, ntn);
        f32x4 accL[4][4], accH[4][4];
        gemm2_tile(gemm2_src(A, DM, Bt, DM, mt * 256, nt * 128), gemm2_src(A, DM, Bt, DM, mtn * 256, ntn * 128), has_next, first, g0, DM, DM, DM, smem, accL, accH);
        first = false;
        epi_in(p, 2 * mt + wr, nt, 0, accL);
        epi_in(p, 2 * mt + wr, nt, 1, accH);
    }
}

DEVI void hg_prep_task(const Params& p, int tk, unsigned char* smem) {
    const int c = tk % NCH, dir = (tk / NCH) & 1, bh = tk / (2 * NCH), h = bh & 3, b = bh >> 2;
    const int tid = tidl(), k = tid & 127, hf = tid >> 7;
    unsigned char* ws = p.ws;
    bf16_t* sQ = (bf16_t*)smem;
    bf16_t* sK = (bf16_t*)(smem + 17408);
    float* tot = (float*)(smem + 34816);
    const bool lat = c >= 4;
    const int rowbase = lat ? (b * SEQ + (c - 4) * 64) : (NLAT + b * CTX + c * 64);
    const bf16_t* lfp = lat ? (const bf16_t*)(ws + OFF_LF) + (size_t)rowbase * 1024 + dir * 512 + h * 128 + k
                            : (const bf16_t*)(ws + OFF_LFC) + (size_t)(rowbase - NLAT) * 1024 + dir * 512 + h * 128 + k;
    const float lfs = __logf(((const float*)(ws + OFF_LB))[dir * 512 + h * 128 + k]) * (1.f / 65535.f);
    const bf16_t* qp = (const bf16_t*)(ws + OFF_QHG) + (size_t)rowbase * 512 + h * 128 + k;
    float lfr[32], qr[32];
#pragma unroll
    for (int i = 0; i < 32; ++i) lfr[i] = (float)lfp[(size_t)(hf * 32 + i) * 1024] * lfs;
#pragma unroll
    for (int i = 0; i < 32; ++i) qr[i] = bf2f(qp[(size_t)(hf * 32 + i) * 512]);
    float tsum = 0.f;
#pragma unroll
    for (int i = 0; i < 32; ++i) tsum += lfr[i];
    tot[hf * 128 + k] = tsum;
    __syncthreads();
    const float t0 = tot[k], t1 = tot[128 + k];
    const float r = dir == 0 ? t0 : t1, blast = t0 + t1;
    const float addv = (dir == 0) ? (hf == 1 ? t0 : 0.f) : (hf == 0 ? t1 : 0.f);
    bf16_t* Qg = (bf16_t*)(ws + OFF_A) + (size_t)tk * 8192;
    float run = addv - r;
    unsigned kw[16];
#define HG_PAIR(i) { \
        const unsigned qq = pk_bf16(qr[i] * __expf(b0), qr[(i) + 1] * __expf(b1)); \
        const unsigned kq = pk_bf16((1.f - __expf(lfr[i])) * __expf(-b0), (1.f - __expf(lfr[(i) + 1])) * __expf(-b1)); \
        kw[(i) >> 1] = kq; \
        const int tok = hf * 32 + (i); \
        sQ[tok * 136 + k] = (bf16_t)(qq & 0xffffu); sQ[(tok + 1) * 136 + k] = (bf16_t)(qq >> 16); \
        sK[tok * 136 + k] = (bf16_t)(kq & 0xffffu); sK[(tok + 1) * 136 + k] = (bf16_t)(kq >> 16); }
    if (dir == 0) {
#pragma unroll
        for (int i = 0; i < 32; i += 2) { const float b0 = run + lfr[i], b1 = b0 + lfr[i + 1]; run = b1; HG_PAIR(i) }
    } else {
#pragma unroll
        for (int i = 30; i >= 0; i -= 2) { const float b1 = run + lfr[i + 1], b0 = b1 + lfr[i]; run = b0; HG_PAIR(i) }
    }
#undef HG_PAIR
    {
        u32x4* kd = (u32x4*)((bf16_t*)(ws + OFF_KT) + (size_t)tk * 8192 + k * 64 + hf * 32);
#pragma unroll
        for (int g = 0; g < 4; ++g) kd[g] = (u32x4){kw[4 * g], kw[4 * g + 1], kw[4 * g + 2], kw[4 * g + 3]};
    }
    if (hf == 0) {
        float* dv = (float*)(ws + OFF_DV) + (size_t)tk * 384;
        dv[k] = __expf(r); dv[128 + k] = __expf(blast - r); dv[256 + k] = __expf(blast);
    }
    __syncthreads();
#pragma unroll
    for (int j = 0; j < 4; ++j) { const int idx = tid + 256 * j, rq = idx >> 4, cq = idx & 15; *(u32x4*)(Qg + rq * 128 + cq * 8) = *(const u32x4*)(smem + rq * 272 + cq * 16); }
    const int lane = tid & 63, w = tid >> 6, fr = lane & 15, fq = lane >> 4;
    f32x4 a[4];
#pragma unroll
    for (int sn = 0; sn < 4; ++sn) a[sn] = (f32x4){0.f, 0.f, 0.f, 0.f};
#pragma unroll
    for (int kk = 0; kk < 4; ++kk) {
        const u32x4 qf = *(const u32x4*)(smem + (16 * w + fr) * 272 + (32 * kk + 8 * fq) * 2);
#pragma unroll
        for (int sn = 0; sn < 4; ++sn) {
            const u32x4 kf = *(const u32x4*)(smem + 17408 + (16 * sn + fr) * 272 + (32 * kk + 8 * fq) * 2);
            a[sn] = mfma16(kf, qf, a[sn]);
        }
    }
    bf16_t* Ag = (bf16_t*)(ws + OFF_AM) + (size_t)tk * 4096;
    const int t = 16 * w + fr;
#pragma unroll
    for (int sn = 0; sn < 4; ++sn) {
        float o[4];
#pragma unroll
        for (int j = 0; j < 4; ++j) { const int s = 16 * sn + 4 * fq + j; const bool keep = dir == 0 ? (s <= t) : (s >= t); o[j] = keep ? a[sn][j] : 0.f; }
        *(u32x2*)(Ag + t * 64 + 16 * sn + 4 * fq) = (u32x2){pk_bf16(o[0], o[1]), pk_bf16(o[2], o[3])};
    }
    __syncthreads();
}

constexpr int SC_KT = 0, SC_QT = 16384, SC_DV = 16384 + 17408, SC_BUF = 16384 + 17408 + 1536;
DEVI int scan_chunk(int dir, int i) { return dir == 0 ? i : (i < 4 ? 3 - i : 71 - i); }
DEVI void scan_block(const Params& p, int blk, unsigned char* smem) {
    const int tid = tidl(), lane = tid & 63, wid = tid >> 6, fr = lane & 15, fq = lane >> 4;
    const int vs = (blk & 1) * 4 + wid, dir = (blk >> 1) & 1, h = (blk >> 2) & 3, b = blk >> 4;
    unsigned char* ws = p.ws;
    const unsigned char* Qt = ws + OFF_A;
    const unsigned char* KtT = ws + OFF_KT;
    const bf16_t* Am = (const bf16_t*)(ws + OFF_AM);
    const unsigned char* dvb = ws + OFF_DV;
    bf16_t* obuf = (bf16_t*)(ws + OFF_OB) + (dir ? (size_t)NLAT * 512 : 0);
    const bf16_t* vrow = (const bf16_t*)(ws + OFF_VHG) + (size_t)((b * 4 + h) * 128 + vs * 16 + fr) * NKEY;
    const int tk0 = ((b * 4 + h) * 2 + dir) * NCH;
    int kt_dst[4], qt_dst[4];
#pragma unroll
    for (int j = 0; j < 4; ++j) {
        const int idx = tid + 256 * j;
        const int rk = idx >> 3, ck = idx & 7; kt_dst[j] = SC_KT + rk * 128 + ((ck ^ ((rk >> 1) & 7)) << 4);
        const int rq = idx >> 4, cq = idx & 15; qt_dst[j] = SC_QT + rq * 272 + cq * 16;
    }
    const int sw = (fr >> 1) & 7;
    const int kt_rd = SC_KT + fr * 128 + ((fq ^ sw) << 4);
    const int qt_rd = SC_QT + fr * 272 + 8 * fq;
    f32x4 S[8];
#pragma unroll
    for (int m = 0; m < 8; ++m) S[m] = (f32x4){0.f, 0.f, 0.f, 0.f};
    u32x4 stK[4], stQ[4], stD, vN[2], aC[8], vC[2];
    {
        const int c = scan_chunk(dir, 0); const size_t tk = tk0 + c;
#pragma unroll
        for (int j = 0; j < 4; ++j) { stK[j] = *(const u32x4*)(KtT + tk * 16384 + (tid + 256 * j) * 16); stQ[j] = *(const u32x4*)(Qt + tk * 16384 + (tid + 256 * j) * 16); }
        stD = (tid < 96) ? *(const u32x4*)(dvb + tk * 1536 + tid * 16) : (u32x4){0u, 0u, 0u, 0u};
        vC[0] = *(const u32x4*)(vrow + 64 * c + 8 * fq); vC[1] = *(const u32x4*)(vrow + 64 * c + 32 + 8 * fq);
#pragma unroll
        for (int q = 0; q < 8; ++q) aC[q] = *(const u32x4*)(Am + tk * 4096 + (16 * (q >> 1) + fr) * 64 + 32 * (q & 1) + 8 * fq);
#pragma unroll
        for (int j = 0; j < 4; ++j) { *(u32x4*)(smem + kt_dst[j]) = stK[j]; *(u32x4*)(smem + qt_dst[j]) = stQ[j]; }
        if (tid < 96) *(u32x4*)(smem + SC_DV + tid * 16) = stD;
        __syncthreads();
    }
#pragma unroll 1
    for (int i = 0; i < NCH; ++i) {
        const int c = scan_chunk(dir, i);
        const unsigned char* buf = smem + (i & 1) * SC_BUF;
        const int cn = scan_chunk(dir, i + 1 < NCH ? i + 1 : NCH - 1);
        const size_t tkn = tk0 + cn;
#pragma unroll
        for (int j = 0; j < 4; ++j) { stK[j] = *(const u32x4*)(KtT + tkn * 16384 + (tid + 256 * j) * 16); stQ[j] = *(const u32x4*)(Qt + tkn * 16384 + (tid + 256 * j) * 16); }
        stD = *(const u32x4*)(dvb + tkn * 1536 + (tid < 96 ? tid : 0) * 16);
        vN[0] = *(const u32x4*)(vrow + 64 * cn + 8 * fq); vN[1] = *(const u32x4*)(vrow + 64 * cn + 32 + 8 * fq);
        f32x4 o[4];
#pragma unroll
        for (int nt = 0; nt < 4; ++nt) o[nt] = (f32x4){0.f, 0.f, 0.f, 0.f};
#pragma unroll
        for (int nt = 0; nt < 4; ++nt) { o[nt] = mfma16(vC[0], aC[2 * nt], o[nt]); o[nt] = mfma16(vC[1], aC[2 * nt + 1], o[nt]); }
        __builtin_amdgcn_sched_barrier(0);
#pragma unroll
        for (int q = 0; q < 8; ++q) aC[q] = *(const u32x4*)(Am + tkn * 4096 + (16 * (q >> 1) + fr) * 64 + 32 * (q & 1) + 8 * fq);
#pragma unroll
        for (int kk = 0; kk < 4; ++kk) {
            const f32x4 da = *(const f32x4*)(buf + SC_DV + (32 * kk + 4 * fq) * 4), db = *(const f32x4*)(buf + SC_DV + (32 * kk + 16 + 4 * fq) * 4);
            const u32x4 sf = (u32x4){pk_bf16_m(S[2 * kk][0] * da[0], S[2 * kk][1] * da[1]), pk_bf16_m(S[2 * kk][2] * da[2], S[2 * kk][3] * da[3]),
                                     pk_bf16_m(S[2 * kk + 1][0] * db[0], S[2 * kk + 1][1] * db[1]), pk_bf16_m(S[2 * kk + 1][2] * db[2], S[2 * kk + 1][3] * db[3])};
#pragma unroll
            for (int nt = 0; nt < 4; ++nt) {
                const u32x2 qa = *(const u32x2*)(buf + qt_rd + nt * 4352 + 64 * kk), qb = *(const u32x2*)(buf + qt_rd + nt * 4352 + 64 * kk + 32);
                o[nt] = mfma16(sf, (u32x4){qa.x, qa.y, qb.x, qb.y}, o[nt]);
            }
        }
        if (c >= 4) {
            mfma_settle();
            bf16_t* od = obuf + (size_t)(b * SEQ + (c - 4) * 64 + fr) * 512 + h * 128 + vs * 16 + 4 * fq;
#pragma unroll
            for (int nt = 0; nt < 4; ++nt) *(u32x2*)(od + (size_t)(16 * nt) * 512) = (u32x2){pk_bf16(o[nt][0], o[nt][1]), pk_bf16(o[nt][2], o[nt][3])};
        }
        __builtin_amdgcn_sched_barrier(0);
#pragma unroll
        for (int mt = 0; mt < 8; ++mt) {
            f32x4 u = (f32x4){0.f, 0.f, 0.f, 0.f};
#pragma unroll
            for (int kk = 0; kk < 2; ++kk) { const u32x4 kf = *(const u32x4*)(buf + ((kt_rd + mt * 2048) ^ (kk << 6))); u = mfma16(kf, vC[kk], u); }
            const f32x4 d2 = *(const f32x4*)(buf + SC_DV + (128 + 16 * mt + 4 * fq) * 4), d3 = *(const f32x4*)(buf + SC_DV + (256 + 16 * mt + 4 * fq) * 4);
            S[mt] = d3 * S[mt] + d2 * u;
        }
        {
            unsigned char* nb = smem + ((i + 1) & 1) * SC_BUF;
#pragma unroll
            for (int j = 0; j < 4; ++j) { *(u32x4*)(nb + kt_dst[j]) = stK[j]; *(u32x4*)(nb + qt_dst[j]) = stQ[j]; }
            if (tid < 96) *(u32x4*)(nb + SC_DV + tid * 16) = stD;
            vC[0] = vN[0]; vC[1] = vN[1];
        }
        __syncthreads();
    }
}

DEVI void attn_item(const Params& p, int item, unsigned char* smem) {
    const int g = item & 3, qb = (item >> 2) & 31, bk = item >> 7, b = bk >> 1, kvh = bk & 1, head = kvh * 4 + g;
    const int tid = tidl(), lane = tid & 63, wid = tid >> 6, fr = lane & 15, fq = lane >> 4;
    unsigned char* ws = p.ws;
    const int r0 = tid >> 3, cl = (tid & 7) ^ ((tid >> 4) & 7);
    const unsigned char* kg0 = ws + OFF_KATT + (size_t)bk * NKEY * 64 * 2 + r0 * 128 + cl * 16;
    const unsigned char* vg0 = ws + OFF_VATT + (size_t)bk * 64 * NKEY * 2 + (size_t)r0 * NKEY * 2 + cl * 16;
    const int st_off = tid * 16;
#define ATT_ISSUE(kt_) { unsigned char* sb_ = smem + ((kt_) & 3) * 16384 + st_off; \
        glds16(kg0 + (size_t)(kt_) * 8192, sb_); glds16(kg0 + (size_t)(kt_) * 8192 + 4096, sb_ + 4096); \
        glds16(vg0 + (kt_) * 128, sb_ + 8192); glds16(vg0 + (size_t)32 * NKEY * 2 + (kt_) * 128, sb_ + 12288); }
    const int q0 = b * SEQ + qb * 128 + wid * 32;
    u32x4 qf[2][2];
#pragma unroll
    for (int qt = 0; qt < 2; ++qt)
#pragma unroll
        for (int kk = 0; kk < 2; ++kk) qf[qt][kk] = *(const u32x4*)((const bf16_t*)(ws + OFF_QATT) + (size_t)(q0 + 16 * qt + fr) * 512 + head * 64 + 32 * kk + 8 * fq);
    f32x4 o[4][2];
#pragma unroll
    for (int dt = 0; dt < 4; ++dt) { o[dt][0] = (f32x4){0.f, 0.f, 0.f, 0.f}; o[dt][1] = (f32x4){0.f, 0.f, 0.f, 0.f}; }
    float gqm = fabsf(p.g_q[lane]), gkm = fabsf(p.g_k[lane]);
#pragma unroll
    for (int of2 = 1; of2 < 64; of2 <<= 1) { gqm = fmaxf(gqm, __shfl_xor(gqm, of2)); gkm = fmaxf(gkm, __shfl_xor(gkm, of2)); }
    const float Mst = 64.f * gqm * gkm * (0.125f * 1.4426950408889634f) * 1.01f;
    f32x4 lacc[2] = {(f32x4){0.f, 0.f, 0.f, 0.f}, (f32x4){0.f, 0.f, 0.f, 0.f}};
    const unsigned one2 = fr == 0 ? 0x3f803f80u : 0u;
    const u32x4 ones = (u32x4){one2, one2, one2, one2};
    const int sw = (fr >> 1) & 7;
    const unsigned lds0 = (unsigned)(size_t)((LDSP unsigned char*)smem);
    const unsigned k_rd = lds0 + fr * 128 + ((fq ^ sw) << 4);
    const unsigned v_rd = lds0 + 8192 + fr * 128 + (((fq >> 1) ^ sw) << 4) + (fq & 1) * 8;
    asm volatile("s_waitcnt vmcnt(0)" ::: "memory");
    __builtin_amdgcn_s_barrier();
    ATT_ISSUE(0) ATT_ISSUE(1) ATT_ISSUE(2)
    for (int kt = 0; kt < NCH; ++kt) {
        if (kt + 2 < NCH) asm volatile("s_waitcnt vmcnt(8)" ::: "memory");
        else if (kt + 1 < NCH) asm volatile("s_waitcnt vmcnt(4)" ::: "memory");
        else asm volatile("s_waitcnt vmcnt(0)" ::: "memory");
        __builtin_amdgcn_s_barrier();
        if (kt + 3 < NCH) ATT_ISSUE(kt + 3)
        const unsigned kb = k_rd + (kt & 3) * 16384, vb = v_rd + (kt & 3) * 16384;
        u32x4 k0, k1, k2, k3, k4, k5, k6, k7;
        asm volatile("ds_read_b128 %0, %1" : "=v"(k0) : "v"(kb));
        asm volatile("ds_read_b128 %0, %1 offset:2048" : "=v"(k1) : "v"(kb));
        asm volatile("ds_read_b128 %0, %1 offset:4096" : "=v"(k2) : "v"(kb));
        asm volatile("ds_read_b128 %0, %1 offset:6144" : "=v"(k3) : "v"(kb));
        asm volatile("ds_read_b128 %0, %1" : "=v"(k4) : "v"(kb ^ 64u));
        asm volatile("ds_read_b128 %0, %1 offset:2048" : "=v"(k5) : "v"(kb ^ 64u));
        asm volatile("ds_read_b128 %0, %1 offset:4096" : "=v"(k6) : "v"(kb ^ 64u));
        asm volatile("ds_read_b128 %0, %1 offset:6144" : "=v"(k7) : "v"(kb ^ 64u));
        asm volatile("s_waitcnt lgkmcnt(0)" : "+v"(k0), "+v"(k1), "+v"(k2), "+v"(k3), "+v"(k4), "+v"(k5), "+v"(k6), "+v"(k7));
        f32x4 s[4][2];
        const f32x4 z4 = (f32x4){-Mst, -Mst, -Mst, -Mst};
        s[0][0] = mfma16(k0, qf[0][0], z4); s[0][1] = mfma16(k0, qf[1][0], z4);
        s[1][0] = mfma16(k1, qf[0][0], z4); s[1][1] = mfma16(k1, qf[1][0], z4);
        s[2][0] = mfma16(k2, qf[0][0], z4); s[2][1] = mfma16(k2, qf[1][0], z4);
        s[3][0] = mfma16(k3, qf[0][0], z4); s[3][1] = mfma16(k3, qf[1][0], z4);
        s[0][0] = mfma16(k4, qf[0][1], s[0][0]); s[0][1] = mfma16(k4, qf[1][1], s[0][1]);
        s[1][0] = mfma16(k5, qf[0][1], s[1][0]); s[1][1] = mfma16(k5, qf[1][1], s[1][1]);
        s[2][0] = mfma16(k6, qf[0][1], s[2][0]); s[2][1] = mfma16(k6, qf[1][1], s[2][1]);
        s[3][0] = mfma16(k7, qf[0][1], s[3][0]); s[3][1] = mfma16(k7, qf[1][1], s[3][1]);
        u32x2 va[8], vbq[8];
#pragma unroll
        for (int kk = 0; kk < 2; ++kk)
#pragma unroll
            for (int dt = 0; dt < 4; ++dt) {
                const unsigned ad = (vb + dt * 2048) ^ (kk << 6);
                asm volatile("ds_read_b64 %0, %1" : "=v"(va[kk * 4 + dt]) : "v"(ad));
                asm volatile("ds_read_b64 %0, %1" : "=v"(vbq[kk * 4 + dt]) : "v"(ad ^ 32u));
            }
        u32x4 pf[2][2];
#pragma unroll
        for (int qt = 0; qt < 2; ++qt) {
#pragma unroll
            for (int ks = 0; ks < 4; ++ks)
#pragma unroll
                for (int j = 0; j < 4; ++j) s[ks][qt][j] = __builtin_amdgcn_exp2f(s[ks][qt][j]);
#pragma unroll
            for (int kk = 0; kk < 2; ++kk)
                pf[qt][kk] = (u32x4){pk_bf16_t(s[2 * kk][qt][0], s[2 * kk][qt][1]), pk_bf16_t(s[2 * kk][qt][2], s[2 * kk][qt][3]),
                                     pk_bf16_t(s[2 * kk + 1][qt][0], s[2 * kk + 1][qt][1]), pk_bf16_t(s[2 * kk + 1][qt][2], s[2 * kk + 1][qt][3])};
        }
        asm volatile("s_nop 1" ::: "memory");
        asm volatile("s_waitcnt lgkmcnt(0)" : "+v"(va[0]), "+v"(va[1]), "+v"(va[2]), "+v"(va[3]), "+v"(va[4]), "+v"(va[5]), "+v"(va[6]), "+v"(va[7]),
                     "+v"(vbq[0]), "+v"(vbq[1]), "+v"(vbq[2]), "+v"(vbq[3]), "+v"(vbq[4]), "+v"(vbq[5]), "+v"(vbq[6]), "+v"(vbq[7]));
#pragma unroll
        for (int kk = 0; kk < 2; ++kk)
#pragma unroll
            for (int dt = 0; dt < 4; ++dt) {
                const u32x4 vfr = (u32x4){va[kk * 4 + dt].x, va[kk * 4 + dt].y, vbq[kk * 4 + dt].x, vbq[kk * 4 + dt].y};
                o[dt][0] = mfma16(vfr, pf[0][kk], o[dt][0]); o[dt][1] = mfma16(vfr, pf[1][kk], o[dt][1]);
            }
        lacc[0] = mfma16(ones, pf[0][0], lacc[0]); lacc[0] = mfma16(ones, pf[0][1], lacc[0]);
        lacc[1] = mfma16(ones, pf[1][0], lacc[1]); lacc[1] = mfma16(ones, pf[1][1], lacc[1]);
    }
#undef ATT_ISSUE
#pragma unroll
    for (int qt = 0; qt < 2; ++qt) {
        const float l = __shfl(lacc[qt][0], fr);
        const float il = 1.f / l;
        bf16_t* dst = (bf16_t*)(ws + OFF_MIX) + (size_t)(q0 + 16 * qt + fr) * 1024 + head * 64 + 4 * fq;
#pragma unroll
        for (int dt = 0; dt < 4; ++dt) *(u32x2*)(dst + 16 * dt) = (u32x2){pk_bf16(o[dt][qt][0] * il, o[dt][qt][1] * il), pk_bf16(o[dt][qt][2] * il, o[dt][qt][3] * il)};
    }
}

DEVI void readout_phase(const Params& p) {
    const int lane = tidl() & 63, wid = tidl() >> 6;
    const bf16_t* of = (const bf16_t*)(p.ws + OFF_OB); const bf16_t* ob = of + (size_t)NLAT * 512;
    const bf16_t* gh = (const bf16_t*)(p.ws + OFF_GHG);
    bf16_t* mix = (bf16_t*)(p.ws + OFF_MIX);
    const f32x4 g0 = *(const f32x4*)(p.g_hg + (lane & 15) * 8), g1 = *(const f32x4*)(p.g_hg + (lane & 15) * 8 + 4);
    for (int t = blockIdx.x; t * 4 < NLAT; t += gridDim.x) {
        const size_t row = (size_t)t * 4 + wid;
        const u32x4 ua = *(const u32x4*)(of + row * 512 + lane * 8), ub = *(const u32x4*)(ob + row * 512 + lane * 8);
        const u32x4 gg = *(const u32x4*)(gh + row * 512 + lane * 8);
        f32x4 v0 = (f32x4){bflo(ua.x) + bflo(ub.x), bfhi(ua.x) + bfhi(ub.x), bflo(ua.y) + bflo(ub.y), bfhi(ua.y) + bfhi(ub.y)};
        f32x4 v1 = (f32x4){bflo(ua.z) + bflo(ub.z), bfhi(ua.z) + bfhi(ub.z), bflo(ua.w) + bflo(ub.w), bfhi(ua.w) + bfhi(ub.w)};
        float ss = v0[0] * v0[0] + v0[1] * v0[1] + v0[2] * v0[2] + v0[3] * v0[3] + v1[0] * v1[0] + v1[1] * v1[1] + v1[2] * v1[2] + v1[3] * v1[3];
        ss += __shfl_xor(ss, 1); ss += __shfl_xor(ss, 2); ss += __shfl_xor(ss, 4); ss += __shfl_xor(ss, 8);
        const float rstd = rsqrtf(ss * (1.f / 128.f) + EPS);
        v0 = v0 * rstd * g0; v1 = v1 * rstd * g1;
        *(u32x4*)(mix + row * 1024 + 512 + lane * 8) = (u32x4){pk_bf16(v0[0] * bflo(gg.x), v0[1] * bfhi(gg.x)), pk_bf16(v0[2] * bflo(gg.y), v0[3] * bfhi(gg.y)),
                                                              pk_bf16(v1[0] * bflo(gg.z), v1[1] * bfhi(gg.z)), pk_bf16(v1[2] * bflo(gg.w), v1[3] * bfhi(gg.w))};
    }
}

template <bool FUSE_NORM>
DEVI void epi_res(const Params& p, int mt, int nt, int wr, const f32x4 (&acc)[4][4], const float* res, float* dst, int gate_idx) {
    const float* mod = (const float*)(p.ws + OFF_MOD);
    const int lane = tidl() & 63, wid = tidl() >> 6, wc = wid & 1, fr = lane & 15, fq = lane >> 4;
    const int b = mt >> 5, col = nt * 128 + wc * 64 + 4 * fq;
    f32x4 gt[4], gs[4];
#pragma unroll
    for (int n = 0; n < 4; ++n) {
        gt[n] = *(const f32x4*)(mod + b * 6144 + gate_idx * 1024 + col + 16 * n);
        if (FUSE_NORM) gs[n] = *(const f32x4*)(p.g_norm2 + col + 16 * n) * (*(const f32x4*)(mod + b * 6144 + 4 * 1024 + col + 16 * n) + 1.f);
    }
#pragma unroll
    for (int m = 0; m < 4; ++m) {
        const int row = mt * 128 + wr * 64 + 16 * m + fr;
        float ss = 0.f;
#pragma unroll
        for (int n = 0; n < 4; ++n) {
            const size_t off = (size_t)row * DM + col + 16 * n;
            const f32x4 v = *(const f32x4*)(res + off) + gt[n] * acc[m][n];
            *(f32x4*)(dst + off) = v;
            if (FUSE_NORM) {
                ss += v[0] * v[0] + v[1] * v[1] + v[2] * v[2] + v[3] * v[3];
                const f32x4 hh = v * gs[n];
                *(u32x2*)((bf16_t*)(p.ws + OFF_A) + off) = (u32x2){pk_bf16(hh[0], hh[1]), pk_bf16(hh[2], hh[3])};
            }
        }
        if (FUSE_NORM) {
            ss += __shfl_xor(ss, 16); ss += __shfl_xor(ss, 32);
            if (fq == 0) atomicAdd((float*)(p.ws + OFF_RSS) + row, ss);
        }
    }
}
template <bool FUSE_NORM>
DEVI void phase_gemm_res(const Params& p, const bf16_t* A, int lda, const bf16_t* Bt, int K, const float* res, float* dst, int gate_idx, unsigned char* smem) {
    bool first = true; int g0 = 0;
    const int nbx = gridDim.x >> 3, wr = tidl() >> 7;
    for (int j = blockIdx.x >> 3; ; j += nbx) {
        int mt, nt, mtn, ntn;
        if (!xcd_tile2(j, 8, false, mt, nt)) break;
        const bool has_next = xcd_tile2(j + nbx, 8, false, mtn, ntn);
        f32x4 accL[4][4], accH[4][4];
        gemm2_tile(gemm2_src(A, lda, Bt, K, mt * 256, nt * 128), gemm2_src(A, lda, Bt, K, mtn * 256, ntn * 128), has_next, first, g0, lda, K, K, smem, accL, accH);
        first = false;
        epi_res<FUSE_NORM>(p, 2 * mt + wr, nt, 0, accL, res, dst, gate_idx);
        epi_res<FUSE_NORM>(p, 2 * mt + wr, nt, 1, accH, res, dst, gate_idx);
    }
}

DEVI void epi_gu(const Params& p, int mt, int nt, int wr, const f32x4 (&acc)[4][4]) {
    bf16_t* act = (bf16_t*)(p.ws + OFF_ACT);
    const int lane = tidl() & 63, wid = tidl() >> 6, wc = wid & 1, fr = lane & 15, fq = lane >> 4;
    const float* cg = (const float*)(p.ws + OFF_CGU) + (mt >> 5) * 2 * DFF + nt * 128 + wc * 64 + 4 * fq;
    f32x4 cb[4];
#pragma unroll
    for (int n = 0; n < 4; ++n) cb[n] = *(const f32x4*)(cg + 16 * n);
#pragma unroll
    for (int m = 0; m < 4; ++m) {
        const int row = mt * 128 + wr * 64 + 16 * m + fr;
        const float rstd = rsqrtf(((const float*)(p.ws + OFF_RSS))[row] * (1.f / DM) + EPS);
        bf16_t* dst = act + (size_t)row * DFF + nt * 64 + wc * 32 + 4 * fq;
#pragma unroll
        for (int n2 = 0; n2 < 2; ++n2) {
            const f32x4 a = acc[m][2 * n2] * rstd + cb[2 * n2], bq = acc[m][2 * n2 + 1] * rstd + cb[2 * n2 + 1];
            *(u32x2*)(dst + 16 * n2) = (u32x2){pk_bf16(siluf(a[0]) * bq[0], siluf(a[1]) * bq[1]), pk_bf16(siluf(a[2]) * bq[2], siluf(a[3]) * bq[3])};
        }
    }
}
DEVI void phase_gemm_gu(const Params& p, unsigned char* smem) {
    const bf16_t* A = (const bf16_t*)(p.ws + OFF_A);
    const bf16_t* Bt = (const bf16_t*)(p.ws + OFF_WGU);
    bool first = true; int g0 = 0;
    const int nbx = gridDim.x >> 3, wr = tidl() >> 7;
    for (int j = blockIdx.x >> 3; ; j += nbx) {
        int mt, nt, mtn, ntn;
        if (!xcd_tile2(j, 44, false, mt, nt)) break;
        const bool has_next = xcd_tile2(j + nbx, 44, false, mtn, ntn);
        f32x4 accL[4][4], accH[4][4];
        gemm2_tile(gemm2_src(A, DM, Bt, DM, mt * 256, nt * 128), gemm2_src(A, DM, Bt, DM, mtn * 256, ntn * 128), has_next, first, g0, DM, DM, DM, smem, accL, accH);
        first = false;
        epi_gu(p, 2 * mt + wr, nt, 0, accL);
        epi_gu(p, 2 * mt + wr, nt, 1, accH);
    }
}

DEVI void final_norm_phase(const Params& p) {
    const int lane = tidl() & 63, wid = tidl() >> 6;
    for (int t = blockIdx.x; t * 4 < NLAT; t += gridDim.x) {
        const float* srow = (const float*)(p.ws + OFF_X1) + ((size_t)t * 4 + wid) * DM;
        float* row = p.out + ((size_t)t * 4 + wid) * DM;
        f32x4 v[4]; float ss = 0.f;
#pragma unroll
        for (int i = 0; i < 4; ++i) { v[i] = *(const f32x4*)(srow + lane * 4 + 256 * i); ss += v[i][0] * v[i][0] + v[i][1] * v[i][1] + v[i][2] * v[i][2] + v[i][3] * v[i][3]; }
        ss = wave_sum(ss);
        const float rstd = rsqrtf(ss * (1.f / DM) + EPS);
#pragma unroll
        for (int i = 0; i < 4; ++i) { const f32x4 gg = *(const f32x4*)(p.g_final + lane * 4 + 256 * i); *(f32x4*)(row + lane * 4 + 256 * i) = v[i] * rstd * gg; }
    }
}


#define XB_TMO      128
#define XB_XCNT(j)  (256  + 64 * (j))
#define XB_XSUB(j)  (1280 + 64 * (j))
#define XB_XGEN(j)  (2304 + 64 * (j))
#define XB_TOP      3328
#define XB_TOPGEN   3392
#define XB_SPIN_CAP (1u << 22)
#define LAS __attribute__((address_space(3)))
DEVI unsigned xb_ld(unsigned* p)              { return __hip_atomic_load(p, __ATOMIC_RELAXED, __HIP_MEMORY_SCOPE_AGENT); }
DEVI unsigned xb_add(unsigned* p, unsigned v) { return __hip_atomic_fetch_add(p, v, __ATOMIC_RELAXED, __HIP_MEMORY_SCOPE_AGENT); }
DEVI unsigned xb_xcc_id() { return (unsigned)__builtin_amdgcn_s_getreg((3 << 11) | 20) & 0xFu; }
#define XB_SPIN(cond, bar) do { unsigned _sp = 0; while (cond) { __builtin_amdgcn_s_sleep(1); \
    if ((++_sp & 255u) == 0u) { if (xb_ld(&(bar)[XB_TMO])) break; if (_sp > XB_SPIN_CAP) { atomicAdd(&(bar)[XB_TMO], 1u); break; } } } } while (0)
struct XcdBarrier { unsigned* bar; unsigned x; volatile unsigned* st; };
DEVI XcdBarrier xcd_barrier_post(unsigned* bar, volatile unsigned* st) {
    XcdBarrier b; b.bar = bar; b.x = xb_xcc_id(); b.st = st;
    if (threadIdx.x == 0) (void)xb_add(&bar[XB_XCNT(b.x)], 1u);
    return b;
}
DEVI void xcd_barrier_complete(unsigned* bar, unsigned x, unsigned& nloc, unsigned& nx) {
    const unsigned G = gridDim.x * gridDim.y * gridDim.z;
    unsigned sum, cnt, mine, sp = 0u;
    for (;;) {
        sum = 0u; cnt = 0u; mine = 0u;
#pragma unroll
        for (unsigned j = 0; j < 16; ++j) { const unsigned c = xb_ld(&bar[XB_XCNT(j)]); sum += c; cnt += (c > 0u) ? 1u : 0u; mine = (j == x) ? c : mine; }
        if (sum == G) break;
        __builtin_amdgcn_s_sleep(1);
        if ((++sp & 255u) == 0u) { if (xb_ld(&bar[XB_TMO])) break; if (sp > XB_SPIN_CAP) { atomicAdd(&bar[XB_TMO], 1u); break; } }
    }
    nloc = mine > 0u ? mine : 1u; nx = cnt > 0u ? cnt : 1u;
}
DEVI void xcd_barrier(const XcdBarrier& b) {
    asm volatile("s_waitcnt vmcnt(0)" ::: "memory");
    __syncthreads();
    if (threadIdx.x == 0) {
        unsigned* bar = b.bar;
        __builtin_amdgcn_s_waitcnt(0);
        unsigned nloc = b.st[0], nx = b.st[1];
        if (nloc == 0u) { xcd_barrier_complete(bar, b.x, nloc, nx); b.st[0] = nloc; b.st[1] = nx; }
        const unsigned old = xb_add(&bar[XB_XSUB(b.x)], 1u);
        const unsigned gen = old / nloc;
        if (old + 1u == (gen + 1u) * nloc) {
            __builtin_amdgcn_fence(__ATOMIC_RELEASE, "agent");
            asm volatile("s_waitcnt vmcnt(0)" ::: "memory");
            const unsigned og = xb_add(&bar[XB_TOP], 1u);
            const unsigned tg = og / nx;
            if (og + 1u == (tg + 1u) * nx) xb_add(&bar[XB_TOPGEN], 1u);
            else XB_SPIN(xb_ld(&bar[XB_TOPGEN]) == tg, bar);
            __builtin_amdgcn_fence(__ATOMIC_ACQUIRE, "agent");
            xb_add(&bar[XB_XGEN(b.x)], 1u);
            asm volatile("s_waitcnt vmcnt(0)" ::: "memory");
        } else {
            XB_SPIN(xb_ld(&bar[XB_XGEN(b.x)]) == gen, bar);
            __builtin_amdgcn_fence(__ATOMIC_ACQUIRE, "agent");
            asm volatile("s_waitcnt vmcnt(0)" ::: "memory");
        }
    }
    __syncthreads();
}

#define GRID_SYNC() xcd_barrier(xb)

__global__ void __launch_bounds__(256, 2) hymba_fwd(Params p) {
    __shared__ __attribute__((aligned(16))) unsigned char smem[73728];
    __shared__ int s_item;
    __shared__ unsigned xb_st[4];
    if (threadIdx.x < 4) xb_st[threadIdx.x] = 0u;
    __syncthreads();
    const XcdBarrier xb = xcd_barrier_post((unsigned*)p.ws, xb_st);
    unsigned char* ws = p.ws;
    const float* mod = (const float*)(ws + OFF_MOD);

    phase0(p, smem);
    GRID_SYNC();
    norm_mod_phase(p.x, p.ctx, (bf16_t*)(ws + OFF_A), p.g_norm1, mod, 0, 1, MROWS);
    late_transposes(p, smem);
    GRID_SYNC();
    phase_gemm_in(p, smem);
    GRID_SYNC();
    for (int t = blockIdx.x; t < NTASK; t += gridDim.x) hg_prep_task(p, t, smem);
    GRID_SYNC();
    if (blockIdx.x < 64) scan_block(p, blockIdx.x, smem);
    for (;;) {
        __syncthreads();
        if (threadIdx.x == 0) s_item = (int)atomicAdd((unsigned*)(ws + OFF_CNT), 1u);
        __syncthreads();
        const int item = s_item;
        if (item >= 1024) break;
        attn_item(p, item, smem);
    }
    GRID_SYNC();
    readout_phase(p);
    cgu_phase(p);
    GRID_SYNC();
    phase_gemm_res<true>(p, (const bf16_t*)(ws + OFF_MIX), DM, (const bf16_t*)(ws + OFF_WOUT), DM, p.x, (float*)(ws + OFF_X1), 2, smem);
    GRID_SYNC();
    phase_gemm_gu(p, smem);
    GRID_SYNC();
    phase_gemm_res<false>(p, (const bf16_t*)(ws + OFF_ACT), DFF, (const bf16_t*)(ws + OFF_WDN), DFF, (const float*)(ws + OFF_X1), (float*)(ws + OFF_X1), 5, smem);
    GRID_SYNC();
    final_norm_phase(p);
}

extern "C" void kernel_launch(void* const* d_in, const int* in_sizes, int n_in, void* d_out, int out_size, void* d_ws, size_t ws_size, hipStream_t stream) {
    static int grid_blocks = 0;
    if (!grid_blocks) {
        int dev = 0, cus = 0, per_cu = 0;
        hipGetDevice(&dev);
        hipDeviceGetAttribute(&cus, hipDeviceAttributeMultiprocessorCount, dev);
        hipOccupancyMaxActiveBlocksPerMultiprocessor(&per_cu, hymba_fwd, 256, 0);
        if (per_cu > 2) per_cu = 2;
        if (per_cu < 1) per_cu = 1;
        grid_blocks = cus * per_cu;
    }
    if (ws_size < WS_NEED) { fprintf(stderr, "workspace too small: %zu < %zu\n", ws_size, (size_t)WS_NEED); return; }
    Params p{};
    p.x = (const float*)d_in[0]; p.c = (const float*)d_in[1]; p.ctx = (const float*)d_in[2]; p.c_ctx = (const float*)d_in[3];
    p.w_mod = (const float*)d_in[4]; p.b_mod = (const float*)d_in[5]; p.g_norm1 = (const float*)d_in[6]; p.w_in = (const float*)d_in[7];
    p.g_q = (const float*)d_in[8]; p.g_k = (const float*)d_in[9]; p.lb_raw = (const float*)d_in[10]; p.g_hg = (const float*)d_in[11];
    p.w_out = (const float*)d_in[12]; p.g_norm2 = (const float*)d_in[13]; p.w_gu = (const float*)d_in[14]; p.w_down = (const float*)d_in[15];
    p.g_final = (const float*)d_in[16];
    p.out = (float*)d_out; p.ws = (unsigned char*)d_ws;
    hipMemsetAsync(d_ws, 0, 32768, stream);
    void* args[] = {&p};
    hipError_t e = hipLaunchCooperativeKernel((void*)hymba_fwd, dim3(grid_blocks), dim3(256), args, 0, stream);
    if (e != hipSuccess) fprintf(stderr, "cooperative launch failed: %s (grid %d)\n", hipGetErrorString(e), grid_blocks);
}
```

```cpp
#include <hip/hip_runtime.h>
#include <hip/hip_cooperative_groups.h>
#include <cstdio>
#include <cstdint>
namespace cg = cooperative_groups;

#define DEVI __device__ __forceinline__
typedef unsigned short bf16_t;
typedef short bf16x8 __attribute__((ext_vector_type(8)));
typedef float f32x4 __attribute__((ext_vector_type(4)));
typedef unsigned u32x4 __attribute__((ext_vector_type(4)));
typedef unsigned u32x2 __attribute__((ext_vector_type(2)));

constexpr int DM = 1024, NB = 4, SEQ = 4096, CTX = 256, NLAT = NB * SEQ, NCTX = NB * CTX, MROWS = NLAT + NCTX;
constexpr int NKEY = CTX + SEQ;
constexpr int INC = 3328, DFF = 2816, NCH = NKEY / 64;
constexpr int NTASK = NB * 4 * 2 * NCH;
constexpr float EPS = 1e-6f;

constexpr size_t OFF_CNT = 16384;
constexpr size_t OFF_MOD = 32768;
constexpr size_t OFF_LB = OFF_MOD + 122880;
constexpr size_t OFF_WIN = OFF_LB + 4096;
constexpr size_t OFF_WOUT = OFF_WIN + 6815744;
constexpr size_t OFF_WGU = OFF_WOUT + 2097152;
constexpr size_t OFF_WDN = OFF_WGU + 11534336;
constexpr size_t OFF_A = OFF_WDN + 5767168;
constexpr size_t OFF_QATT = OFF_A + 35651584;
constexpr size_t OFF_KATT = OFF_QATT + 16777216;
constexpr size_t OFF_VATT = OFF_KATT + 4456448;
constexpr size_t OFF_QHG = OFF_VATT + 4456448;
constexpr size_t OFF_VHG = OFF_QHG + 17825792;
constexpr size_t OFF_LFC = OFF_VHG + 17825792;
constexpr size_t OFF_GHG = OFF_LFC + 4194304;
constexpr size_t OFF_KT = OFF_GHG + 16777216;
constexpr size_t OFF_AM = OFF_KT + 35651584;
constexpr size_t OFF_DV = OFF_AM + 17825792;
constexpr size_t OFF_MIX = OFF_DV + 3342336;
constexpr size_t OFF_END1 = OFF_MIX + 33554432;
constexpr size_t OFF_LF = OFF_MIX;
constexpr size_t OFF_OB = OFF_END1;
constexpr size_t OFF_END3 = OFF_OB + 33554432;
constexpr size_t OFF_RSS = OFF_END3;
constexpr size_t OFF_CGU = OFF_RSS + 65536;
static_assert(OFF_CGU + 90112 <= 268435456, "workspace over 256 MiB");
static_assert(OFF_LF + 67108864 <= 268435456 && OFF_END3 <= 268435456, "workspace over 256 MiB");
constexpr size_t OFF_X1 = OFF_QATT;
constexpr size_t OFF_ACT = OFF_X1 + 67108864;
constexpr size_t OFF_END2 = OFF_ACT + 92274688;
constexpr size_t WS_NEED = 268435456;
static_assert(WS_NEED <= 268435456, "workspace over 256 MiB");

struct Params {
    const float *x, *c, *ctx, *c_ctx, *w_mod, *b_mod, *g_norm1, *w_in, *g_q, *g_k, *lb_raw, *g_hg, *w_out, *g_norm2, *w_gu, *w_down, *g_final;
    float* out; unsigned char* ws;
};

DEVI unsigned pk_bf16(float lo, float hi) { unsigned r; asm("v_cvt_pk_bf16_f32 %0, %1, %2" : "=v"(r) : "v"(lo), "v"(hi)); return r; }
DEVI unsigned pk_bf16_t(float lo, float hi) { unsigned r; asm("s_nop 1\n\tv_cvt_pk_bf16_f32 %0, %1, %2" : "=v"(r) : "v"(lo), "v"(hi)); return r; }
DEVI unsigned pk_bf16_m(float lo, float hi) { unsigned r; asm("v_cvt_pk_bf16_f32 %0, %1, %2\n\ts_nop 1" : "=v"(r) : "v"(lo), "v"(hi)); return r; }
DEVI void mfma_settle() { asm volatile("s_nop 7\n\ts_nop 7" ::: "memory"); }
DEVI float bf2f(bf16_t h) { return __uint_as_float(((unsigned)h) << 16); }
DEVI float bflo(unsigned u) { return __uint_as_float(u << 16); }
DEVI float bfhi(unsigned u) { return __uint_as_float(u & 0xffff0000u); }
DEVI float siluf(float v) { return v * __builtin_amdgcn_rcpf(1.f + __expf(-v)); }
DEVI f32x4 mfma16(u32x4 a, u32x4 b, f32x4 c) {
    return __builtin_amdgcn_mfma_f32_16x16x32_bf16(__builtin_bit_cast(bf16x8, a), __builtin_bit_cast(bf16x8, b), c, 0, 0, 0);
}
DEVI int tidl() { int t = (int)threadIdx.x; asm volatile("" : "+v"(t)); return t; }
DEVI float wave_sum(float v) {
#pragma unroll
    for (int o = 1; o < 64; o <<= 1) v += __shfl_xor(v, o);
    return v;
}

DEVI void p0_transpose(const float* __restrict__ W, int ldw, bf16_t* __restrict__ Wt, int ldt, int k0, int n0, int gu, unsigned char* smem) {
    float* tile = (float*)smem;
    const int tid = tidl();
#pragma unroll
    for (int i = 0; i < 4; ++i) {
        const int kr = (tid >> 4) + 16 * i, nc = (tid & 15) * 4;
        const f32x4 v = *(const f32x4*)(W + (size_t)(k0 + kr) * ldw + n0 + nc);
        tile[kr * 65 + nc + 0] = v[0]; tile[kr * 65 + nc + 1] = v[1]; tile[kr * 65 + nc + 2] = v[2]; tile[kr * 65 + nc + 3] = v[3];
    }
    __syncthreads();
    const int nl = tid >> 2, kc = (tid & 3) * 16;
    unsigned w[8];
#pragma unroll
    for (int i = 0; i < 8; ++i) w[i] = pk_bf16(tile[(kc + 2 * i) * 65 + nl], tile[(kc + 2 * i + 1) * 65 + nl]);
    const int n = n0 + nl; int nrow = n;
    if (gu) { const int isB = n >= DFF; const int jj = isB ? n - DFF : n; nrow = (jj >> 4) * 32 + (jj & 15) + (isB ? 16 : 0); }
    u32x4* dst = (u32x4*)(Wt + (size_t)nrow * ldt + k0 + kc);
    dst[0] = (u32x4){w[0], w[1], w[2], w[3]}; dst[1] = (u32x4){w[4], w[5], w[6], w[7]};
    __syncthreads();
}

DEVI void p0_mod(const Params& p, int tsk, unsigned char* smem) {
    float* sc = (float*)smem;
    float* red = sc + 5 * 1024;
    float* mod = (float*)(p.ws + OFF_MOD);
    const int tid = tidl();
    for (int idx = tid; idx < 5120; idx += 256) { const int r = idx >> 10, k = idx & 1023; const float v = r < 4 ? p.c[r * 1024 + k] : p.c_ctx[k]; sc[idx] = siluf(v); }
    __syncthreads();
    const int cl = tid & 31, kp = tid >> 5, col = tsk * 32 + cl;
    float a0 = 0.f, a1 = 0.f, a2 = 0.f, a3 = 0.f, a4 = 0.f;
#pragma unroll 16
    for (int k = kp * 128; k < kp * 128 + 128; ++k) {
        const float w = p.w_mod[(size_t)k * 6144 + col];
        a0 += sc[k] * w; a1 += sc[1024 + k] * w; a2 += sc[2048 + k] * w; a3 += sc[3072 + k] * w; a4 += sc[4096 + k] * w;
    }
    red[(kp * 5 + 0) * 32 + cl] = a0; red[(kp * 5 + 1) * 32 + cl] = a1; red[(kp * 5 + 2) * 32 + cl] = a2; red[(kp * 5 + 3) * 32 + cl] = a3; red[(kp * 5 + 4) * 32 + cl] = a4;
    __syncthreads();
    if (tid < 160) { const int r = tid >> 5, c2 = tid & 31; float s = 0.f;
#pragma unroll
        for (int q = 0; q < 8; ++q) s += red[(q * 5 + r) * 32 + c2];
        mod[r * 6144 + tsk * 32 + c2] = s + p.b_mod[tsk * 32 + c2]; }
    __syncthreads();
}

DEVI void phase0(const Params& p, unsigned char* smem) {
    constexpr int T_MOD = 192, T_IN = 16 * 52;
    constexpr int E0 = T_MOD + 1, E1 = E0 + T_IN;
    for (int t = blockIdx.x; t < E1; t += gridDim.x) {
        if (t < T_MOD) { p0_mod(p, t, smem); }
        else if (t == T_MOD) {
            float* lb = (float*)(p.ws + OFF_LB);
            for (int i = tidl(); i < 1024; i += 256) lb[i] = 1.f / (1.f + __expf(p.lb_raw[1024 + i] - p.lb_raw[i]));
            float* rss = (float*)(p.ws + OFF_RSS);
            for (int i = tidl(); i < NLAT; i += 256) rss[i] = 0.f;
        }
        else { const int u = t - E0, kt = u / 52, nt = u % 52; p0_transpose(p.w_in, INC, (bf16_t*)(p.ws + OFF_WIN), 1024, kt * 64, nt * 64, 0, smem); }
    }
}
DEVI void late_transposes(const Params& p, unsigned char* smem) {
    constexpr int T_OUT = 16 * 16, T_GU = 16 * 88, T_DN = 44 * 16;
    constexpr int E2 = T_OUT, E3 = E2 + T_GU, E4 = E3 + T_DN;
    for (int t = blockIdx.x; t < E4; t += gridDim.x) {
        if (t < E2) { const int kt = t / 16, nt = t % 16; p0_transpose(p.w_out, 1024, (bf16_t*)(p.ws + OFF_WOUT), 1024, kt * 64, nt * 64, 0, smem); }
        else if (t < E3) { const int u = t - E2, kt = u / 88, nt = u % 88; p0_transpose(p.w_gu, 2 * DFF, (bf16_t*)(p.ws + OFF_WGU), 1024, kt * 64, nt * 64, 1, smem); }
        else { const int u = t - E3, kt = u / 16, nt = u % 16; p0_transpose(p.w_down, 1024, (bf16_t*)(p.ws + OFF_WDN), DFF, kt * 64, nt * 64, 0, smem); }
    }
}

DEVI void norm_mod_phase(const float* __restrict__ src_lat, const float* __restrict__ src_ctx, bf16_t* __restrict__ dst, const float* __restrict__ g,
                         const float* __restrict__ mod, int shift_idx, int scale_idx, int nrows) {
    const int lane = tidl() & 63, wid = tidl() >> 6;
    for (int t = blockIdx.x; t * 4 < nrows; t += gridDim.x) {
        const int row = t * 4 + wid;
        const float* src = row < NLAT ? src_lat + (size_t)row * DM : src_ctx + (size_t)(row - NLAT) * DM;
        const int mrow = row < NLAT ? (row >> 12) : 4;
        f32x4 v[4]; float ss = 0.f;
#pragma unroll
        for (int i = 0; i < 4; ++i) { v[i] = *(const f32x4*)(src + lane * 4 + 256 * i); ss += v[i][0] * v[i][0] + v[i][1] * v[i][1] + v[i][2] * v[i][2] + v[i][3] * v[i][3]; }
        ss = wave_sum(ss);
        const float rstd = rsqrtf(ss * (1.f / DM) + EPS);
#pragma unroll
        for (int i = 0; i < 4; ++i) {
            const int col = lane * 4 + 256 * i;
            const f32x4 gg = *(const f32x4*)(g + col), sh = *(const f32x4*)(mod + mrow * 6144 + shift_idx * 1024 + col), sc = *(const f32x4*)(mod + mrow * 6144 + scale_idx * 1024 + col);
            f32x4 h;
#pragma unroll
            for (int j = 0; j < 4; ++j) h[j] = v[i][j] * rstd * gg[j] * (1.f + sc[j]) + sh[j];
            *(u32x2*)(dst + (size_t)row * DM + col) = (u32x2){pk_bf16(h[0], h[1]), pk_bf16(h[2], h[3])};
        }
    }
}


DEVI void cgu_phase(const Params& p) {
    const int lane = tidl() & 63, wid = tidl() >> 6;
    const float* mod = (const float*)(p.ws + OFF_MOD);
    const bf16_t* W = (const bf16_t*)(p.ws + OFF_WGU);
    float* cgu = (float*)(p.ws + OFF_CGU);
    for (int t = blockIdx.x; t * 4 < 2 * DFF; t += gridDim.x) {
        const int n = t * 4 + wid;
        const u32x4 w0 = *(const u32x4*)(W + (size_t)n * DM + lane * 16), w1 = *(const u32x4*)(W + (size_t)n * DM + lane * 16 + 8);
        float wv[16] = {bflo(w0.x), bfhi(w0.x), bflo(w0.y), bfhi(w0.y), bflo(w0.z), bfhi(w0.z), bflo(w0.w), bfhi(w0.w),
                        bflo(w1.x), bfhi(w1.x), bflo(w1.y), bfhi(w1.y), bflo(w1.z), bfhi(w1.z), bflo(w1.w), bfhi(w1.w)};
#pragma unroll
        for (int b = 0; b < 4; ++b) {
            const float* sh = mod + b * 6144 + 3 * 1024 + lane * 16;
            float s = 0.f;
#pragma unroll
            for (int q = 0; q < 4; ++q) { const f32x4 sv = *(const f32x4*)(sh + 4 * q); s += sv[0] * wv[4 * q] + sv[1] * wv[4 * q + 1] + sv[2] * wv[4 * q + 2] + sv[3] * wv[4 * q + 3]; }
            s = wave_sum(s);
            if (lane == 0) cgu[b * 2 * DFF + n] = s;
        }
    }
}

#define LDSP __attribute__((address_space(3)))
#define GLBP __attribute__((address_space(1)))
DEVI void glds16(const void* g, unsigned char* l) {
    __builtin_amdgcn_global_load_lds((const GLBP void*)g, (LDSP void*)l, 16, 0, 0);
}
struct GTile2 { const bf16_t* ga; const bf16_t* gb; };
DEVI GTile2 gemm2_src(const bf16_t* A, int lda, const bf16_t* Bt, int ldb, int row0, int col0) {
    const int tid = tidl(), sr = tid >> 2, scn = (tid & 3) ^ ((tid >> 4) & 3);
    GTile2 t; t.ga = A + (size_t)(row0 + sr) * lda + scn * 8; t.gb = Bt + (size_t)(col0 + sr) * ldb + scn * 8; return t;
}
#define G2_ISSUE_T(T, kt_, slot_) { unsigned char* sb_ = smem + (slot_) * 24576 + st_off; const int ko_ = (kt_) * 32; \
        glds16(T.ga + ko_, sb_); glds16(T.ga + a64 + ko_, sb_ + 4096); glds16(T.ga + 2 * a64 + ko_, sb_ + 8192); glds16(T.ga + 3 * a64 + ko_, sb_ + 12288); \
        glds16(T.gb + ko_, sb_ + 16384); glds16(T.gb + b64 + ko_, sb_ + 20480); }
DEVI int mod3(int v) { return v >= 6 ? v - 6 : (v >= 3 ? v - 3 : v); }
DEVI void gemm2_tile(const GTile2 cur, const GTile2 nxt, const bool has_next, const bool first, int& g0, int lda, int ldb, int K, unsigned char* smem,
                     f32x4 (&accL)[4][4], f32x4 (&accH)[4][4]) {
    const int tid = tidl(), lane = tid & 63, wid = tid >> 6, wr = wid >> 1, wc = wid & 1, fr = lane & 15, fq = lane >> 4;
    const size_t a64 = (size_t)64 * lda, b64 = (size_t)64 * ldb;
    const int st_off = tid * 16;
    const int sw = (fr >> 2) & 3;
    const unsigned lds0 = (unsigned)(size_t)((LDSP unsigned char*)smem);
    const unsigned a_rd = lds0 + (wr * 128 + fr) * 64 + ((fq ^ sw) << 4);
    const unsigned b_rd = lds0 + 16384 + (wc * 64 + fr) * 64 + ((fq ^ sw) << 4);
#pragma unroll
    for (int m = 0; m < 4; ++m)
#pragma unroll
        for (int n = 0; n < 4; ++n) { accL[m][n] = (f32x4){0.f, 0.f, 0.f, 0.f}; accH[m][n] = (f32x4){0.f, 0.f, 0.f, 0.f}; }
    const int nk = K >> 5;
    if (first) {
        asm volatile("s_waitcnt vmcnt(0)" ::: "memory");
        __builtin_amdgcn_s_barrier();
        G2_ISSUE_T(cur, 0, mod3(g0)) G2_ISSUE_T(cur, 1, mod3(g0 + 1))
    }
    int slot = mod3(g0);
    for (int s = 0; s < nk; ++s) {
        if (has_next || s + 1 < nk) asm volatile("s_waitcnt vmcnt(6)" ::: "memory");
        else asm volatile("s_waitcnt vmcnt(0)" ::: "memory");
        __builtin_amdgcn_s_barrier();
        { const int s2 = s + 2; const int sl2 = mod3(slot + 2);
          if (s2 < nk) G2_ISSUE_T(cur, s2, sl2) else if (has_next) G2_ISSUE_T(nxt, s2 - nk, sl2) }
        const unsigned sa = a_rd + slot * 24576, sb = b_rd + slot * 24576;
        u32x4 a0, a1, a2, a3, a4, a5, a6, a7, b0, b1, b2, b3;
        asm volatile("ds_read_b128 %0, %1" : "=v"(a0) : "v"(sa)); asm volatile("ds_read_b128 %0, %1 offset:1024" : "=v"(a1) : "v"(sa));
        asm volatile("ds_read_b128 %0, %1 offset:2048" : "=v"(a2) : "v"(sa)); asm volatile("ds_read_b128 %0, %1 offset:3072" : "=v"(a3) : "v"(sa));
        asm volatile("ds_read_b128 %0, %1" : "=v"(b0) : "v"(sb)); asm volatile("ds_read_b128 %0, %1 offset:1024" : "=v"(b1) : "v"(sb));
        asm volatile("ds_read_b128 %0, %1 offset:2048" : "=v"(b2) : "v"(sb)); asm volatile("ds_read_b128 %0, %1 offset:3072" : "=v"(b3) : "v"(sb));
        asm volatile("ds_read_b128 %0, %1 offset:4096" : "=v"(a4) : "v"(sa)); asm volatile("ds_read_b128 %0, %1 offset:5120" : "=v"(a5) : "v"(sa));
        asm volatile("ds_read_b128 %0, %1 offset:6144" : "=v"(a6) : "v"(sa)); asm volatile("ds_read_b128 %0, %1 offset:7168" : "=v"(a7) : "v"(sa));
        asm volatile("s_waitcnt lgkmcnt(4)" : "+v"(a0), "+v"(a1), "+v"(a2), "+v"(a3), "+v"(b0), "+v"(b1), "+v"(b2), "+v"(b3));
        accL[0][0] = mfma16(b0, a0, accL[0][0]); accL[0][1] = mfma16(b1, a0, accL[0][1]); accL[0][2] = mfma16(b2, a0, accL[0][2]); accL[0][3] = mfma16(b3, a0, accL[0][3]);
        accL[1][0] = mfma16(b0, a1, accL[1][0]); accL[1][1] = mfma16(b1, a1, accL[1][1]); accL[1][2] = mfma16(b2, a1, accL[1][2]); accL[1][3] = mfma16(b3, a1, accL[1][3]);
        accL[2][0] = mfma16(b0, a2, accL[2][0]); accL[2][1] = mfma16(b1, a2, accL[2][1]); accL[2][2] = mfma16(b2, a2, accL[2][2]); accL[2][3] = mfma16(b3, a2, accL[2][3]);
        accL[3][0] = mfma16(b0, a3, accL[3][0]); accL[3][1] = mfma16(b1, a3, accL[3][1]); accL[3][2] = mfma16(b2, a3, accL[3][2]); accL[3][3] = mfma16(b3, a3, accL[3][3]);
        asm volatile("s_waitcnt lgkmcnt(0)" : "+v"(a4), "+v"(a5), "+v"(a6), "+v"(a7), "+v"(b0), "+v"(b1), "+v"(b2), "+v"(b3));
        accH[0][0] = mfma16(b0, a4, accH[0][0]); accH[0][1] = mfma16(b1, a4, accH[0][1]); accH[0][2] = mfma16(b2, a4, accH[0][2]); accH[0][3] = mfma16(b3, a4, accH[0][3]);
        accH[1][0] = mfma16(b0, a5, accH[1][0]); accH[1][1] = mfma16(b1, a5, accH[1][1]); accH[1][2] = mfma16(b2, a5, accH[1][2]); accH[1][3] = mfma16(b3, a5, accH[1][3]);
        accH[2][0] = mfma16(b0, a6, accH[2][0]); accH[2][1] = mfma16(b1, a6, accH[2][1]); accH[2][2] = mfma16(b2, a6, accH[2][2]); accH[2][3] = mfma16(b3, a6, accH[2][3]);
        accH[3][0] = mfma16(b0, a7, accH[3][0]); accH[3][1] = mfma16(b1, a7, accH[3][1]); accH[3][2] = mfma16(b2, a7, accH[3][2]); accH[3][3] = mfma16(b3, a7, accH[3][3]);
        slot = mod3(slot + 1);
    }
    g0 = slot;
}
DEVI bool xcd_tile2(int j, int NT, bool ctx, int& mt, int& nt) {
    const int x = blockIdx.x & 7, band = 8 * NT;
    if (j < band) { nt = j >> 3; mt = 8 * x + (j & 7); return true; }
    const int u = j - band;
    if (ctx && u < 9) { const int w = x * 9 + u; mt = 64 + w / 18; nt = 4 + w % 18; return true; }
    mt = 0; nt = 0; return false;
}

DEVI void epi_in(const Params& p, int mt, int nt, int wr, const f32x4 (&acc)[4][4]) {
    const int lane = tidl() & 63, wid = tidl() >> 6, wc = wid & 1, fr = lane & 15, fq = lane >> 4;
    const int row0 = mt * 128 + wr * 64 + fr;
    const bool lat = mt < 128;
    const int b = lat ? (mt >> 5) : ((mt - 128) >> 1);
    const int ntok0 = lat ? (CTX + ((mt & 31) * 128 + wr * 64 + fr)) : (((mt - 128) & 1) * 128 + wr * 64 + fr);
    unsigned char* ws = p.ws;
    if (nt < 5) {
        const bool isq = nt < 4;
        const float* gg = isq ? p.g_q : p.g_k;
        f32x4 gv[4];
#pragma unroll
        for (int n = 0; n < 4; ++n) gv[n] = *(const f32x4*)(gg + 16 * n + 4 * fq);
        float inv[4];
#pragma unroll
        for (int j = 0; j < 4; ++j) inv[j] = exp2f(-(float)(4 * fq + j) * (13.287712379549449f / 16.f));
        const float osc = isq ? 0.125f * 1.4426950408889634f : 1.f;
#pragma unroll
        for (int m = 0; m < 4; ++m) {
            float ss = 0.f;
#pragma unroll
            for (int n = 0; n < 4; ++n) ss += acc[m][n][0] * acc[m][n][0] + acc[m][n][1] * acc[m][n][1] + acc[m][n][2] * acc[m][n][2] + acc[m][n][3] * acc[m][n][3];
            ss += __shfl_xor(ss, 16); ss += __shfl_xor(ss, 32);
            const float rstd = rsqrtf(ss * (1.f / 64.f) + EPS);
            f32x4 v[4];
#pragma unroll
            for (int n = 0; n < 4; ++n) v[n] = acc[m][n] * rstd * gv[n];
            if (lat) {
                const int t = (mt & 31) * 128 + wr * 64 + fr + 16 * m;
                const float pr = (float)(t >> 6), pc = (float)(t & 63);
#pragma unroll
                for (int a = 0; a < 2; ++a) {
                    const float pos = a == 0 ? pr : pc;
#pragma unroll
                    for (int j = 0; j < 4; ++j) {
                        const float ang = pos * inv[j]; const float cs = __cosf(ang), sn = __sinf(ang);
                        const float x0 = v[2 * a][j], x1 = v[2 * a + 1][j];
                        v[2 * a][j] = x0 * cs - x1 * sn; v[2 * a + 1][j] = x1 * cs + x0 * sn;
                    }
                }
            }
            bf16_t* dst;
            if (isq) dst = (bf16_t*)(ws + OFF_QATT) + (size_t)(row0 + 16 * m) * 512 + (nt * 2 + wc) * 64 + 4 * fq;
            else dst = (bf16_t*)(ws + OFF_KATT) + ((size_t)(b * 2 + wc) * NKEY + ntok0 + 16 * m) * 64 + 4 * fq;
#pragma unroll
            for (int n = 0; n < 4; ++n) *(u32x2*)(dst + 16 * n) = (u32x2){pk_bf16(v[n][0] * osc, v[n][1] * osc), pk_bf16(v[n][2] * osc, v[n][3] * osc)};
        }
    } else if (nt == 5) {
        mfma_settle();
        bf16_t* base = (bf16_t*)(ws + OFF_VATT) + (size_t)(b * 2 + wc) * 64 * NKEY;
#pragma unroll
        for (int m = 0; m < 4; ++m)
#pragma unroll
            for (int n = 0; n < 4; ++n)
#pragma unroll
                for (int j = 0; j < 4; ++j) base[(size_t)(16 * n + 4 * fq + j) * NKEY + ntok0 + 16 * m] = (bf16_t)(pk_bf16(acc[m][n][j], 0.f) & 0xffffu);
    } else if (nt < 10) {
        const int cl = (nt - 6) * 128 + wc * 64 + 4 * fq;
#pragma unroll
        for (int m = 0; m < 4; ++m) {
            bf16_t* dst = (bf16_t*)(ws + OFF_QHG) + (size_t)(row0 + 16 * m) * 512 + cl;
#pragma unroll
            for (int n = 0; n < 4; ++n) {
                const float s = 0.08838834764831845f;
                *(u32x2*)(dst + 16 * n) = (u32x2){pk_bf16(siluf(acc[m][n][0]) * s, siluf(acc[m][n][1]) * s), pk_bf16(siluf(acc[m][n][2]) * s, siluf(acc[m][n][3]) * s)};
            }
        }
    } else if (nt < 14) {
        mfma_settle();
        const int h = nt - 10;
        bf16_t* base = (bf16_t*)(ws + OFF_VHG) + (size_t)((b * 4 + h) * 128 + wc * 64) * NKEY;
#pragma unroll
        for (int m = 0; m < 4; ++m)
#pragma unroll
            for (int n = 0; n < 4; ++n)
#pragma unroll
                for (int j = 0; j < 4; ++j) base[(size_t)(16 * n + 4 * fq + j) * NKEY + ntok0 + 16 * m] = (bf16_t)(pk_bf16(acc[m][n][j], 0.f) & 0xffffu);
    } else if (nt < 22) {
        const int cl = (nt - 14) * 128 + wc * 64 + 4 * fq;
        const float* lb = (const float*)(ws + OFF_LB);
        f32x4 lbv[4], qs[4];
#pragma unroll
        for (int n = 0; n < 4; ++n) {
            lbv[n] = *(const f32x4*)(lb + cl + 16 * n);
#pragma unroll
            for (int j = 0; j < 4; ++j) qs[n][j] = 65535.f * __builtin_amdgcn_rcpf(__logf(lbv[n][j]));
        }
#pragma unroll
        for (int m = 0; m < 4; ++m) {
            bf16_t* dst = lat ? (bf16_t*)(ws + OFF_LF) + (size_t)(row0 + 16 * m) * 1024 + cl : (bf16_t*)(ws + OFF_LFC) + (size_t)(row0 + 16 * m - NLAT) * 1024 + cl;
#pragma unroll
            for (int n = 0; n < 4; ++n) {
                unsigned q[4];
#pragma unroll
                for (int j = 0; j < 4; ++j) {
                    const float sg = __builtin_amdgcn_rcpf(1.f + __expf(-acc[m][n][j]));
                    const float lf = __logf(lbv[n][j] + (1.f - lbv[n][j]) * sg);
                    q[j] = (unsigned)fminf(fmaxf(lf * qs[n][j] + 0.5f, 0.f), 65535.f);
                }
                *(u32x2*)(dst + 16 * n) = (u32x2){q[0] | (q[1] << 16), q[2] | (q[3] << 16)};
            }
        }
    } else {
        const int cl = (nt - 22) * 128 + wc * 64 + 4 * fq;
#pragma unroll
        for (int m = 0; m < 4; ++m) {
            bf16_t* dst = (bf16_t*)(ws + OFF_GHG) + (size_t)(row0 + 16 * m) * 512 + cl;
#pragma unroll
            for (int n = 0; n < 4; ++n)
                *(u32x2*)(dst + 16 * n) = (u32x2){pk_bf16(siluf(acc[m][n][0]), siluf(acc[m][n][1])), pk_bf16(siluf(acc[m][n][2]), siluf(acc[m][n][3]))};
        }
    }
}

DEVI void phase_gemm_in(const Params& p, unsigned char* smem) {
    const bf16_t* A = (const bf16_t*)(p.ws + OFF_A);
    const bf16_t* Bt = (const bf16_t*)(p.ws + OFF_WIN);
    bool first = true; int g0 = 0;
    const int nbx = gridDim.x >> 3, wr = tidl() >> 7;
    for (int j = blockIdx.x >> 3; ; j += nbx) {
        int mt, nt, mtn, ntn;
        if (!xcd_tile2(j, 26, true, mt, nt)) break;
        const bool has_next = xcd_tile2(j + nbx, 26, true, mtn, ntn);
        f32x4 accL[4][4], accH[4][4];
        gemm2_tile(gemm2_src(A, DM, Bt, DM, mt * 256, nt * 128), gemm2_src(A, DM, Bt, DM, mtn * 256, ntn * 128), has_next, first, g0, DM, DM, DM, smem, accL, accH);
        first = false;
        epi_in(p, 2 * mt + wr, nt, 0, accL);
        epi_in(p, 2 * mt + wr, nt, 1, accH);
    }
}

DEVI void hg_prep_task(const Params& p, int tk, unsigned char* smem) {
    const int c = tk % NCH, dir = (tk / NCH) & 1, bh = tk / (2 * NCH), h = bh & 3, b = bh >> 2;
    const int tid = tidl(), k = tid & 127, hf = tid >> 7;
    unsigned char* ws = p.ws;
    bf16_t* sQ = (bf16_t*)smem;
    bf16_t* sK = (bf16_t*)(smem + 17408);
    float* tot = (float*)(smem + 34816);
    const bool lat = c >= 4;
    const int rowbase = lat ? (b * SEQ + (c - 4) * 64) : (NLAT + b * CTX + c * 64);
    const bf16_t* lfp = lat ? (const bf16_t*)(ws + OFF_LF) + (size_t)rowbase * 1024 + dir * 512 + h * 128 + k
                            : (const bf16_t*)(ws + OFF_LFC) + (size_t)(rowbase - NLAT) * 1024 + dir * 512 + h * 128 + k;
    const float lfs = __logf(((const float*)(ws + OFF_LB))[dir * 512 + h * 128 + k]) * (1.f / 65535.f);
    const bf16_t* qp = (const bf16_t*)(ws + OFF_QHG) + (size_t)rowbase * 512 + h * 128 + k;
    float lfr[32], qr[32];
#pragma unroll
    for (int i = 0; i < 32; ++i) lfr[i] = (float)lfp[(size_t)(hf * 32 + i) * 1024] * lfs;
#pragma unroll
    for (int i = 0; i < 32; ++i) qr[i] = bf2f(qp[(size_t)(hf * 32 + i) * 512]);
    float tsum = 0.f;
#pragma unroll
    for (int i = 0; i < 32; ++i) tsum += lfr[i];
    tot[hf * 128 + k] = tsum;
    __syncthreads();
    const float t0 = tot[k], t1 = tot[128 + k];
    const float r = dir == 0 ? t0 : t1, blast = t0 + t1;
    const float addv = (dir == 0) ? (hf == 1 ? t0 : 0.f) : (hf == 0 ? t1 : 0.f);
    bf16_t* Qg = (bf16_t*)(ws + OFF_A) + (size_t)tk * 8192;
    float run = addv - r;
    unsigned kw[16];
#define HG_PAIR(i) { \
        const unsigned qq = pk_bf16(qr[i] * __expf(b0), qr[(i) + 1] * __expf(b1)); \
        const unsigned kq = pk_bf16((1.f - __expf(lfr[i])) * __expf(-b0), (1.f - __expf(lfr[(i) + 1])) * __expf(-b1)); \
        kw[(i) >> 1] = kq; \
        const int tok = hf * 32 + (i); \
        sQ[tok * 136 + k] = (bf16_t)(qq & 0xffffu); sQ[(tok + 1) * 136 + k] = (bf16_t)(qq >> 16); \
        sK[tok * 136 + k] = (bf16_t)(kq & 0xffffu); sK[(tok + 1) * 136 + k] = (bf16_t)(kq >> 16); }
    if (dir == 0) {
#pragma unroll
        for (int i = 0; i < 32; i += 2) { const float b0 = run + lfr[i], b1 = b0 + lfr[i + 1]; run = b1; HG_PAIR(i) }
    } else {
#pragma unroll
        for (int i = 30; i >= 0; i -= 2) { const float b1 = run + lfr[i + 1], b0 = b1 + lfr[i]; run = b0; HG_PAIR(i) }
    }
#undef HG_PAIR
    {
        u32x4* kd = (u32x4*)((bf16_t*)(ws + OFF_KT) + (size_t)tk * 8192 + k * 64 + hf * 32);
#pragma unroll
        for (int g = 0; g < 4; ++g) kd[g] = (u32x4){kw[4 * g], kw[4 * g + 1], kw[4 * g + 2], kw[4 * g + 3]};
    }
    if (hf == 0) {
        float* dv = (float*)(ws + OFF_DV) + (size_t)tk * 384;
        dv[k] = __expf(r); dv[128 + k] = __expf(blast - r); dv[256 + k] = __expf(blast);
    }
    __syncthreads();
#pragma unroll
    for (int j = 0; j < 4; ++j) { const int idx = tid + 256 * j, rq = idx >> 4, cq = idx & 15; *(u32x4*)(Qg + rq * 128 + cq * 8) = *(const u32x4*)(smem + rq * 272 + cq * 16); }
    const int lane = tid & 63, w = tid >> 6, fr = lane & 15, fq = lane >> 4;
    f32x4 a[4];
#pragma unroll
    for (int sn = 0; sn < 4; ++sn) a[sn] = (f32x4){0.f, 0.f, 0.f, 0.f};
#pragma unroll
    for (int kk = 0; kk < 4; ++kk) {
        const u32x4 qf = *(const u32x4*)(smem + (16 * w + fr) * 272 + (32 * kk + 8 * fq) * 2);
#pragma unroll
        for (int sn = 0; sn < 4; ++sn) {
            const u32x4 kf = *(const u32x4*)(smem + 17408 + (16 * sn + fr) * 272 + (32 * kk + 8 * fq) * 2);
            a[sn] = mfma16(kf, qf, a[sn]);
        }
    }
    bf16_t* Ag = (bf16_t*)(ws + OFF_AM) + (size_t)tk * 4096;
    const int t = 16 * w + fr;
#pragma unroll
    for (int sn = 0; sn < 4; ++sn) {
        float o[4];
#pragma unroll
        for (int j = 0; j < 4; ++j) { const int s = 16 * sn + 4 * fq + j; const bool keep = dir == 0 ? (s <= t) : (s >= t); o[j] = keep ? a[sn][j] : 0.f; }
        *(u32x2*)(Ag + t * 64 + 16 * sn + 4 * fq) = (u32x2){pk_bf16(o[0], o[1]), pk_bf16(o[2], o[3])};
    }
    __syncthreads();
}

constexpr int SC_KT = 0, SC_QT = 16384, SC_DV = 16384 + 17408, SC_BUF = 16384 + 17408 + 1536;
DEVI int scan_chunk(int dir, int i) { return dir == 0 ? i : (i < 4 ? 3 - i : 71 - i); }
DEVI void scan_block(const Params& p, int blk, unsigned char* smem) {
    const int tid = tidl(), lane = tid & 63, wid = tid >> 6, fr = lane & 15, fq = lane >> 4;
    const int vs = (blk & 1) * 4 + wid, dir = (blk >> 1) & 1, h = (blk >> 2) & 3, b = blk >> 4;
    unsigned char* ws = p.ws;
    const unsigned char* Qt = ws + OFF_A;
    const unsigned char* KtT = ws + OFF_KT;
    const bf16_t* Am = (const bf16_t*)(ws + OFF_AM);
    const unsigned char* dvb = ws + OFF_DV;
    bf16_t* obuf = (bf16_t*)(ws + OFF_OB) + (dir ? (size_t)NLAT * 512 : 0);
    const bf16_t* vrow = (const bf16_t*)(ws + OFF_VHG) + (size_t)((b * 4 + h) * 128 + vs * 16 + fr) * NKEY;
    const int tk0 = ((b * 4 + h) * 2 + dir) * NCH;
    int kt_dst[4], qt_dst[4];
#pragma unroll
    for (int j = 0; j < 4; ++j) {
        const int idx = tid + 256 * j;
        const int rk = idx >> 3, ck = idx & 7; kt_dst[j] = SC_KT + rk * 128 + ((ck ^ ((rk >> 1) & 7)) << 4);
        const int rq = idx >> 4, cq = idx & 15; qt_dst[j] = SC_QT + rq * 272 + cq * 16;
    }
    const int sw = (fr >> 1) & 7;
    const int kt_rd = SC_KT + fr * 128 + ((fq ^ sw) << 4);
    const int qt_rd = SC_QT + fr * 272 + 8 * fq;
    f32x4 S[8];
#pragma unroll
    for (int m = 0; m < 8; ++m) S[m] = (f32x4){0.f, 0.f, 0.f, 0.f};
    u32x4 stK[4], stQ[4], stD, vN[2], aC[8], vC[2];
    {
        const int c = scan_chunk(dir, 0); const size_t tk = tk0 + c;
#pragma unroll
        for (int j = 0; j < 4; ++j) { stK[j] = *(const u32x4*)(KtT + tk * 16384 + (tid + 256 * j) * 16); stQ[j] = *(const u32x4*)(Qt + tk * 16384 + (tid + 256 * j) * 16); }
        stD = (tid < 96) ? *(const u32x4*)(dvb + tk * 1536 + tid * 16) : (u32x4){0u, 0u, 0u, 0u};
        vC[0] = *(const u32x4*)(vrow + 64 * c + 8 * fq); vC[1] = *(const u32x4*)(vrow + 64 * c + 32 + 8 * fq);
#pragma unroll
        for (int q = 0; q < 8; ++q) aC[q] = *(const u32x4*)(Am + tk * 4096 + (16 * (q >> 1) + fr) * 64 + 32 * (q & 1) + 8 * fq);
#pragma unroll
        for (int j = 0; j < 4; ++j) { *(u32x4*)(smem + kt_dst[j]) = stK[j]; *(u32x4*)(smem + qt_dst[j]) = stQ[j]; }
        if (tid < 96) *(u32x4*)(smem + SC_DV + tid * 16) = stD;
        __syncthreads();
    }
#pragma unroll 1
    for (int i = 0; i < NCH; ++i) {
        const int c = scan_chunk(dir, i);
        const unsigned char* buf = smem + (i & 1) * SC_BUF;
        const int cn = scan_chunk(dir, i + 1 < NCH ? i + 1 : NCH - 1);
        const size_t tkn = tk0 + cn;
#pragma unroll
        for (int j = 0; j < 4; ++j) { stK[j] = *(const u32x4*)(KtT + tkn * 16384 + (tid + 256 * j) * 16); stQ[j] = *(const u32x4*)(Qt + tkn * 16384 + (tid + 256 * j) * 16); }
        stD = *(const u32x4*)(dvb + tkn * 1536 + (tid < 96 ? tid : 0) * 16);
        vN[0] = *(const u32x4*)(vrow + 64 * cn + 8 * fq); vN[1] = *(const u32x4*)(vrow + 64 * cn + 32 + 8 * fq);
        f32x4 o[4];
#pragma unroll
        for (int nt = 0; nt < 4; ++nt) o[nt] = (f32x4){0.f, 0.f, 0.f, 0.f};
#pragma unroll
        for (int nt = 0; nt < 4; ++nt) { o[nt] = mfma16(vC[0], aC[2 * nt], o[nt]); o[nt] = mfma16(vC[1], aC[2 * nt + 1], o[nt]); }
        __builtin_amdgcn_sched_barrier(0);
#pragma unroll
        for (int q = 0; q < 8; ++q) aC[q] = *(const u32x4*)(Am + tkn * 4096 + (16 * (q >> 1) + fr) * 64 + 32 * (q & 1) + 8 * fq);
#pragma unroll
        for (int kk = 0; kk < 4; ++kk) {
            const f32x4 da = *(const f32x4*)(buf + SC_DV + (32 * kk + 4 * fq) * 4), db = *(const f32x4*)(buf + SC_DV + (32 * kk + 16 + 4 * fq) * 4);
            const u32x4 sf = (u32x4){pk_bf16_m(S[2 * kk][0] * da[0], S[2 * kk][1] * da[1]), pk_bf16_m(S[2 * kk][2] * da[2], S[2 * kk][3] * da[3]),
                                     pk_bf16_m(S[2 * kk + 1][0] * db[0], S[2 * kk + 1][1] * db[1]), pk_bf16_m(S[2 * kk + 1][2] * db[2], S[2 * kk + 1][3] * db[3])};
#pragma unroll
            for (int nt = 0; nt < 4; ++nt) {
                const u32x2 qa = *(const u32x2*)(buf + qt_rd + nt * 4352 + 64 * kk), qb = *(const u32x2*)(buf + qt_rd + nt * 4352 + 64 * kk + 32);
                o[nt] = mfma16(sf, (u32x4){qa.x, qa.y, qb.x, qb.y}, o[nt]);
            }
        }
        if (c >= 4) {
            mfma_settle();
            bf16_t* od = obuf + (size_t)(b * SEQ + (c - 4) * 64 + fr) * 512 + h * 128 + vs * 16 + 4 * fq;
#pragma unroll
            for (int nt = 0; nt < 4; ++nt) *(u32x2*)(od + (size_t)(16 * nt) * 512) = (u32x2){pk_bf16(o[nt][0], o[nt][1]), pk_bf16(o[nt][2], o[nt][3])};
        }
        __builtin_amdgcn_sched_barrier(0);
#pragma unroll
        for (int mt = 0; mt < 8; ++mt) {
            f32x4 u = (f32x4){0.f, 0.f, 0.f, 0.f};
#pragma unroll
            for (int kk = 0; kk < 2; ++kk) { const u32x4 kf = *(const u32x4*)(buf + ((kt_rd + mt * 2048) ^ (kk << 6))); u = mfma16(kf, vC[kk], u); }
            const f32x4 d2 = *(const f32x4*)(buf + SC_DV + (128 + 16 * mt + 4 * fq) * 4), d3 = *(const f32x4*)(buf + SC_DV + (256 + 16 * mt + 4 * fq) * 4);
            S[mt] = d3 * S[mt] + d2 * u;
        }
        {
            unsigned char* nb = smem + ((i + 1) & 1) * SC_BUF;
#pragma unroll
            for (int j = 0; j < 4; ++j) { *(u32x4*)(nb + kt_dst[j]) = stK[j]; *(u32x4*)(nb + qt_dst[j]) = stQ[j]; }
            if (tid < 96) *(u32x4*)(nb + SC_DV + tid * 16) = stD;
            vC[0] = vN[0]; vC[1] = vN[1];
        }
        __syncthreads();
    }
}

DEVI void attn_item(const Params& p, int item, unsigned char* smem) {
    const int g = item & 3, qb = (item >> 2) & 31, bk = item >> 7, b = bk >> 1, kvh = bk & 1, head = kvh * 4 + g;
    const int tid = tidl(), lane = tid & 63, wid = tid >> 6, fr = lane & 15, fq = lane >> 4;
    unsigned char* ws = p.ws;
    const int r0 = tid >> 3, cl = (tid & 7) ^ ((tid >> 4) & 7);
    const unsigned char* kg0 = ws + OFF_KATT + (size_t)bk * NKEY * 64 * 2 + r0 * 128 + cl * 16;
    const unsigned char* vg0 = ws + OFF_VATT + (size_t)bk * 64 * NKEY * 2 + (size_t)r0 * NKEY * 2 + cl * 16;
    const int st_off = tid * 16;
#define ATT_ISSUE(kt_) { unsigned char* sb_ = smem + ((kt_) & 3) * 16384 + st_off; \
        glds16(kg0 + (size_t)(kt_) * 8192, sb_); glds16(kg0 + (size_t)(kt_) * 8192 + 4096, sb_ + 4096); \
        glds16(vg0 + (kt_) * 128, sb_ + 8192); glds16(vg0 + (size_t)32 * NKEY * 2 + (kt_) * 128, sb_ + 12288); }
    const int q0 = b * SEQ + qb * 128 + wid * 32;
    u32x4 qf[2][2];
#pragma unroll
    for (int qt = 0; qt < 2; ++qt)
#pragma unroll
        for (int kk = 0; kk < 2; ++kk) qf[qt][kk] = *(const u32x4*)((const bf16_t*)(ws + OFF_QATT) + (size_t)(q0 + 16 * qt + fr) * 512 + head * 64 + 32 * kk + 8 * fq);
    f32x4 o[4][2];
#pragma unroll
    for (int dt = 0; dt < 4; ++dt) { o[dt][0] = (f32x4){0.f, 0.f, 0.f, 0.f}; o[dt][1] = (f32x4){0.f, 0.f, 0.f, 0.f}; }
    float gqm = fabsf(p.g_q[lane]), gkm = fabsf(p.g_k[lane]);
#pragma unroll
    for (int of2 = 1; of2 < 64; of2 <<= 1) { gqm = fmaxf(gqm, __shfl_xor(gqm, of2)); gkm = fmaxf(gkm, __shfl_xor(gkm, of2)); }
    const float Mst = 64.f * gqm * gkm * (0.125f * 1.4426950408889634f) * 1.01f;
    f32x4 lacc[2] = {(f32x4){0.f, 0.f, 0.f, 0.f}, (f32x4){0.f, 0.f, 0.f, 0.f}};
    const unsigned one2 = fr == 0 ? 0x3f803f80u : 0u;
    const u32x4 ones = (u32x4){one2, one2, one2, one2};
    const int sw = (fr >> 1) & 7;
    const unsigned lds0 = (unsigned)(size_t)((LDSP unsigned char*)smem);
    const unsigned k_rd = lds0 + fr * 128 + ((fq ^ sw) << 4);
    const unsigned v_rd = lds0 + 8192 + fr * 128 + (((fq >> 1) ^ sw) << 4) + (fq & 1) * 8;
    asm volatile("s_waitcnt vmcnt(0)" ::: "memory");
    __builtin_amdgcn_s_barrier();
    ATT_ISSUE(0) ATT_ISSUE(1) ATT_ISSUE(2)
    for (int kt = 0; kt < NCH; ++kt) {
        if (kt + 2 < NCH) asm volatile("s_waitcnt vmcnt(8)" ::: "memory");
        else if (kt + 1 < NCH) asm volatile("s_waitcnt vmcnt(4)" ::: "memory");
        else asm volatile("s_waitcnt vmcnt(0)" ::: "memory");
        __builtin_amdgcn_s_barrier();
        if (kt + 3 < NCH) ATT_ISSUE(kt + 3)
        const unsigned kb = k_rd + (kt & 3) * 16384, vb = v_rd + (kt & 3) * 16384;
        u32x4 k0, k1, k2, k3, k4, k5, k6, k7;
        asm volatile("ds_read_b128 %0, %1" : "=v"(k0) : "v"(kb));
        asm volatile("ds_read_b128 %0, %1 offset:2048" : "=v"(k1) : "v"(kb));
        asm volatile("ds_read_b128 %0, %1 offset:4096" : "=v"(k2) : "v"(kb));
        asm volatile("ds_read_b128 %0, %1 offset:6144" : "=v"(k3) : "v"(kb));
        asm volatile("ds_read_b128 %0, %1" : "=v"(k4) : "v"(kb ^ 64u));
        asm volatile("ds_read_b128 %0, %1 offset:2048" : "=v"(k5) : "v"(kb ^ 64u));
        asm volatile("ds_read_b128 %0, %1 offset:4096" : "=v"(k6) : "v"(kb ^ 64u));
        asm volatile("ds_read_b128 %0, %1 offset:6144" : "=v"(k7) : "v"(kb ^ 64u));
        asm volatile("s_waitcnt lgkmcnt(0)" : "+v"(k0), "+v"(k1), "+v"(k2), "+v"(k3), "+v"(k4), "+v"(k5), "+v"(k6), "+v"(k7));
        f32x4 s[4][2];
        const f32x4 z4 = (f32x4){-Mst, -Mst, -Mst, -Mst};
        s[0][0] = mfma16(k0, qf[0][0], z4); s[0][1] = mfma16(k0, qf[1][0], z4);
        s[1][0] = mfma16(k1, qf[0][0], z4); s[1][1] = mfma16(k1, qf[1][0], z4);
        s[2][0] = mfma16(k2, qf[0][0], z4); s[2][1] = mfma16(k2, qf[1][0], z4);
        s[3][0] = mfma16(k3, qf[0][0], z4); s[3][1] = mfma16(k3, qf[1][0], z4);
        s[0][0] = mfma16(k4, qf[0][1], s[0][0]); s[0][1] = mfma16(k4, qf[1][1], s[0][1]);
        s[1][0] = mfma16(k5, qf[0][1], s[1][0]); s[1][1] = mfma16(k5, qf[1][1], s[1][1]);
        s[2][0] = mfma16(k6, qf[0][1], s[2][0]); s[2][1] = mfma16(k6, qf[1][1], s[2][1]);
        s[3][0] = mfma16(k7, qf[0][1], s[3][0]); s[3][1] = mfma16(k7, qf[1][1], s[3][1]);
        u32x2 va[8], vbq[8];
#pragma unroll
        for (int kk = 0; kk < 2; ++kk)
#pragma unroll
            for (int dt = 0; dt < 4; ++dt) {
                const unsigned ad = (vb + dt * 2048) ^ (kk << 6);
                asm volatile("ds_read_b64 %0, %1" : "=v"(va[kk * 4 + dt]) : "v"(ad));
                asm volatile("ds_read_b64 %0, %1" : "=v"(vbq[kk * 4 + dt]) : "v"(ad ^ 32u));
            }
        u32x4 pf[2][2];
#pragma unroll
        for (int qt = 0; qt < 2; ++qt) {
#pragma unroll
            for (int ks = 0; ks < 4; ++ks)
#pragma unroll
                for (int j = 0; j < 4; ++j) s[ks][qt][j] = __builtin_amdgcn_exp2f(s[ks][qt][j]);
#pragma unroll
            for (int kk = 0; kk < 2; ++kk)
                pf[qt][kk] = (u32x4){pk_bf16_t(s[2 * kk][qt][0], s[2 * kk][qt][1]), pk_bf16_t(s[2 * kk][qt][2], s[2 * kk][qt][3]),
                                     pk_bf16_t(s[2 * kk + 1][qt][0], s[2 * kk + 1][qt][1]), pk_bf16_t(s[2 * kk + 1][qt][2], s[2 * kk + 1][qt][3])};
        }
        asm volatile("s_nop 1" ::: "memory");
        asm volatile("s_waitcnt lgkmcnt(0)" : "+v"(va[0]), "+v"(va[1]), "+v"(va[2]), "+v"(va[3]), "+v"(va[4]), "+v"(va[5]), "+v"(va[6]), "+v"(va[7]),
                     "+v"(vbq[0]), "+v"(vbq[1]), "+v"(vbq[2]), "+v"(vbq[3]), "+v"(vbq[4]), "+v"(vbq[5]), "+v"(vbq[6]), "+v"(vbq[7]));
#pragma unroll
        for (int kk = 0; kk < 2; ++kk)
#pragma unroll
            for (int dt = 0; dt < 4; ++dt) {
                const u32x4 vfr = (u32x4){va[kk * 4 + dt].x, va[kk * 4 + dt].y, vbq[kk * 4 + dt].x, vbq[kk * 4 + dt].y};
                o[dt][0] = mfma16(vfr, pf[0][kk], o[dt][0]); o[dt][1] = mfma16(vfr, pf[1][kk], o[dt][1]);
            }
        lacc[0] = mfma16(ones, pf[0][0], lacc[0]); lacc[0] = mfma16(ones, pf[0][1], lacc[0]);
        lacc[1] = mfma16(ones, pf[1][0], lacc[1]); lacc[1] = mfma16(ones, pf[1][1], lacc[1]);
    }
#undef ATT_ISSUE
#pragma unroll
    for (int qt = 0; qt < 2; ++qt) {
        const float l = __shfl(lacc[qt][0], fr);
        const float il = 1.f / l;
        bf16_t* dst = (bf16_t*)(ws + OFF_MIX) + (size_t)(q0 + 16 * qt + fr) * 1024 + head * 64 + 4 * fq;
#pragma unroll
        for (int dt = 0; dt < 4; ++dt) *(u32x2*)(dst + 16 * dt) = (u32x2){pk_bf16(o[dt][qt][0] * il, o[dt][qt][1] * il), pk_bf16(o[dt][qt][2] * il, o[dt][qt][3] * il)};
    }
}

DEVI void readout_phase(const Params& p) {
    const int lane = tidl() & 63, wid = tidl() >> 6;
    const bf16_t* of = (const bf16_t*)(p.ws + OFF_OB); const bf16_t* ob = of + (size_t)NLAT * 512;
    const bf16_t* gh = (const bf16_t*)(p.ws + OFF_GHG);
    bf16_t* mix = (bf16_t*)(p.ws + OFF_MIX);
    const f32x4 g0 = *(const f32x4*)(p.g_hg + (lane & 15) * 8), g1 = *(const f32x4*)(p.g_hg + (lane & 15) * 8 + 4);
    for (int t = blockIdx.x; t * 4 < NLAT; t += gridDim.x) {
        const size_t row = (size_t)t * 4 + wid;
        const u32x4 ua = *(const u32x4*)(of + row * 512 + lane * 8), ub = *(const u32x4*)(ob + row * 512 + lane * 8);
        const u32x4 gg = *(const u32x4*)(gh + row * 512 + lane * 8);
        f32x4 v0 = (f32x4){bflo(ua.x) + bflo(ub.x), bfhi(ua.x) + bfhi(ub.x), bflo(ua.y) + bflo(ub.y), bfhi(ua.y) + bfhi(ub.y)};
        f32x4 v1 = (f32x4){bflo(ua.z) + bflo(ub.z), bfhi(ua.z) + bfhi(ub.z), bflo(ua.w) + bflo(ub.w), bfhi(ua.w) + bfhi(ub.w)};
        float ss = v0[0] * v0[0] + v0[1] * v0[1] + v0[2] * v0[2] + v0[3] * v0[3] + v1[0] * v1[0] + v1[1] * v1[1] + v1[2] * v1[2] + v1[3] * v1[3];
        ss += __shfl_xor(ss, 1); ss += __shfl_xor(ss, 2); ss += __shfl_xor(ss, 4); ss += __shfl_xor(ss, 8);
        const float rstd = rsqrtf(ss * (1.f / 128.f) + EPS);
        v0 = v0 * rstd * g0; v1 = v1 * rstd * g1;
        *(u32x4*)(mix + row * 1024 + 512 + lane * 8) = (u32x4){pk_bf16(v0[0] * bflo(gg.x), v0[1] * bfhi(gg.x)), pk_bf16(v0[2] * bflo(gg.y), v0[3] * bfhi(gg.y)),
                                                              pk_bf16(v1[0] * bflo(gg.z), v1[1] * bfhi(gg.z)), pk_bf16(v1[2] * bflo(gg.w), v1[3] * bfhi(gg.w))};
    }
}

template <bool FUSE_NORM>
DEVI void epi_res(const Params& p, int mt, int nt, int wr, const f32x4 (&acc)[4][4], const float* res, float* dst, int gate_idx) {
    const float* mod = (const float*)(p.ws + OFF_MOD);
    const int lane = tidl() & 63, wid = tidl() >> 6, wc = wid & 1, fr = lane & 15, fq = lane >> 4;
    const int b = mt >> 5, col = nt * 128 + wc * 64 + 4 * fq;
    f32x4 gt[4], gs[4];
#pragma unroll
    for (int n = 0; n < 4; ++n) {
        gt[n] = *(const f32x4*)(mod + b * 6144 + gate_idx * 1024 + col + 16 * n);
        if (FUSE_NORM) gs[n] = *(const f32x4*)(p.g_norm2 + col + 16 * n) * (*(const f32x4*)(mod + b * 6144 + 4 * 1024 + col + 16 * n) + 1.f);
    }
#pragma unroll
    for (int m = 0; m < 4; ++m) {
        const int row = mt * 128 + wr * 64 + 16 * m + fr;
        float ss = 0.f;
#pragma unroll
        for (int n = 0; n < 4; ++n) {
            const size_t off = (size_t)row * DM + col + 16 * n;
            const f32x4 v = *(const f32x4*)(res + off) + gt[n] * acc[m][n];
            *(f32x4*)(dst + off) = v;
            if (FUSE_NORM) {
                ss += v[0] * v[0] + v[1] * v[1] + v[2] * v[2] + v[3] * v[3];
                const f32x4 hh = v * gs[n];
                *(u32x2*)((bf16_t*)(p.ws + OFF_A) + off) = (u32x2){pk_bf16(hh[0], hh[1]), pk_bf16(hh[2], hh[3])};
            }
        }
        if (FUSE_NORM) {
            ss += __shfl_xor(ss, 16); ss += __shfl_xor(ss, 32);
            if (fq == 0) atomicAdd((float*)(p.ws + OFF_RSS) + row, ss);
        }
    }
}
template <bool FUSE_NORM>
DEVI void phase_gemm_res(const Params& p, const bf16_t* A, int lda, const bf16_t* Bt, int K, const float* res, float* dst, int gate_idx, unsigned char* smem) {
    bool first = true; int g0 = 0;
    const int nbx = gridDim.x >> 3, wr = tidl() >> 7;
    for (int j = blockIdx.x >> 3; ; j += nbx) {
        int mt, nt, mtn, ntn;
        if (!xcd_tile2(j, 8, false, mt, nt)) break;
        const bool has_next = xcd_tile2(j + nbx, 8, false, mtn, ntn);
        f32x4 accL[4][4], accH[4][4];
        gemm2_tile(gemm2_src(A, lda, Bt, K, mt * 256, nt * 128), gemm2_src(A, lda, Bt, K, mtn * 256, ntn * 128), has_next, first, g0, lda, K, K, smem, accL, accH);
        first = false;
        epi_res<FUSE_NORM>(p, 2 * mt + wr, nt, 0, accL, res, dst, gate_idx);
        epi_res<FUSE_NORM>(p, 2 * mt + wr, nt, 1, accH, res, dst, gate_idx);
    }
}

DEVI void epi_gu(const Params& p, int mt, int nt, int wr, const f32x4 (&acc)[4][4]) {
    bf16_t* act = (bf16_t*)(p.ws + OFF_ACT);
    const int lane = tidl() & 63, wid = tidl() >> 6, wc = wid & 1, fr = lane & 15, fq = lane >> 4;
    const float* cg = (const float*)(p.ws + OFF_CGU) + (mt >> 5) * 2 * DFF + nt * 128 + wc * 64 + 4 * fq;
    f32x4 cb[4];
#pragma unroll
    for (int n = 0; n < 4; ++n) cb[n] = *(const f32x4*)(cg + 16 * n);
#pragma unroll
    for (int m = 0; m < 4; ++m) {
        const int row = mt * 128 + wr * 64 + 16 * m + fr;
        const float rstd = rsqrtf(((const float*)(p.ws + OFF_RSS))[row] * (1.f / DM) + EPS);
        bf16_t* dst = act + (size_t)row * DFF + nt * 64 + wc * 32 + 4 * fq;
#pragma unroll
        for (int n2 = 0; n2 < 2; ++n2) {
            const f32x4 a = acc[m][2 * n2] * rstd + cb[2 * n2], bq = acc[m][2 * n2 + 1] * rstd + cb[2 * n2 + 1];
            *(u32x2*)(dst + 16 * n2) = (u32x2){pk_bf16(siluf(a[0]) * bq[0], siluf(a[1]) * bq[1]), pk_bf16(siluf(a[2]) * bq[2], siluf(a[3]) * bq[3])};
        }
    }
}
DEVI void phase_gemm_gu(const Params& p, unsigned char* smem) {
    const bf16_t* A = (const bf16_t*)(p.ws + OFF_A);
    const bf16_t* Bt = (const bf16_t*)(p.ws + OFF_WGU);
    bool first = true; int g0 = 0;
    const int nbx = gridDim.x >> 3, wr = tidl() >> 7;
    for (int j = blockIdx.x >> 3; ; j += nbx) {
        int mt, nt, mtn, ntn;
        if (!xcd_tile2(j, 44, false, mt, nt)) break;
        const bool has_next = xcd_tile2(j + nbx, 44, false, mtn, ntn);
        f32x4 accL[4][4], accH[4][4];
        gemm2_tile(gemm2_src(A, DM, Bt, DM, mt * 256, nt * 128), gemm2_src(A, DM, Bt, DM, mtn * 256, ntn * 128), has_next, first, g0, DM, DM, DM, smem, accL, accH);
        first = false;
        epi_gu(p, 2 * mt + wr, nt, 0, accL);
        epi_gu(p, 2 * mt + wr, nt, 1, accH);
    }
}

DEVI void final_norm_phase(const Params& p) {
    const int lane = tidl() & 63, wid = tidl() >> 6;
    for (int t = blockIdx.x; t * 4 < NLAT; t += gridDim.x) {
        const float* srow = (const float*)(p.ws + OFF_X1) + ((size_t)t * 4 + wid) * DM;
        float* row = p.out + ((size_t)t * 4 + wid) * DM;
        f32x4 v[4]; float ss = 0.f;
#pragma unroll
        for (int i = 0; i < 4; ++i) { v[i] = *(const f32x4*)(srow + lane * 4 + 256 * i); ss += v[i][0] * v[i][0] + v[i][1] * v[i][1] + v[i][2] * v[i][2] + v[i][3] * v[i][3]; }
        ss = wave_sum(ss);
        const float rstd = rsqrtf(ss * (1.f / DM) + EPS);
#pragma unroll
        for (int i = 0; i < 4; ++i) { const f32x4 gg = *(const f32x4*)(p.g_final + lane * 4 + 256 * i); *(f32x4*)(row + lane * 4 + 256 * i) = v[i] * rstd * gg; }
    }
}


#define XB_TMO      128
#define XB_XCNT(j)  (256  + 64 * (j))
#define XB_XSUB(j)  (1280 + 64 * (j))
#define XB_XGEN(j)  (2304 + 64 * (j))
#define XB_TOP      3328
#define XB_TOPGEN   3392
#define XB_SPIN_CAP (1u << 22)
#define LAS __attribute__((address_space(3)))
DEVI unsigned xb_ld(unsigned* p)              { return __hip_atomic_load(p, __ATOMIC_RELAXED, __HIP_MEMORY_SCOPE_AGENT); }
DEVI unsigned xb_add(unsigned* p, unsigned v) { return __hip_atomic_fetch_add(p, v, __ATOMIC_RELAXED, __HIP_MEMORY_SCOPE_AGENT); }
DEVI unsigned xb_xcc_id() { return (unsigned)__builtin_amdgcn_s_getreg((3 << 11) | 20) & 0xFu; }
#define XB_SPIN(cond, bar) do { unsigned _sp = 0; while (cond) { __builtin_amdgcn_s_sleep(1); \
    if ((++_sp & 255u) == 0u) { if (xb_ld(&(bar)[XB_TMO])) break; if (_sp > XB_SPIN_CAP) { atomicAdd(&(bar)[XB_TMO], 1u); break; } } } } while (0)
struct XcdBarrier { unsigned* bar; unsigned x; volatile unsigned* st; };
DEVI XcdBarrier xcd_barrier_post(unsigned* bar, volatile unsigned* st) {
    XcdBarrier b; b.bar = bar; b.x = xb_xcc_id(); b.st = st;
    if (threadIdx.x == 0) (void)xb_add(&bar[XB_XCNT(b.x)], 1u);
    return b;
}
DEVI void xcd_barrier_complete(unsigned* bar, unsigned x, unsigned& nloc, unsigned& nx) {
    const unsigned G = gridDim.x * gridDim.y * gridDim.z;
    unsigned sum, cnt, mine, sp = 0u;
    for (;;) {
        sum = 0u; cnt = 0u; mine = 0u;
#pragma unroll
        for (unsigned j = 0; j < 16; ++j) { const unsigned c = xb_ld(&bar[XB_XCNT(j)]); sum += c; cnt += (c > 0u) ? 1u : 0u; mine = (j == x) ? c : mine; }
        if (sum == G) break;
        __builtin_amdgcn_s_sleep(1);
        if ((++sp & 255u) == 0u) { if (xb_ld(&bar[XB_TMO])) break; if (sp > XB_SPIN_CAP) { atomicAdd(&bar[XB_TMO], 1u); break; } }
    }
    nloc = mine > 0u ? mine : 1u; nx = cnt > 0u ? cnt : 1u;
}
DEVI void xcd_barrier(const XcdBarrier& b) {
    asm volatile("s_waitcnt vmcnt(0)" ::: "memory");
    __syncthreads();
    if (threadIdx.x == 0) {
        unsigned* bar = b.bar;
        __builtin_amdgcn_s_waitcnt(0);
        unsigned nloc = b.st[0], nx = b.st[1];
        if (nloc == 0u) { xcd_barrier_complete(bar, b.x, nloc, nx); b.st[0] = nloc; b.st[1] = nx; }
        const unsigned old = xb_add(&bar[XB_XSUB(b.x)], 1u);
        const unsigned gen = old / nloc;
        if (old + 1u == (gen + 1u) * nloc) {
            __builtin_amdgcn_fence(__ATOMIC_RELEASE, "agent");
            asm volatile("s_waitcnt vmcnt(0)" ::: "memory");
            const unsigned og = xb_add(&bar[XB_TOP], 1u);
            const unsigned tg = og / nx;
            if (og + 1u == (tg + 1u) * nx) xb_add(&bar[XB_TOPGEN], 1u);
            else XB_SPIN(xb_ld(&bar[XB_TOPGEN]) == tg, bar);
            __builtin_amdgcn_fence(__ATOMIC_ACQUIRE, "agent");
            xb_add(&bar[XB_XGEN(b.x)], 1u);
            asm volatile("s_waitcnt vmcnt(0)" ::: "memory");
        } else {
            XB_SPIN(xb_ld(&bar[XB_XGEN(b.x)]) == gen, bar);
            __builtin_amdgcn_fence(__ATOMIC_ACQUIRE, "agent");
            asm volatile("s_waitcnt vmcnt(0)" ::: "memory");
        }
    }
    __syncthreads();
}

#define GRID_SYNC() xcd_barrier(xb)

__global__ void __launch_bounds__(256, 2) hymba_fwd(Params p) {
    __shared__ __attribute__((aligned(16))) unsigned char smem[73728];
    __shared__ int s_item;
    __shared__ unsigned xb_st[4];
    if (threadIdx.x < 4) xb_st[threadIdx.x] = 0u;
    __syncthreads();
    const XcdBarrier xb = xcd_barrier_post((unsigned*)p.ws, xb_st);
    unsigned char* ws = p.ws;
    const float* mod = (const float*)(ws + OFF_MOD);

    phase0(p, smem);
    GRID_SYNC();
    norm_mod_phase(p.x, p.ctx, (bf16_t*)(ws + OFF_A), p.g_norm1, mod, 0, 1, MROWS);
    late_transposes(p, smem);
    GRID_SYNC();
    phase_gemm_in(p, smem);
    GRID_SYNC();
    for (int t = blockIdx.x; t < NTASK; t += gridDim.x) hg_prep_task(p, t, smem);
    GRID_SYNC();
    if (blockIdx.x < 64) {
        const int bi = (int)blockIdx.x, q8 = bi >> 3, chain = (bi & 7) + 8 * (q8 >> 1);
        scan_block(p, chain * 2 + (q8 & 1), smem);
    }
    for (;;) {
        __syncthreads();
        if (threadIdx.x == 0) s_item = (int)atomicAdd((unsigned*)(ws + OFF_CNT), 1u);
        __syncthreads();
        const int item = s_item;
        if (item >= 1024) break;
        attn_item(p, item, smem);
    }
    GRID_SYNC();
    readout_phase(p);
    cgu_phase(p);
    GRID_SYNC();
    phase_gemm_res<true>(p, (const bf16_t*)(ws + OFF_MIX), DM, (const bf16_t*)(ws + OFF_WOUT), DM, p.x, (float*)(ws + OFF_X1), 2, smem);
    GRID_SYNC();
    phase_gemm_gu(p, smem);
    GRID_SYNC();
    phase_gemm_res<false>(p, (const bf16_t*)(ws + OFF_ACT), DFF, (const bf16_t*)(ws + OFF_WDN), DFF, (const float*)(ws + OFF_X1), (float*)(ws + OFF_X1), 5, smem);
    GRID_SYNC();
    final_norm_phase(p);
}

extern "C" void kernel_launch(void* const* d_in, const int* in_sizes, int n_in, void* d_out, int out_size, void* d_ws, size_t ws_size, hipStream_t stream) {
    static int grid_blocks = 0;
    if (!grid_blocks) {
        int dev = 0, cus = 0, per_cu = 0;
        hipGetDevice(&dev);
        hipDeviceGetAttribute(&cus, hipDeviceAttributeMultiprocessorCount, dev);
        hipOccupancyMaxActiveBlocksPerMultiprocessor(&per_cu, hymba_fwd, 256, 0);
        if (per_cu > 2) per_cu = 2;
        if (per_cu < 1) per_cu = 1;
        grid_blocks = cus * per_cu;
    }
    if (ws_size < WS_NEED) { fprintf(stderr, "workspace too small: %zu < %zu\n", ws_size, (size_t)WS_NEED); return; }
    Params p{};
    p.x = (const float*)d_in[0]; p.c = (const float*)d_in[1]; p.ctx = (const float*)d_in[2]; p.c_ctx = (const float*)d_in[3];
    p.w_mod = (const float*)d_in[4]; p.b_mod = (const float*)d_in[5]; p.g_norm1 = (const float*)d_in[6]; p.w_in = (const float*)d_in[7];
    p.g_q = (const float*)d_in[8]; p.g_k = (const float*)d_in[9]; p.lb_raw = (const float*)d_in[10]; p.g_hg = (const float*)d_in[11];
    p.w_out = (const float*)d_in[12]; p.g_norm2 = (const float*)d_in[13]; p.w_gu = (const float*)d_in[14]; p.w_down = (const float*)d_in[15];
    p.g_final = (const float*)d_in[16];
    p.out = (float*)d_out; p.ws = (unsigned char*)d_ws;
    hipMemsetAsync(d_ws, 0, 32768, stream);
    void* args[] = {&p};
    hipError_t e = hipLaunchCooperativeKernel((void*)hymba_fwd, dim3(grid_blocks), dim3(256), args, 0, stream);
    if (e != hipSuccess) fprintf(stderr, "cooperative launch failed: %s (grid %d)\n", hipGetErrorString(e), grid_blocks);
}
```
